# Optimizing an MI355X kernel written in HIP

```python
import jax, jax.numpy as jnp
from jax import lax
import numpy as np

D_MODEL = 1024
BATCH = 16
SEQ = 4096
DEPTH = 1

D_MIX = D_MODEL
HG_WIDTH = D_MIX // 2
HG_HEADS = 4
HG_DK = HG_WIDTH // HG_HEADS
HG_DV = HG_WIDTH // HG_HEADS
HGRN_CHUNK = 16
GM_WIDTH = D_MIX - HG_WIDTH
GM_GROUPS = 4
GM_GROUP_DIM = GM_WIDTH // GM_GROUPS
GM_CHUNK = 128
PROJ_SIZES = (HG_WIDTH, HG_WIDTH, HG_WIDTH, HG_WIDTH, HG_WIDTH, GM_WIDTH, GM_WIDTH)
PROJ_TOTAL = 5 * HG_WIDTH + 2 * GM_WIDTH
PEER_HEADS = 8
PEER_N_KEYS = 128
PEER_N_EXPERTS = PEER_N_KEYS * PEER_N_KEYS
PEER_TOPK = 16
PEER_QUERY_DIM = 256
PEER_HALF = PEER_QUERY_DIM // 2
PEER_BLOCK = 128
DEEPNORM_ALPHA = (2 * DEPTH) ** 0.25
DEEPNORM_BETA = (8 * DEPTH) ** -0.25
LN_EPS = 1e-5
RMS_EPS = 1e-6

kernel_name = "hybrid_hgrn2_gmlp_peer_deepnorm"


def _layer_norm(x, g, b):
    xf = x.astype(jnp.float32)
    mu = jnp.mean(xf, axis=-1, keepdims=True)
    var = jnp.mean(jnp.square(xf - mu), axis=-1, keepdims=True)
    y = (xf - mu) * lax.rsqrt(var + LN_EPS) * g.astype(jnp.float32) + b.astype(jnp.float32)
    return y.astype(x.dtype)


def _gla_chunkwise(q, k, v, logf):
    B, H, S, DK = q.shape
    DV = v.shape[-1]
    n = S // HGRN_CHUNK
    q = q.reshape(B, H, n, HGRN_CHUNK, DK)
    k = k.reshape(B, H, n, HGRN_CHUNK, DK)
    v = v.reshape(B, H, n, HGRN_CHUNK, DV)
    logf = logf.reshape(B, H, n, HGRN_CHUNK, DK)
    b = jnp.cumsum(logf, axis=3)
    b_last = b[:, :, :, -1:, :]
    q_rel = q * jnp.exp(b - b_last)
    k_rel = k * jnp.exp(b_last - b)
    scores = jnp.einsum('bhntd,bhnsd->bhnts', q_rel, k_rel)
    tri = jnp.tril(jnp.ones((HGRN_CHUNK, HGRN_CHUNK), dtype=bool))
    o_intra = jnp.einsum('bhnts,bhnse->bhnte', jnp.where(tri, scores, 0.0), v)
    q_inter = q * jnp.exp(b)
    decay = jnp.exp(b_last[:, :, :, 0, :])

    def step(state, xs):
        qi, ki, vi, dc = xs
        o = jnp.einsum('bhtd,bhde->bhte', qi, state)
        state = state * dc[..., None] + jnp.einsum('bhsd,bhse->bhde', ki, vi)
        return state, o

    xs = (jnp.moveaxis(q_inter, 2, 0), jnp.moveaxis(k_rel, 2, 0),
          jnp.moveaxis(v, 2, 0), jnp.moveaxis(decay, 2, 0))
    state0 = jnp.zeros((B, H, DK, DV), q.dtype)
    _, o_inter = lax.scan(step, state0, xs)
    o = o_intra + jnp.moveaxis(o_inter, 0, 2)
    return o.reshape(B, H, S, DV)


def _hybrid_mixer(x, w_in, lb, hg_norm_g, gm_ln_g, gm_ln_b, gm_ws, gm_bs, w_out):
    B, S, _ = x.shape
    proj = jnp.einsum('bsd,de->bse', x, w_in)
    splits = [int(c) for c in np.cumsum(PROJ_SIZES)[:-1]]
    q, z_f, z_b, i_in, g, u, v = jnp.split(proj, splits, axis=-1)

    def heads(t):
        return t.astype(jnp.float32).reshape(B, S, HG_HEADS, -1).transpose(0, 2, 1, 3)

    qh, vh = heads(q), heads(i_in)

    def forget(z, lb_dir):
        z = heads(z)
        lb_dir = lb_dir.reshape(HG_HEADS, 1, HG_DK)
        logf = jnp.log(lb_dir + (1.0 - lb_dir) * jax.nn.sigmoid(z))
        k = (1.0 - lb_dir) * jax.nn.sigmoid(-z)
        return k, logf

    k_f, logf_f = forget(z_f, lb[0])
    k_b, logf_b = forget(z_b, lb[1])
    o_f = _gla_chunkwise(qh, k_f, vh, logf_f)
    flip = lambda t: jnp.flip(t, axis=2)
    o_b = flip(_gla_chunkwise(flip(qh), flip(k_b), flip(vh), flip(logf_b)))
    o = o_f + o_b
    o = o * lax.rsqrt(jnp.mean(jnp.square(o), axis=-1, keepdims=True) + RMS_EPS)
    o = o.transpose(0, 2, 1, 3).reshape(B, S, HG_WIDTH)
    y_hg = (o * hg_norm_g.astype(jnp.float32) * jax.nn.silu(g.astype(jnp.float32))).astype(x.dtype)

    u = jax.nn.gelu(u)
    v = jax.nn.gelu(v)
    n = S // GM_CHUNK
    vc = v.reshape(B, n, GM_CHUNK, GM_GROUPS, GM_GROUP_DIM)
    vc = _layer_norm(vc, gm_ln_g, gm_ln_b)
    sp = jnp.einsum('gpq,bnqgc->bnpgc', gm_ws, vc) + gm_bs.T[:, :, None]
    y_gm = u * sp.reshape(B, S, GM_WIDTH)

    y = jnp.concatenate([y_hg, y_gm], axis=-1)
    return jnp.einsum('bse,ed->bsd', y, w_out)


def _peer(x, wq, k1, k2, u_tab, v_tab):
    B, S, D = x.shape
    blocks = x.reshape(-1, PEER_BLOCK, D)

    def one_block(xb):
        T = xb.shape[0]
        qb = jnp.einsum('td,de->te', xb, wq).reshape(T, PEER_HEADS, 2, PEER_HALF)
        s1 = jnp.einsum('thd,hkd->thk', qb[:, :, 0], k1)
        s2 = jnp.einsum('thd,hkd->thk', qb[:, :, 1], k2)
        v1, i1 = lax.top_k(s1, PEER_TOPK)
        v2, i2 = lax.top_k(s2, PEER_TOPK)
        cand = (v1[..., :, None] + v2[..., None, :]).reshape(T, PEER_HEADS, PEER_TOPK * PEER_TOPK)
        cand_idx = (i1[..., :, None] * PEER_N_KEYS + i2[..., None, :]).reshape(T, PEER_HEADS, PEER_TOPK * PEER_TOPK)
        top_s, pos = lax.top_k(cand, PEER_TOPK)
        expert = jnp.take_along_axis(cand_idx, pos, axis=-1).reshape(T, PEER_HEADS * PEER_TOPK)
        gate = jax.nn.softmax(top_s.astype(jnp.float32), axis=-1).astype(xb.dtype)
        gate = gate.reshape(T, PEER_HEADS * PEER_TOPK)
        hid = jnp.einsum('td,tkd->tk', xb, u_tab[expert])
        act = gate * jax.nn.gelu(hid)
        return jnp.einsum('tk,tkd->td', act, v_tab[expert])

    out = lax.map(one_block, blocks)
    return out.reshape(B, S, D)


def setup_inputs(seed: int = 0) -> dict:
    key = jax.random.key(seed)
    ks = jax.random.split(key, 20)
    f32 = jnp.float32
    nrm = lambda k, shape, s: jax.random.normal(k, shape, f32) * s
    x = jax.random.normal(ks[0], (BATCH, SEQ, D_MODEL), f32)
    col_scale = jnp.concatenate([
        jnp.ones((3 * HG_WIDTH,), f32), jnp.full((HG_WIDTH,), DEEPNORM_BETA, f32),
        jnp.ones((HG_WIDTH,), f32), jnp.full((GM_WIDTH,), DEEPNORM_BETA, f32),
        jnp.ones((GM_WIDTH,), f32)])
    w_in = nrm(ks[1], (DEPTH, D_MODEL, PROJ_TOTAL), D_MODEL ** -0.5) * col_scale
    hgrn_lb_logits = nrm(ks[2], (2, DEPTH + 1, HG_WIDTH), 0.1)
    hgrn_norm_g = 1.0 + nrm(ks[3], (DEPTH, HG_WIDTH), 0.02)
    gmlp_ln_g = 1.0 + nrm(ks[4], (DEPTH, GM_GROUPS, GM_GROUP_DIM), 0.02)
    gmlp_ln_b = nrm(ks[5], (DEPTH, GM_GROUPS, GM_GROUP_DIM), 0.02)
    gmlp_ws = nrm(ks[6], (DEPTH, GM_GROUPS, GM_CHUNK, GM_CHUNK), GM_CHUNK ** -0.5)
    gmlp_bs = 1.0 + nrm(ks[7], (DEPTH, GM_GROUPS, GM_CHUNK), 0.02)
    w_out = nrm(ks[8], (DEPTH, D_MIX, D_MODEL), DEEPNORM_BETA * D_MIX ** -0.5)
    ln1_g = 1.0 + nrm(ks[9], (DEPTH, D_MODEL), 0.02)
    ln1_b = nrm(ks[10], (DEPTH, D_MODEL), 0.02)
    peer_wq = nrm(ks[11], (DEPTH, D_MODEL, PEER_HEADS * PEER_QUERY_DIM), D_MODEL ** -0.5)
    peer_k1 = nrm(ks[12], (DEPTH, PEER_HEADS, PEER_N_KEYS, PEER_HALF), PEER_HALF ** -0.5)
    peer_k2 = nrm(ks[13], (DEPTH, PEER_HEADS, PEER_N_KEYS, PEER_HALF), PEER_HALF ** -0.5)
    peer_u = nrm(ks[14], (DEPTH, PEER_N_EXPERTS, D_MODEL), D_MODEL ** -0.5)
    peer_v = nrm(ks[15], (DEPTH, PEER_N_EXPERTS, D_MODEL), DEEPNORM_BETA * (PEER_HEADS * PEER_TOPK) ** -0.5)
    ln2_g = 1.0 + nrm(ks[16], (DEPTH, D_MODEL), 0.02)
    ln2_b = nrm(ks[17], (DEPTH, D_MODEL), 0.02)
    return {"x": x, "w_in": w_in, "hgrn_lb_logits": hgrn_lb_logits, "hgrn_norm_g": hgrn_norm_g,
            "gmlp_ln_g": gmlp_ln_g, "gmlp_ln_b": gmlp_ln_b, "gmlp_ws": gmlp_ws, "gmlp_bs": gmlp_bs,
            "w_out": w_out, "ln1_g": ln1_g, "ln1_b": ln1_b, "peer_wq": peer_wq,
            "peer_k1": peer_k1, "peer_k2": peer_k2, "peer_u": peer_u, "peer_v": peer_v,
            "ln2_g": ln2_g, "ln2_b": ln2_b}


def reference(x, w_in, hgrn_lb_logits, hgrn_norm_g, gmlp_ln_g, gmlp_ln_b, gmlp_ws, gmlp_bs,
              w_out, ln1_g, ln1_b, peer_wq, peer_k1, peer_k2, peer_u, peer_v, ln2_g, ln2_b):
    lb_all = jnp.cumsum(jax.nn.softmax(hgrn_lb_logits.astype(jnp.float32), axis=1), axis=1)
    h = x
    for l in range(DEPTH):
        mix = _hybrid_mixer(h, w_in[l], lb_all[:, l], hgrn_norm_g[l], gmlp_ln_g[l], gmlp_ln_b[l],
                            gmlp_ws[l], gmlp_bs[l], w_out[l])
        h = _layer_norm(DEEPNORM_ALPHA * h + mix, ln1_g[l], ln1_b[l])
        ffn = _peer(h, peer_wq[l], peer_k1[l], peer_k2[l], peer_u[l], peer_v[l])
        h = _layer_norm(DEEPNORM_ALPHA * h + ffn, ln2_g[l], ln2_b[l])
    return h
```

```cpp
#include <hip/hip_runtime.h>
#include <hip/hip_cooperative_groups.h>
#include <cstdio>
#include <cstdint>
namespace cg = cooperative_groups;

namespace pg8 {
#define PG8_LAS __attribute__((address_space(3)))
typedef unsigned short bf16_t;
typedef short bf16x8 __attribute__((ext_vector_type(8)));
typedef float f32x4 __attribute__((ext_vector_type(4)));
typedef unsigned u32x4 __attribute__((ext_vector_type(4)));
constexpr int BM = 256, BK = 64, HALF = 128, HTB = HALF * BK * 2  , STAGE_BYTES = 8 * HTB, NXCD = 8, WGM = 8;

__host__ __device__ __forceinline__ int lds_byte(int r, int c) { const int st = (r >> 4) * 2 + (c >> 5), rr = r & 15, cc = c & 31, ob = rr * 64 + cc * 2; return st * 1024 + (ob ^ (((ob >> 9) & 1) << 5)); }
__host__ __device__ __forceinline__ void stage_rc(int b, int& R, int& C) { const int st = b / 1024, sb = b % 1024, swz = sb ^ (((sb >> 9) & 1) << 5); R = (st >> 1) * 16 + swz / 64; C = (st & 1) * 32 + (swz % 64) / 2; }
__host__ __device__ __forceinline__ int perm32(int rho) { const int n = rho >> 4, i = rho & 15; return 8 * (i >> 2) + 4 * n + (i & 3); }

struct Unit { int pm, pn; };
struct Gemm { const bf16_t* A; const bf16_t* Bt; int M, N, K; };

struct StaticOrder {
    int nM, nN, nwg, G, c;
    __host__ __device__ void init(int M, int N, int G_, int c_) { nM = M / BM; nN = N / BM; nwg = nM * nN; G = G_; c = c_; }
    __host__ __device__ bool next(int i, Unit& u) const {
        const long L = (long)i * G + c; if (L >= nwg) return false;
        int wgid = (int)L; { const int q = nwg / NXCD, r = nwg % NXCD, xcd = wgid % NXCD, off = wgid / NXCD; wgid = (xcd < r ? xcd * (q + 1) : r * (q + 1) + (xcd - r) * q) + off; }
        const int nig = WGM * nN, gid = wgid / nig, fm = gid * WGM, gsz = (nM - fm) < WGM ? (nM - fm) : WGM;
        u.pm = fm + ((wgid % nig) % gsz); u.pn = (wgid % nig) / gsz; return true;
    }
    __device__ __forceinline__ void a_ready(const Unit&) const {}
    __device__ __forceinline__ void done(const Unit&) const {}
};
__device__ __forceinline__ unsigned cvt_pk_bf16(float lo, float hi) { unsigned r; asm volatile("v_cvt_pk_bf16_f32 %0, %1, %2" : "=v"(r) : "v"(lo), "v"(hi)); return r; }
template <class Epi, class Sched, bool ALIGN_EPI = false, bool SP2 = false>
__device__ __forceinline__ void gemm_phase(PG8_LAS unsigned char* lds, const Gemm g, const Sched& S, const Epi& E) {
    const int tid = threadIdx.x, wid = __builtin_amdgcn_readfirstlane(tid >> 6), lane = tid & 63, wr = wid >> 2, wc = wid & 3, fr = lane & 15, fq = lane >> 4;
    const int K = g.K, nt = K / BK;
    unsigned voffA[2], voffB[2];
#pragma unroll
    for (int i = 0; i < 2; ++i) { int R, C; stage_rc(tid * 16 + i * 8192, R, C); const int Rb = Epi::PERM ? ((R & ~31) + perm32(R & 31)) : R;
        voffA[i] = (unsigned)(R * K + C) * 2u; voffB[i] = (unsigned)(Rb * K + C) * 2u; }
    const size_t kstep = (size_t)(BK * 2);
    const size_t hstep = (size_t)HALF * K * 2;
    const size_t tstep = 2 * hstep;
    const unsigned ldsw = (unsigned)wid * 1024u;
    const int aoff = lds_byte(wr * 64 + fr, fq * 8), boff = lds_byte(wc * 32 + fr, fq * 8);
#define PG8_SA(b, h) (((b) * 2 + (h)) * HTB)
#define PG8_SB(b, h) ((4 + (b) * 2 + (h)) * HTB)
#define PG8_STAGE(bufoff, gbase, voff) do { _Pragma("unroll") for (int _i = 0; _i < 2; ++_i) \
        __builtin_amdgcn_global_load_lds((const unsigned*)((const char*)(gbase) + (voff)[_i]), (PG8_LAS unsigned*)(lds + (bufoff) + ldsw + _i * 8192), 16, 0, 0); } while (0)
#define PG8_LDA(dst, b, h) do { _Pragma("unroll") for (int m = 0; m < 4; ++m) _Pragma("unroll") for (int k = 0; k < 2; ++k) dst[m][k] = *(const PG8_LAS bf16x8*)(lds + PG8_SA(b, h) + aoff + m * 2048 + k * 1024); } while (0)
#define PG8_LDB(dst, b, h) do { _Pragma("unroll") for (int n = 0; n < 2; ++n) _Pragma("unroll") for (int k = 0; k < 2; ++k) dst[n][k] = *(const PG8_LAS bf16x8*)(lds + PG8_SB(b, h) + boff + n * 2048 + k * 1024); } while (0)
#define PG8_MMA(ai, bj, At, Bt) do { __builtin_amdgcn_s_setprio(1); _Pragma("unroll") for (int m = 0; m < 4; ++m) _Pragma("unroll") for (int n = 0; n < 2; ++n) _Pragma("unroll") for (int k = 0; k < 2; ++k) \
        acc[ai][bj][m][n] = __builtin_amdgcn_mfma_f32_16x16x32_bf16(Bt[n][k], At[m][k], acc[ai][bj][m][n], 0, 0, 0); __builtin_amdgcn_s_setprio(0); } while (0)
#define PG8_WAIT_V(n) asm volatile("s_waitcnt vmcnt(" #n ")" ::: "memory")
#define PG8_WAIT_L(n) asm volatile("s_waitcnt lgkmcnt(" #n ")" ::: "memory")
#define PG8_BAR __builtin_amdgcn_s_barrier()
#define PG8_SCHED __builtin_amdgcn_sched_barrier(0)
    Unit cur, nxt; int ui = 0;
    if (!S.next(0, cur)) return;
    f32x4 acc[2][2][4][2];
#pragma unroll
    for (int a = 0; a < 2; ++a)
#pragma unroll
        for (int b = 0; b < 2; ++b)
#pragma unroll
            for (int m = 0; m < 4; ++m)
#pragma unroll
                for (int n = 0; n < 2; ++n) acc[a][b][m][n] = (f32x4){0.f, 0.f, 0.f, 0.f};
    bf16x8 At[4][2], B0[2][2], B1[2][2];
    const char* cA = (const char*)g.A + (size_t)cur.pm * tstep; const char* cB = (const char*)g.Bt + (size_t)cur.pn * tstep;
    S.a_ready(cur);
    if constexpr (SP2) {
        PG8_STAGE(PG8_SB(0, 0), cB, voffB); PG8_STAGE(PG8_SB(0, 1), cB + hstep, voffB); PG8_STAGE(PG8_SA(0, 0), cA, voffA); PG8_STAGE(PG8_SA(0, 1), cA + hstep, voffA);
        if (wr == 1) PG8_BAR;
        PG8_WAIT_V(2); PG8_BAR;
        PG8_STAGE(PG8_SB(1, 0), cB + kstep, voffB); PG8_STAGE(PG8_SA(1, 0), cA + kstep, voffA); PG8_STAGE(PG8_SB(1, 1), cB + hstep + kstep, voffB);
        PG8_WAIT_V(6); PG8_BAR;
    } else {
        PG8_STAGE(PG8_SB(0, 0), cB, voffB); PG8_STAGE(PG8_SA(0, 0), cA, voffA); PG8_STAGE(PG8_SB(0, 1), cB + hstep, voffB); PG8_STAGE(PG8_SA(0, 1), cA + hstep, voffA);
        if (wr == 1) PG8_BAR;
        PG8_WAIT_V(4); PG8_BAR;
        PG8_STAGE(PG8_SB(1, 0), cB + kstep, voffB); PG8_STAGE(PG8_SA(1, 0), cA + kstep, voffA); PG8_STAGE(PG8_SB(1, 1), cB + hstep + kstep, voffB);
        PG8_WAIT_V(6); PG8_BAR;
    }
    for (;;) {
        const bool has_next = S.next(ui + 1, nxt);
        const char* nA = has_next ? (const char*)g.A + (size_t)nxt.pm * tstep : cA; const char* nB = has_next ? (const char*)g.Bt + (size_t)nxt.pn * tstep : cB;
        for (int t = 0; t < nt; t += 2) {
            const bool last = (t == nt - 2);
            const char* a1 = cA + (size_t)(t + 1) * kstep;
            const char* a2 = last ? nA : cA + (size_t)(t + 2) * kstep; const char* b2 = last ? nB : cB + (size_t)(t + 2) * kstep;
            const char* a3 = a2 + kstep; const char* b3 = b2 + kstep;
            if (last && has_next) S.a_ready(nxt);
            if constexpr (SP2) {
            PG8_LDB(B0, 0, 0); PG8_LDB(B1, 0, 1); PG8_SCHED; PG8_LDA(At, 0, 0); PG8_STAGE(PG8_SA(1, 1), a1 + hstep, voffA);
            PG8_WAIT_V(8); PG8_WAIT_L(0); PG8_BAR; PG8_MMA(0, 0, At, B0); PG8_MMA(0, 1, At, B1); PG8_BAR; PG8_SCHED;
            PG8_LDA(At, 0, 1); PG8_STAGE(PG8_SB(0, 0), b2, voffB); PG8_STAGE(PG8_SB(0, 1), b2 + hstep, voffB); PG8_STAGE(PG8_SA(0, 0), a2, voffA);
            PG8_WAIT_V(8); PG8_WAIT_L(0); PG8_BAR; PG8_MMA(1, 0, At, B0); PG8_MMA(1, 1, At, B1); PG8_BAR; PG8_SCHED;
            PG8_LDB(B0, 1, 0); PG8_LDB(B1, 1, 1); PG8_SCHED; PG8_LDA(At, 1, 0); PG8_STAGE(PG8_SA(0, 1), a2 + hstep, voffA);
            PG8_WAIT_V(8); PG8_WAIT_L(0); PG8_BAR; PG8_MMA(0, 0, At, B0); PG8_MMA(0, 1, At, B1); PG8_BAR; PG8_SCHED;
            PG8_LDA(At, 1, 1); PG8_STAGE(PG8_SB(1, 0), b3, voffB); PG8_STAGE(PG8_SB(1, 1), b3 + hstep, voffB); PG8_STAGE(PG8_SA(1, 0), a3, voffA);
            PG8_WAIT_V(8); PG8_WAIT_L(0); PG8_BAR; PG8_MMA(1, 0, At, B0); PG8_MMA(1, 1, At, B1); PG8_BAR; PG8_SCHED;
            } else {
            PG8_LDB(B0, 0, 0); PG8_SCHED; PG8_LDA(At, 0, 0); PG8_STAGE(PG8_SA(1, 1), a1 + hstep, voffA);
            PG8_WAIT_L(8); PG8_BAR; PG8_WAIT_L(0); PG8_MMA(0, 0, At, B0); PG8_BAR; PG8_SCHED;
            PG8_LDB(B1, 0, 1); PG8_STAGE(PG8_SB(0, 0), b2, voffB);
            PG8_BAR; PG8_WAIT_L(0); PG8_MMA(0, 1, At, B1); PG8_BAR;
            PG8_LDA(At, 0, 1); PG8_STAGE(PG8_SA(0, 0), a2, voffA);
            PG8_BAR; PG8_WAIT_L(0); PG8_MMA(1, 0, At, B0); PG8_BAR; PG8_SCHED;
            PG8_STAGE(PG8_SB(0, 1), b2 + hstep, voffB);
            PG8_WAIT_V(6); PG8_BAR; PG8_MMA(1, 1, At, B1); PG8_BAR;
            PG8_LDB(B0, 1, 0); PG8_SCHED; PG8_LDA(At, 1, 0); PG8_STAGE(PG8_SA(0, 1), a2 + hstep, voffA);
            PG8_WAIT_L(8); PG8_BAR; PG8_WAIT_L(0); PG8_MMA(0, 0, At, B0); PG8_BAR; PG8_SCHED;
            PG8_LDB(B1, 1, 1); PG8_STAGE(PG8_SB(1, 0), b3, voffB);
            PG8_BAR; PG8_WAIT_L(0); PG8_MMA(0, 1, At, B1); PG8_BAR;
            PG8_LDA(At, 1, 1); PG8_STAGE(PG8_SA(1, 0), a3, voffA);
            PG8_BAR; PG8_WAIT_L(0); PG8_MMA(1, 0, At, B0); PG8_BAR; PG8_SCHED;
            PG8_STAGE(PG8_SB(1, 1), b3 + hstep, voffB);
            PG8_WAIT_V(6); PG8_BAR; PG8_MMA(1, 1, At, B1); PG8_BAR;
            }
        }
        if constexpr (ALIGN_EPI) { if (wr == 0) PG8_BAR; }
        if constexpr (!Epi::AFTER_DRAIN) { E(acc, cur, wr, wc, fr, fq); S.done(cur); }
        if (!has_next) break;
#pragma unroll
        for (int a = 0; a < 2; ++a)
#pragma unroll
            for (int b = 0; b < 2; ++b)
#pragma unroll
                for (int m = 0; m < 4; ++m)
#pragma unroll
                    for (int n = 0; n < 2; ++n) acc[a][b][m][n] = (f32x4){0.f, 0.f, 0.f, 0.f};
        cur = nxt; cA = nA; cB = nB; ++ui;
        if constexpr (ALIGN_EPI) { if (wr == 1) PG8_BAR; }
    }
    PG8_WAIT_V(0);
    if constexpr (!ALIGN_EPI) { if (wr == 0) PG8_BAR; }
    PG8_BAR;
    if constexpr (Epi::AFTER_DRAIN) { E.fused(acc, cur, wr, wc, fr, fq, lds, wid, lane); S.done(cur); }
#undef PG8_SA
#undef PG8_SB
#undef PG8_STAGE
#undef PG8_LDA
#undef PG8_LDB
#undef PG8_MMA
#undef PG8_WAIT_V
#undef PG8_WAIT_L
#undef PG8_BAR
#undef PG8_SCHED
}
}

constexpr int NT = 512, NWAVES = 8;
constexpr int LDS_BYTES = 147456;
constexpr int MTOK = 65536, DM = 1024, SEQ = 4096, NBATCH = 16;
constexpr int NPROJ = 3584;
constexpr int C_Q = 0, C_ZF = 512, C_ZB = 1024, C_I = 1536, C_G = 2048, C_U = 2560, C_V = 3072;
constexpr int NSC = 2048;
constexpr float ALPHA = 1.189207115002721f;
constexpr float LN_EPS = 1e-5f, RMS_EPS = 1e-6f;

constexpr size_t MiB = 1u << 20;
constexpr size_t WS_WIN = 1 * MiB;
constexpr size_t WS_WOUT = 8 * MiB;
constexpr size_t WS_WSC = 10 * MiB;
constexpr size_t WS_XB = 16 * MiB;
constexpr size_t WS_PROJ = 144 * MiB;
constexpr size_t WS_Y = 592 * MiB;
constexpr size_t WS_OF = 720 * MiB;
constexpr size_t WS_OB = 848 * MiB;
constexpr size_t WS_SC = 144 * MiB;
constexpr size_t WS_EID = 720 * MiB;
constexpr size_t WS_GATE = 752 * MiB;
constexpr size_t WS_END = 976 * MiB;

typedef unsigned short bf16;
typedef float f32x4 __attribute__((ext_vector_type(4)));
typedef unsigned u32x4 __attribute__((ext_vector_type(4)));
#define LAS __attribute__((address_space(3)))

__device__ __forceinline__ unsigned f2bf(float f) { unsigned u = __float_as_uint(f); return (u + 0x7fffu + ((u >> 16) & 1u)) >> 16; }
__device__ __forceinline__ unsigned pk2(float lo, float hi) { return f2bf(lo) | (f2bf(hi) << 16); }
__device__ __forceinline__ float bflo(unsigned w) { return __uint_as_float(w << 16); }
__device__ __forceinline__ float bfhi(unsigned w) { return __uint_as_float(w & 0xffff0000u); }
__device__ __forceinline__ float sigmoidf_(float z) { return 1.0f / (1.0f + __expf(-z)); }
__device__ __forceinline__ float gelu_tanh(float x) { return x / (1.0f + __expf(-1.5957691216057308f * (x + 0.044715f * x * x * x))); }
__device__ __forceinline__ float silu_(float x) { return x / (1.0f + __expf(-x)); }
__device__ __forceinline__ float wave_sum(float v) {
#pragma unroll
    for (int o = 1; o < 64; o <<= 1) v += __shfl_xor(v, o);
    return v;
}

struct Params {
    const float *x, *w_in, *lb_logits, *hg_norm_g, *gm_ln_g, *gm_ln_b, *gm_ws, *gm_bs, *w_out, *ln1_g, *ln1_b, *wq, *k1, *k2, *pu, *pv, *ln2_g, *ln2_b;
    float* out; unsigned char* ws;
};

namespace pg8 {
struct EpiProj {
    static constexpr bool PERM = true, AFTER_DRAIN = false;
    bf16* O;
    __device__ __forceinline__ void operator()(const f32x4 (&acc)[2][2][4][2], const Unit& u, int wr, int wc, int fr, int fq) const {
        const int row0 = u.pm * BM + wr * 64 + fr, col0 = u.pn * BM + wc * 32 + 8 * fq;
        const int act = u.pn >= 10 ? 2 : (u.pn >= 8 ? 1 : 0);
#pragma unroll
        for (int ai = 0; ai < 2; ++ai)
#pragma unroll
            for (int m = 0; m < 4; ++m) { bf16* rowp = O + (size_t)(row0 + ai * HALF + m * 16) * NPROJ + col0;
#pragma unroll
                for (int bj = 0; bj < 2; ++bj) { f32x4 v0 = acc[ai][bj][m][0], v1 = acc[ai][bj][m][1];
                    if (act == 2) {
#pragma unroll
                        for (int j = 0; j < 4; ++j) { v0[j] = gelu_tanh(v0[j]); v1[j] = gelu_tanh(v1[j]); } }
                    else if (act == 1) {
#pragma unroll
                        for (int j = 0; j < 4; ++j) { v0[j] = silu_(v0[j]); v1[j] = silu_(v1[j]); } }
                    u32x4 w; w.x = cvt_pk_bf16(v0[0], v0[1]); w.y = cvt_pk_bf16(v0[2], v0[3]); w.z = cvt_pk_bf16(v1[0], v1[1]); w.w = cvt_pk_bf16(v1[2], v1[3]);
                    *(u32x4*)(rowp + bj * HALF) = w; } }
    }
};
struct EpiPre {
    static constexpr bool PERM = false, AFTER_DRAIN = false;
    const float* X; float* P;
    __device__ __forceinline__ void operator()(const f32x4 (&acc)[2][2][4][2], const Unit& u, int wr, int wc, int fr, int fq) const {
        const int row0 = u.pm * BM + wr * 64 + fr, col0 = u.pn * BM + wc * 32 + 4 * fq;
#pragma unroll
        for (int ai = 0; ai < 2; ++ai)
#pragma unroll
            for (int m = 0; m < 4; ++m) { const size_t off = (size_t)(row0 + ai * HALF + m * 16) * DM + col0;
#pragma unroll
                for (int bj = 0; bj < 2; ++bj)
#pragma unroll
                    for (int n = 0; n < 2; ++n) { const f32x4 xv = *(const f32x4*)(X + off + bj * HALF + n * 16);
                        *(f32x4*)(P + off + bj * HALF + n * 16) = xv * ALPHA + acc[ai][bj][m][n]; } }
    }
};
struct EpiF32 {
    static constexpr bool PERM = false, AFTER_DRAIN = false;
    float* C; int ldc;
    __device__ __forceinline__ void operator()(const f32x4 (&acc)[2][2][4][2], const Unit& u, int wr, int wc, int fr, int fq) const {
        const int row0 = u.pm * BM + wr * 64 + fr, col0 = u.pn * BM + wc * 32 + 4 * fq;
#pragma unroll
        for (int ai = 0; ai < 2; ++ai)
#pragma unroll
            for (int m = 0; m < 4; ++m) { float* rowp = C + (size_t)(row0 + ai * HALF + m * 16) * ldc + col0;
#pragma unroll
                for (int bj = 0; bj < 2; ++bj)
#pragma unroll
                    for (int n = 0; n < 2; ++n) *(f32x4*)(rowp + bj * HALF + n * 16) = acc[ai][bj][m][n]; }
    }
};
}

__device__ __forceinline__ void p0_transpose_item(const float* W, int K, int N, bf16* WT, LAS float* scr, int item, int lane) {
    const int nblk = N / 32, kb = item / nblk, nb = item % nblk, k0 = 64 * kb, n0 = 32 * nb;
#pragma unroll 8
    for (int i = 0; i < 32; ++i) { const int kk = 2 * i + (lane >> 5); scr[kk * 33 + (lane & 31)] = W[(size_t)(k0 + kk) * N + n0 + (lane & 31)]; }
    asm volatile("s_waitcnt lgkmcnt(0)" ::: "memory");
    const int c = lane & 7;
#pragma unroll
    for (int j = 0; j < 4; ++j) { const int n = (lane >> 3) + 8 * j; const LAS float* s = scr + (8 * c) * 33 + n;
        u32x4 o; o.x = pk2(s[0 * 33], s[1 * 33]); o.y = pk2(s[2 * 33], s[3 * 33]); o.z = pk2(s[4 * 33], s[5 * 33]); o.w = pk2(s[6 * 33], s[7 * 33]);
        *(u32x4*)(WT + (size_t)(n0 + n) * K + k0 + 8 * c) = o; }
    asm volatile("s_waitcnt lgkmcnt(0)" ::: "memory");
}

__device__ __forceinline__ void phase0(const Params& p, unsigned char* lds_g) {
    const int tid = threadIdx.x, lane = tid & 63, wave = tid >> 6;
    unsigned char* ws = p.ws;
    {
        const size_t n8 = (size_t)MTOK * DM / 8, gsz = (size_t)gridDim.x * NT;
        const f32x4* x4 = (const f32x4*)p.x; u32x4* o = (u32x4*)(ws + WS_XB);
        for (size_t i = (size_t)blockIdx.x * NT + tid; i < n8; i += gsz) { const f32x4 a = x4[2 * i], b = x4[2 * i + 1];
            u32x4 w; w.x = pk2(a[0], a[1]); w.y = pk2(a[2], a[3]); w.z = pk2(b[0], b[1]); w.w = pk2(b[2], b[3]); o[i] = w; }
    }
    {
        LAS float* scr = (LAS float*)(lds_g + wave * 16384);
        const int gw = blockIdx.x * NWAVES + wave, NGW = gridDim.x * NWAVES;
        constexpr int I_IN = (DM / 64) * (NPROJ / 32), I_OUT = (DM / 64) * (DM / 32);
        for (int it = gw; it < I_IN + I_OUT; it += NGW) {
            if (it < I_IN) p0_transpose_item(p.w_in, DM, NPROJ, (bf16*)(ws + WS_WIN), scr, it, lane);
            else p0_transpose_item(p.w_out, DM, DM, (bf16*)(ws + WS_WOUT), scr, it - I_IN, lane);
        }
    }
    __syncthreads();
    {
        float* Ks = (float*)lds_g;
        float* Ws = (float*)(lds_g + 128 * 132 * 4);
        bf16* WscT = (bf16*)(ws + WS_WSC);
        for (int it = blockIdx.x; it < 256; it += gridDim.x) {
            const int combo = it >> 4, dt = it & 15, h = combo >> 1, half = combo & 1, d0 = dt * 64;
            const float* kp = (half ? p.k2 : p.k1) + (size_t)h * 128 * 128;
            for (int i = tid; i < 128 * 128; i += NT) Ks[(i >> 7) * 132 + (i & 127)] = kp[i];
            for (int i = tid; i < 64 * 128; i += NT) Ws[i] = p.wq[(size_t)(d0 + (i >> 7)) * 2048 + h * 256 + half * 128 + (i & 127)];
            __syncthreads();
            const int key = tid & 127, dg = tid >> 7;
            float acc[16];
#pragma unroll
            for (int i = 0; i < 16; ++i) acc[i] = 0.f;
            for (int j = 0; j < 128; j += 4) {
                const f32x4 kv = *(const f32x4*)(Ks + key * 132 + j);
#pragma unroll
                for (int i = 0; i < 16; ++i) { const f32x4 wv = *(const f32x4*)(Ws + (dg * 16 + i) * 128 + j);
                    acc[i] += kv[0] * wv[0] + kv[1] * wv[1] + kv[2] * wv[2] + kv[3] * wv[3]; }
            }
            bf16* orow = WscT + (size_t)(h * 256 + half * 128 + key) * DM + d0 + dg * 16;
            u32x4 w0, w1; w0.x = pk2(acc[0], acc[1]); w0.y = pk2(acc[2], acc[3]); w0.z = pk2(acc[4], acc[5]); w0.w = pk2(acc[6], acc[7]);
            w1.x = pk2(acc[8], acc[9]); w1.y = pk2(acc[10], acc[11]); w1.z = pk2(acc[12], acc[13]); w1.w = pk2(acc[14], acc[15]);
            *(u32x4*)orow = w0; *(u32x4*)(orow + 8) = w1;
            __syncthreads();
        }
    }
}

__device__ __forceinline__ void hgrn_naive_item(const Params& p, unsigned char* lds_g, int item) {
    const int tid = threadIdx.x, lane = tid & 63, wave = tid >> 6;
    const int b = item >> 3, h = (item >> 1) & 3, dir = item & 1;
    float* F = (float*)lds_g; float* Kk = F + 64 * 128; float* Q = Kk + 64 * 128; float* V = Q + 64 * 128;
    const bf16* proj = (const bf16*)(p.ws + WS_PROJ);
    float* O = (float*)(p.ws + (dir ? WS_OB : WS_OF));
    const int ts = tid >> 3, dg = tid & 7;
    float lb[16];
#pragma unroll
    for (int i = 0; i < 16; ++i) { const int c = h * 128 + dg * 16 + i; const float l0 = p.lb_logits[(dir * 2 + 0) * 512 + c], l1 = p.lb_logits[(dir * 2 + 1) * 512 + c]; lb[i] = 1.0f / (1.0f + __expf(l1 - l0)); }
    const int e = wave * 16 + (lane >> 2), dq = lane & 3;
    float S[32];
#pragma unroll
    for (int i = 0; i < 32; ++i) S[i] = 0.f;
    for (int c = 0; c < SEQ / 64; ++c) {
        {
            const int s = c * 64 + ts, t = dir ? (SEQ - 1 - s) : s; const size_t row = (size_t)b * SEQ + t;
            const bf16* pr = proj + row * NPROJ;
            const u32x4 z0 = *(const u32x4*)(pr + (dir ? C_ZB : C_ZF) + h * 128 + dg * 16), z1 = *(const u32x4*)(pr + (dir ? C_ZB : C_ZF) + h * 128 + dg * 16 + 8);
            const u32x4 q0 = *(const u32x4*)(pr + C_Q + h * 128 + dg * 16), q1 = *(const u32x4*)(pr + C_Q + h * 128 + dg * 16 + 8);
            const u32x4 i0 = *(const u32x4*)(pr + C_I + h * 128 + dg * 16), i1 = *(const u32x4*)(pr + C_I + h * 128 + dg * 16 + 8);
            const unsigned zw[8] = {z0.x, z0.y, z0.z, z0.w, z1.x, z1.y, z1.z, z1.w};
            const unsigned qw[8] = {q0.x, q0.y, q0.z, q0.w, q1.x, q1.y, q1.z, q1.w};
            const unsigned iw[8] = {i0.x, i0.y, i0.z, i0.w, i1.x, i1.y, i1.z, i1.w};
            const int base = ts * 128 + dg * 16;
#pragma unroll
            for (int j = 0; j < 8; ++j) {
                const float za = bflo(zw[j]), zb = bfhi(zw[j]);
                const float sa = sigmoidf_(za), sb = sigmoidf_(zb);
                F[base + 2 * j] = lb[2 * j] + (1.0f - lb[2 * j]) * sa; F[base + 2 * j + 1] = lb[2 * j + 1] + (1.0f - lb[2 * j + 1]) * sb;
                Kk[base + 2 * j] = (1.0f - lb[2 * j]) * (1.0f - sa); Kk[base + 2 * j + 1] = (1.0f - lb[2 * j + 1]) * (1.0f - sb);
                Q[base + 2 * j] = bflo(qw[j]); Q[base + 2 * j + 1] = bfhi(qw[j]);
                V[base + 2 * j] = bflo(iw[j]); V[base + 2 * j + 1] = bfhi(iw[j]);
            }
        }
        __syncthreads();
        for (int s2 = 0; s2 < 64; ++s2) {
            const float v = V[s2 * 128 + e];
            float o = 0.f;
            const float* fp = F + s2 * 128 + dq * 32; const float* kp = Kk + s2 * 128 + dq * 32; const float* qp = Q + s2 * 128 + dq * 32;
#pragma unroll
            for (int i = 0; i < 32; i += 4) {
                const f32x4 fv = *(const f32x4*)(fp + i), kv = *(const f32x4*)(kp + i), qv = *(const f32x4*)(qp + i);
#pragma unroll
                for (int j = 0; j < 4; ++j) { S[i + j] = fv[j] * S[i + j] + kv[j] * v; o += S[i + j] * qv[j]; }
            }
            o += __shfl_xor(o, 1); o += __shfl_xor(o, 2);
            if (dq == 0) { const int s = c * 64 + s2, t = dir ? (SEQ - 1 - s) : s; O[((size_t)b * SEQ + t) * 512 + h * 128 + e] = o; }
        }
        __syncthreads();
    }
}

__device__ __forceinline__ void gmlp_naive_item(const Params& p, unsigned char* lds_g, int item) {
    const int tid = threadIdx.x, lane = tid & 63, wave = tid >> 6;
    const int g = item & 3, n = (item >> 2) & 31, b = item >> 7;
    float* Wt = (float*)lds_g;
    float* vc = Wt + 128 * 132;
    const bf16* proj = (const bf16*)(p.ws + WS_PROJ);
    bf16* Y = (bf16*)(p.ws + WS_Y);
    const float* Wg = p.gm_ws + (size_t)g * 128 * 128;
    for (int i = tid; i < 128 * 128; i += NT) { const int pp = i >> 7, q = i & 127; Wt[q * 132 + pp] = Wg[i]; }
    const size_t row0 = (size_t)b * SEQ + n * 128;
    for (int pos = wave * 16; pos < wave * 16 + 16; ++pos) {
        const unsigned w = *(const unsigned*)(proj + (row0 + pos) * NPROJ + C_V + g * 128 + lane * 2);
        const float a = bflo(w), c = bfhi(w);
        const float mu = wave_sum(a + c) * (1.0f / 128.0f);
        const float da = a - mu, dc = c - mu;
        const float var = wave_sum(da * da + dc * dc) * (1.0f / 128.0f);
        const float rstd = 1.0f / sqrtf(var + LN_EPS);
        vc[pos * 128 + lane * 2] = da * rstd * p.gm_ln_g[g * 128 + lane * 2] + p.gm_ln_b[g * 128 + lane * 2];
        vc[pos * 128 + lane * 2 + 1] = dc * rstd * p.gm_ln_g[g * 128 + lane * 2 + 1] + p.gm_ln_b[g * 128 + lane * 2 + 1];
    }
    __syncthreads();
    const int c = tid & 127, pg = tid >> 7;
    float acc[32];
#pragma unroll
    for (int i = 0; i < 32; ++i) acc[i] = 0.f;
    for (int q = 0; q < 128; ++q) {
        const float xv = vc[q * 128 + c];
        const float* wp = Wt + q * 132 + pg * 32;
#pragma unroll
        for (int i = 0; i < 32; i += 4) { const f32x4 wv = *(const f32x4*)(wp + i);
#pragma unroll
            for (int j = 0; j < 4; ++j) acc[i + j] += wv[j] * xv; }
    }
#pragma unroll
    for (int i = 0; i < 32; ++i) { const int pp = pg * 32 + i; const size_t row = row0 + pp;
        const float uv = __uint_as_float(((unsigned)proj[row * NPROJ + C_U + g * 128 + c]) << 16);
        Y[row * DM + 512 + g * 128 + c] = (bf16)f2bf(uv * (acc[i] + p.gm_bs[g * 128 + pp])); }
    __syncthreads();
}

__device__ __forceinline__ void hgrn_finalize(const Params& p) {
    const int tid = threadIdx.x, lane = tid & 63, wave = tid >> 6;
    const float* OF = (const float*)(p.ws + WS_OF); const float* OB = (const float*)(p.ws + WS_OB);
    const bf16* proj = (const bf16*)(p.ws + WS_PROJ); bf16* Y = (bf16*)(p.ws + WS_Y);
    for (int t = blockIdx.x * NWAVES + wave; t < MTOK; t += gridDim.x * NWAVES) {
        const f32x4 a0 = *(const f32x4*)(OF + (size_t)t * 512 + lane * 8), a1 = *(const f32x4*)(OF + (size_t)t * 512 + lane * 8 + 4);
        const f32x4 b0 = *(const f32x4*)(OB + (size_t)t * 512 + lane * 8), b1 = *(const f32x4*)(OB + (size_t)t * 512 + lane * 8 + 4);
        const f32x4 o0 = a0 + b0, o1 = a1 + b1;
        float ss = o0[0] * o0[0] + o0[1] * o0[1] + o0[2] * o0[2] + o0[3] * o0[3] + o1[0] * o1[0] + o1[1] * o1[1] + o1[2] * o1[2] + o1[3] * o1[3];
        ss += __shfl_xor(ss, 1); ss += __shfl_xor(ss, 2); ss += __shfl_xor(ss, 4); ss += __shfl_xor(ss, 8);
        const float r = 1.0f / sqrtf(ss * (1.0f / 128.0f) + RMS_EPS);
        const u32x4 gw = *(const u32x4*)(proj + (size_t)t * NPROJ + C_G + lane * 8);
        const f32x4 n0 = *(const f32x4*)(p.hg_norm_g + lane * 8), n1 = *(const f32x4*)(p.hg_norm_g + lane * 8 + 4);
        u32x4 w;
        w.x = pk2(o0[0] * r * n0[0] * bflo(gw.x), o0[1] * r * n0[1] * bfhi(gw.x));
        w.y = pk2(o0[2] * r * n0[2] * bflo(gw.y), o0[3] * r * n0[3] * bfhi(gw.y));
        w.z = pk2(o1[0] * r * n1[0] * bflo(gw.z), o1[1] * r * n1[1] * bfhi(gw.z));
        w.w = pk2(o1[2] * r * n1[2] * bflo(gw.w), o1[3] * r * n1[3] * bfhi(gw.w));
        *(u32x4*)(Y + (size_t)t * DM + lane * 8) = w;
    }
}

__device__ __forceinline__ void ln1_pass(const Params& p) {
    const int tid = threadIdx.x, lane = tid & 63, wave = tid >> 6;
    bf16* H1B = (bf16*)(p.ws + WS_XB);
    for (int t = blockIdx.x * NWAVES + wave; t < MTOK; t += gridDim.x * NWAVES) {
        float* row = p.out + (size_t)t * DM;
        f32x4 v[4]; float s = 0.f;
#pragma unroll
        for (int j = 0; j < 4; ++j) { v[j] = *(const f32x4*)(row + j * 256 + lane * 4); s += (v[j][0] + v[j][1]) + (v[j][2] + v[j][3]); }
        const float mean = wave_sum(s) * (1.0f / DM); float s2 = 0.f;
#pragma unroll
        for (int j = 0; j < 4; ++j) { v[j] = v[j] - mean; s2 += (v[j][0] * v[j][0] + v[j][1] * v[j][1]) + (v[j][2] * v[j][2] + v[j][3] * v[j][3]); }
        const float rstd = 1.0f / sqrtf(wave_sum(s2) * (1.0f / DM) + LN_EPS);
#pragma unroll
        for (int j = 0; j < 4; ++j) { const f32x4 gg = *(const f32x4*)(p.ln1_g + j * 256 + lane * 4), bb = *(const f32x4*)(p.ln1_b + j * 256 + lane * 4);
            const f32x4 hv = v[j] * rstd * gg + bb;
            *(f32x4*)(row + j * 256 + lane * 4) = hv;
            unsigned long long w = (unsigned long long)pk2(hv[0], hv[1]) | ((unsigned long long)pk2(hv[2], hv[3]) << 32);
            *(unsigned long long*)(H1B + (size_t)t * DM + j * 256 + lane * 4) = w; }
    }
}

__device__ __forceinline__ void wave_argmax(float& v, int& i) {
#pragma unroll
    for (int o = 1; o < 64; o <<= 1) { const float ov = __shfl_xor(v, o); const int oi = __shfl_xor(i, o); if (ov > v || (ov == v && oi < i)) { v = ov; i = oi; } }
}
__device__ __forceinline__ void topk_naive(const Params& p) {
    const int tid = threadIdx.x, lane = tid & 63, wave = tid >> 6;
    const float* SC = (const float*)(p.ws + WS_SC);
    int* EID = (int*)(p.ws + WS_EID); float* GATE = (float*)(p.ws + WS_GATE);
    const float NEG = -3.0e38f;
    for (int it = blockIdx.x * NWAVES + wave; it < MTOK * 8; it += gridDim.x * NWAVES) {
        const int t = it >> 3, h = it & 7;
        const float* srow = SC + (size_t)t * NSC + h * 256;
        float tv[2]; int ti[2];
#pragma unroll
        for (int hh = 0; hh < 2; ++hh) {
            float a = srow[hh * 128 + lane], b = srow[hh * 128 + 64 + lane];
            float myv = NEG; int myi = 0;
            for (int r = 0; r < 16; ++r) {
                float bv; int bi; if (a >= b) { bv = a; bi = lane; } else { bv = b; bi = lane + 64; }
                wave_argmax(bv, bi);
                if (lane == r) { myv = bv; myi = bi; }
                if (bi == lane) a = NEG; if (bi == lane + 64) b = NEG;
            }
            tv[hh] = myv; ti[hh] = myi;
        }
        float cv[4];
#pragma unroll
        for (int j = 0; j < 4; ++j) cv[j] = __shfl(tv[0], (lane >> 4) + 4 * j) + __shfl(tv[1], lane & 15);
        float gv = NEG; int gpos = 0;
        for (int r = 0; r < 16; ++r) {
            float bv = cv[0]; int bi = lane;
#pragma unroll
            for (int j = 1; j < 4; ++j) if (cv[j] > bv) { bv = cv[j]; bi = lane + 64 * j; }
            wave_argmax(bv, bi);
            if (lane == r) { gv = bv; gpos = bi; }
#pragma unroll
            for (int j = 0; j < 4; ++j) if (bi == lane + 64 * j) cv[j] = NEG;
        }
        const float mx = __shfl(gv, 0);
        float ex = lane < 16 ? __expf(gv - mx) : 0.f;
        float den = ex; den += __shfl_xor(den, 1); den += __shfl_xor(den, 2); den += __shfl_xor(den, 4); den += __shfl_xor(den, 8);
        const int i1 = __shfl(ti[0], gpos >> 4), i2 = __shfl(ti[1], gpos & 15);
        if (lane < 16) { EID[(size_t)t * 128 + h * 16 + lane] = i1 * 128 + i2; GATE[(size_t)t * 128 + h * 16 + lane] = ex / den; }
    }
}

__device__ __forceinline__ void peer_naive(const Params& p) {
    const int tid = threadIdx.x, lane = tid & 63, wave = tid >> 6;
    const int* EID = (const int*)(p.ws + WS_EID); const float* GATE = (const float*)(p.ws + WS_GATE);
    for (int t = blockIdx.x * NWAVES + wave; t < MTOK; t += gridDim.x * NWAVES) {
        float* row = p.out + (size_t)t * DM;
        f32x4 hv[4], acc[4];
#pragma unroll
        for (int j = 0; j < 4; ++j) { hv[j] = *(const f32x4*)(row + j * 256 + lane * 4); acc[j] = (f32x4){0.f, 0.f, 0.f, 0.f}; }
        const int e_lo = EID[(size_t)t * 128 + lane], e_hi = EID[(size_t)t * 128 + 64 + lane];
        const float g_lo = GATE[(size_t)t * 128 + lane], g_hi = GATE[(size_t)t * 128 + 64 + lane];
        for (int k = 0; k < 128; ++k) {
            const int e = __shfl(k < 64 ? e_lo : e_hi, k & 63); const float gt = __shfl(k < 64 ? g_lo : g_hi, k & 63);
            const float* ur = p.pu + (size_t)e * DM; const float* vr = p.pv + (size_t)e * DM;
            float d = 0.f;
#pragma unroll
            for (int j = 0; j < 4; ++j) { const f32x4 uv = *(const f32x4*)(ur + j * 256 + lane * 4); d += (hv[j][0] * uv[0] + hv[j][1] * uv[1]) + (hv[j][2] * uv[2] + hv[j][3] * uv[3]); }
            const float hid = wave_sum(d);
            const float a = gt * gelu_tanh(hid);
#pragma unroll
            for (int j = 0; j < 4; ++j) { const f32x4 vv = *(const f32x4*)(vr + j * 256 + lane * 4); acc[j] += vv * a; }
        }
        float s = 0.f;
#pragma unroll
        for (int j = 0; j < 4; ++j) { acc[j] = hv[j] * ALPHA + acc[j]; s += (acc[j][0] + acc[j][1]) + (acc[j][2] + acc[j][3]); }
        const float mean = wave_sum(s) * (1.0f / DM); float s2 = 0.f;
#pragma unroll
        for (int j = 0; j < 4; ++j) { acc[j] = acc[j] - mean; s2 += (acc[j][0] * acc[j][0] + acc[j][1] * acc[j][1]) + (acc[j][2] * acc[j][2] + acc[j][3] * acc[j][3]); }
        const float rstd = 1.0f / sqrtf(wave_sum(s2) * (1.0f / DM) + LN_EPS);
#pragma unroll
        for (int j = 0; j < 4; ++j) { const f32x4 gg = *(const f32x4*)(p.ln2_g + j * 256 + lane * 4), bb = *(const f32x4*)(p.ln2_b + j * 256 + lane * 4);
            *(f32x4*)(row + j * 256 + lane * 4) = acc[j] * rstd * gg + bb; }
    }
}

__global__ void __launch_bounds__(NT, 2) mega(Params p) {
    extern __shared__ __attribute__((aligned(16))) unsigned char lds[];
    cg::grid_group grid = cg::this_grid();
    unsigned char* ws = p.ws;
    const int G = gridDim.x;

    phase0(p, lds);
    grid.sync();

    {
        pg8::Gemm g{(const bf16*)(ws + WS_XB), (const bf16*)(ws + WS_WIN), MTOK, NPROJ, DM}; pg8::StaticOrder S; S.init(MTOK, NPROJ, G, (int)blockIdx.x);
        pg8::EpiProj E{(bf16*)(ws + WS_PROJ)};
        pg8::gemm_phase<pg8::EpiProj, pg8::StaticOrder, true, true>((PG8_LAS unsigned char*)lds, g, S, E);
    }
    grid.sync();

    {
        const int half = G / 2;
        if ((int)blockIdx.x < half) { for (int it = blockIdx.x; it < 128; it += half) hgrn_naive_item(p, lds, it); }
        else { for (int it = blockIdx.x - half; it < 2048; it += G - half) gmlp_naive_item(p, lds, it); }
    }
    grid.sync();
    hgrn_finalize(p);
    grid.sync();

    {
        pg8::Gemm g{(const bf16*)(ws + WS_Y), (const bf16*)(ws + WS_WOUT), MTOK, DM, DM}; pg8::StaticOrder S; S.init(MTOK, DM, G, (int)blockIdx.x);
        pg8::EpiPre E{p.x, p.out};
        pg8::gemm_phase<pg8::EpiPre, pg8::StaticOrder, true, true>((PG8_LAS unsigned char*)lds, g, S, E);
    }
    grid.sync();
    ln1_pass(p);
    grid.sync();

    {
        pg8::Gemm g{(const bf16*)(ws + WS_XB), (const bf16*)(ws + WS_WSC), MTOK, NSC, DM}; pg8::StaticOrder S; S.init(MTOK, NSC, G, (int)blockIdx.x);
        pg8::EpiF32 E{(float*)(ws + WS_SC), NSC};
        pg8::gemm_phase<pg8::EpiF32, pg8::StaticOrder, true, true>((PG8_LAS unsigned char*)lds, g, S, E);
    }
    grid.sync();
    topk_naive(p);
    grid.sync();
    peer_naive(p);
}

extern "C" void kernel_launch(void* const* d_in, const int* in_sizes, int n_in, void* d_out, int out_size, void* d_ws, size_t ws_size, hipStream_t stream) {
    static int grid = 0;
    if (grid == 0) {
        if (n_in != 18 || in_sizes[0] != MTOK * DM || out_size != MTOK * DM || ws_size < WS_END) {
            fprintf(stderr, "kernel_launch: unexpected shapes (n_in %d, in0 %d, out %d, ws %zu); nothing launched\n", n_in, n_in > 0 ? in_sizes[0] : -1, out_size, ws_size); grid = -1; return; }
        int dev = 0, cus = 0, per_cu = 0;
        if (hipGetDevice(&dev) != hipSuccess || hipDeviceGetAttribute(&cus, hipDeviceAttributeMultiprocessorCount, dev) != hipSuccess) { grid = -1; return; }
        if (hipFuncSetAttribute((const void*)mega, hipFuncAttributeMaxDynamicSharedMemorySize, LDS_BYTES) != hipSuccess) { fprintf(stderr, "kernel_launch: hipFuncSetAttribute failed\n"); grid = -1; return; }
        if (hipOccupancyMaxActiveBlocksPerMultiprocessor(&per_cu, (const void*)mega, NT, LDS_BYTES) != hipSuccess || per_cu < 1) { fprintf(stderr, "kernel_launch: occupancy query says %d\n", per_cu); grid = -1; return; }
        grid = cus;
    }
    if (grid < 0) return;
    Params p{};
    p.x = (const float*)d_in[0]; p.w_in = (const float*)d_in[1]; p.lb_logits = (const float*)d_in[2]; p.hg_norm_g = (const float*)d_in[3];
    p.gm_ln_g = (const float*)d_in[4]; p.gm_ln_b = (const float*)d_in[5]; p.gm_ws = (const float*)d_in[6]; p.gm_bs = (const float*)d_in[7];
    p.w_out = (const float*)d_in[8]; p.ln1_g = (const float*)d_in[9]; p.ln1_b = (const float*)d_in[10]; p.wq = (const float*)d_in[11];
    p.k1 = (const float*)d_in[12]; p.k2 = (const float*)d_in[13]; p.pu = (const float*)d_in[14]; p.pv = (const float*)d_in[15];
    p.ln2_g = (const float*)d_in[16]; p.ln2_b = (const float*)d_in[17];
    p.out = (float*)d_out; p.ws = (unsigned char*)d_ws;
    void* args[] = {&p};
    hipError_t e = hipLaunchCooperativeKernel((const void*)mega, dim3(grid), dim3(NT), args, LDS_BYTES, stream);
    if (e != hipSuccess) fprintf(stderr, "kernel_launch: cooperative launch failed: %s (grid %d)\n", hipGetErrorString(e), grid);
}
```

```cpp
#include <hip/hip_runtime.h>
#include <hip/hip_cooperative_groups.h>
#include <cstdio>
#include <cstdint>
namespace cg = cooperative_groups;

namespace pg8 {
#define PG8_LAS __attribute__((address_space(3)))
typedef unsigned short bf16_t;
typedef short bf16x8 __attribute__((ext_vector_type(8)));
typedef float f32x4 __attribute__((ext_vector_type(4)));
typedef unsigned u32x4 __attribute__((ext_vector_type(4)));
constexpr int BM = 256, BK = 64, HALF = 128, HTB = HALF * BK * 2  , STAGE_BYTES = 8 * HTB, NXCD = 8, WGM = 8;

__host__ __device__ __forceinline__ int lds_byte(int r, int c) { const int st = (r >> 4) * 2 + (c >> 5), rr = r & 15, cc = c & 31, ob = rr * 64 + cc * 2; return st * 1024 + (ob ^ (((ob >> 9) & 1) << 5)); }
__host__ __device__ __forceinline__ void stage_rc(int b, int& R, int& C) { const int st = b / 1024, sb = b % 1024, swz = sb ^ (((sb >> 9) & 1) << 5); R = (st >> 1) * 16 + swz / 64; C = (st & 1) * 32 + (swz % 64) / 2; }
__host__ __device__ __forceinline__ int perm32(int rho) { const int n = rho >> 4, i = rho & 15; return 8 * (i >> 2) + 4 * n + (i & 3); }

struct Unit { int pm, pn; };
struct Gemm { const bf16_t* A; const bf16_t* Bt; int M, N, K; };

struct StaticOrder {
    int nM, nN, nwg, G, c;
    __host__ __device__ void init(int M, int N, int G_, int c_) { nM = M / BM; nN = N / BM; nwg = nM * nN; G = G_; c = c_; }
    __host__ __device__ bool next(int i, Unit& u) const {
        const long L = (long)i * G + c; if (L >= nwg) return false;
        int wgid = (int)L; { const int q = nwg / NXCD, r = nwg % NXCD, xcd = wgid % NXCD, off = wgid / NXCD; wgid = (xcd < r ? xcd * (q + 1) : r * (q + 1) + (xcd - r) * q) + off; }
        const int nig = WGM * nN, gid = wgid / nig, fm = gid * WGM, gsz = (nM - fm) < WGM ? (nM - fm) : WGM;
        u.pm = fm + ((wgid % nig) % gsz); u.pn = (wgid % nig) / gsz; return true;
    }
    __device__ __forceinline__ void a_ready(const Unit&) const {}
    __device__ __forceinline__ void done(const Unit&) const {}
};
__device__ __forceinline__ unsigned cvt_pk_bf16(float lo, float hi) { unsigned r; asm volatile("v_cvt_pk_bf16_f32 %0, %1, %2" : "=v"(r) : "v"(lo), "v"(hi)); return r; }
template <class Epi, class Sched, bool ALIGN_EPI = false, bool SP2 = false>
__device__ __forceinline__ void gemm_phase(PG8_LAS unsigned char* lds, const Gemm g, const Sched& S, const Epi& E) {
    const int tid = threadIdx.x, wid = __builtin_amdgcn_readfirstlane(tid >> 6), lane = tid & 63, wr = wid >> 2, wc = wid & 3, fr = lane & 15, fq = lane >> 4;
    const int K = g.K, nt = K / BK;
    unsigned voffA[2], voffB[2];
#pragma unroll
    for (int i = 0; i < 2; ++i) { int R, C; stage_rc(tid * 16 + i * 8192, R, C); const int Rb = Epi::PERM ? ((R & ~31) + perm32(R & 31)) : R;
        voffA[i] = (unsigned)(R * K + C) * 2u; voffB[i] = (unsigned)(Rb * K + C) * 2u; }
    const size_t kstep = (size_t)(BK * 2);
    const size_t hstep = (size_t)HALF * K * 2;
    const size_t tstep = 2 * hstep;
    const unsigned ldsw = (unsigned)wid * 1024u;
    const int aoff = lds_byte(wr * 64 + fr, fq * 8), boff = lds_byte(wc * 32 + fr, fq * 8);
#define PG8_SA(b, h) (((b) * 2 + (h)) * HTB)
#define PG8_SB(b, h) ((4 + (b) * 2 + (h)) * HTB)
#define PG8_STAGE(bufoff, gbase, voff) do { _Pragma("unroll") for (int _i = 0; _i < 2; ++_i) \
        __builtin_amdgcn_global_load_lds((const unsigned*)((const char*)(gbase) + (voff)[_i]), (PG8_LAS unsigned*)(lds + (bufoff) + ldsw + _i * 8192), 16, 0, 0); } while (0)
#define PG8_LDA(dst, b, h) do { _Pragma("unroll") for (int m = 0; m < 4; ++m) _Pragma("unroll") for (int k = 0; k < 2; ++k) dst[m][k] = *(const PG8_LAS bf16x8*)(lds + PG8_SA(b, h) + aoff + m * 2048 + k * 1024); } while (0)
#define PG8_LDB(dst, b, h) do { _Pragma("unroll") for (int n = 0; n < 2; ++n) _Pragma("unroll") for (int k = 0; k < 2; ++k) dst[n][k] = *(const PG8_LAS bf16x8*)(lds + PG8_SB(b, h) + boff + n * 2048 + k * 1024); } while (0)
#define PG8_MMA(ai, bj, At, Bt) do { __builtin_amdgcn_s_setprio(1); _Pragma("unroll") for (int m = 0; m < 4; ++m) _Pragma("unroll") for (int n = 0; n < 2; ++n) _Pragma("unroll") for (int k = 0; k < 2; ++k) \
        acc[ai][bj][m][n] = __builtin_amdgcn_mfma_f32_16x16x32_bf16(Bt[n][k], At[m][k], acc[ai][bj][m][n], 0, 0, 0); __builtin_amdgcn_s_setprio(0); } while (0)
#define PG8_WAIT_V(n) asm volatile("s_waitcnt vmcnt(" #n ")" ::: "memory")
#define PG8_WAIT_L(n) asm volatile("s_waitcnt lgkmcnt(" #n ")" ::: "memory")
#define PG8_BAR __builtin_amdgcn_s_barrier()
#define PG8_SCHED __builtin_amdgcn_sched_barrier(0)
    Unit cur, nxt; int ui = 0;
    if (!S.next(0, cur)) return;
    f32x4 acc[2][2][4][2];
#pragma unroll
    for (int a = 0; a < 2; ++a)
#pragma unroll
        for (int b = 0; b < 2; ++b)
#pragma unroll
            for (int m = 0; m < 4; ++m)
#pragma unroll
                for (int n = 0; n < 2; ++n) acc[a][b][m][n] = (f32x4){0.f, 0.f, 0.f, 0.f};
    bf16x8 At[4][2], B0[2][2], B1[2][2];
    const char* cA = (const char*)g.A + (size_t)cur.pm * tstep; const char* cB = (const char*)g.Bt + (size_t)cur.pn * tstep;
    S.a_ready(cur);
    if constexpr (SP2) {
        PG8_STAGE(PG8_SB(0, 0), cB, voffB); PG8_STAGE(PG8_SB(0, 1), cB + hstep, voffB); PG8_STAGE(PG8_SA(0, 0), cA, voffA); PG8_STAGE(PG8_SA(0, 1), cA + hstep, voffA);
        if (wr == 1) PG8_BAR;
        PG8_WAIT_V(2); PG8_BAR;
        PG8_STAGE(PG8_SB(1, 0), cB + kstep, voffB); PG8_STAGE(PG8_SA(1, 0), cA + kstep, voffA); PG8_STAGE(PG8_SB(1, 1), cB + hstep + kstep, voffB);
        PG8_WAIT_V(6); PG8_BAR;
    } else {
        PG8_STAGE(PG8_SB(0, 0), cB, voffB); PG8_STAGE(PG8_SA(0, 0), cA, voffA); PG8_STAGE(PG8_SB(0, 1), cB + hstep, voffB); PG8_STAGE(PG8_SA(0, 1), cA + hstep, voffA);
        if (wr == 1) PG8_BAR;
        PG8_WAIT_V(4); PG8_BAR;
        PG8_STAGE(PG8_SB(1, 0), cB + kstep, voffB); PG8_STAGE(PG8_SA(1, 0), cA + kstep, voffA); PG8_STAGE(PG8_SB(1, 1), cB + hstep + kstep, voffB);
        PG8_WAIT_V(6); PG8_BAR;
    }
    for (;;) {
        const bool has_next = S.next(ui + 1, nxt);
        const char* nA = has_next ? (const char*)g.A + (size_t)nxt.pm * tstep : cA; const char* nB = has_next ? (const char*)g.Bt + (size_t)nxt.pn * tstep : cB;
        for (int t = 0; t < nt; t += 2) {
            const bool last = (t == nt - 2);
            const char* a1 = cA + (size_t)(t + 1) * kstep;
            const char* a2 = last ? nA : cA + (size_t)(t + 2) * kstep; const char* b2 = last ? nB : cB + (size_t)(t + 2) * kstep;
            const char* a3 = a2 + kstep; const char* b3 = b2 + kstep;
            if (last && has_next) S.a_ready(nxt);
            if constexpr (SP2) {
            PG8_LDB(B0, 0, 0); PG8_LDB(B1, 0, 1); PG8_SCHED; PG8_LDA(At, 0, 0); PG8_STAGE(PG8_SA(1, 1), a1 + hstep, voffA);
            PG8_WAIT_V(8); PG8_WAIT_L(0); PG8_BAR; PG8_MMA(0, 0, At, B0); PG8_MMA(0, 1, At, B1); PG8_BAR; PG8_SCHED;
            PG8_LDA(At, 0, 1); PG8_STAGE(PG8_SB(0, 0), b2, voffB); PG8_STAGE(PG8_SB(0, 1), b2 + hstep, voffB); PG8_STAGE(PG8_SA(0, 0), a2, voffA);
            PG8_WAIT_V(8); PG8_WAIT_L(0); PG8_BAR; PG8_MMA(1, 0, At, B0); PG8_MMA(1, 1, At, B1); PG8_BAR; PG8_SCHED;
            PG8_LDB(B0, 1, 0); PG8_LDB(B1, 1, 1); PG8_SCHED; PG8_LDA(At, 1, 0); PG8_STAGE(PG8_SA(0, 1), a2 + hstep, voffA);
            PG8_WAIT_V(8); PG8_WAIT_L(0); PG8_BAR; PG8_MMA(0, 0, At, B0); PG8_MMA(0, 1, At, B1); PG8_BAR; PG8_SCHED;
            PG8_LDA(At, 1, 1); PG8_STAGE(PG8_SB(1, 0), b3, voffB); PG8_STAGE(PG8_SB(1, 1), b3 + hstep, voffB); PG8_STAGE(PG8_SA(1, 0), a3, voffA);
            PG8_WAIT_V(8); PG8_WAIT_L(0); PG8_BAR; PG8_MMA(1, 0, At, B0); PG8_MMA(1, 1, At, B1); PG8_BAR; PG8_SCHED;
            } else {
            PG8_LDB(B0, 0, 0); PG8_SCHED; PG8_LDA(At, 0, 0); PG8_STAGE(PG8_SA(1, 1), a1 + hstep, voffA);
            PG8_WAIT_L(8); PG8_BAR; PG8_WAIT_L(0); PG8_MMA(0, 0, At, B0); PG8_BAR; PG8_SCHED;
            PG8_LDB(B1, 0, 1); PG8_STAGE(PG8_SB(0, 0), b2, voffB);
            PG8_BAR; PG8_WAIT_L(0); PG8_MMA(0, 1, At, B1); PG8_BAR;
            PG8_LDA(At, 0, 1); PG8_STAGE(PG8_SA(0, 0), a2, voffA);
            PG8_BAR; PG8_WAIT_L(0); PG8_MMA(1, 0, At, B0); PG8_BAR; PG8_SCHED;
            PG8_STAGE(PG8_SB(0, 1), b2 + hstep, voffB);
            PG8_WAIT_V(6); PG8_BAR; PG8_MMA(1, 1, At, B1); PG8_BAR;
            PG8_LDB(B0, 1, 0); PG8_SCHED; PG8_LDA(At, 1, 0); PG8_STAGE(PG8_SA(0, 1), a2 + hstep, voffA);
            PG8_WAIT_L(8); PG8_BAR; PG8_WAIT_L(0); PG8_MMA(0, 0, At, B0); PG8_BAR; PG8_SCHED;
            PG8_LDB(B1, 1, 1); PG8_STAGE(PG8_SB(1, 0), b3, voffB);
            PG8_BAR; PG8_WAIT_L(0); PG8_MMA(0, 1, At, B1); PG8_BAR;
            PG8_LDA(At, 1, 1); PG8_STAGE(PG8_SA(1, 0), a3, voffA);
            PG8_BAR; PG8_WAIT_L(0); PG8_MMA(1, 0, At, B0); PG8_BAR; PG8_SCHED;
            PG8_STAGE(PG8_SB(1, 1), b3 + hstep, voffB);
            PG8_WAIT_V(6); PG8_BAR; PG8_MMA(1, 1, At, B1); PG8_BAR;
            }
        }
        if constexpr (ALIGN_EPI) { if (wr == 0) PG8_BAR; }
        if constexpr (!Epi::AFTER_DRAIN) { E(acc, cur, wr, wc, fr, fq); S.done(cur); }
        if (!has_next) break;
#pragma unroll
        for (int a = 0; a < 2; ++a)
#pragma unroll
            for (int b = 0; b < 2; ++b)
#pragma unroll
                for (int m = 0; m < 4; ++m)
#pragma unroll
                    for (int n = 0; n < 2; ++n) acc[a][b][m][n] = (f32x4){0.f, 0.f, 0.f, 0.f};
        cur = nxt; cA = nA; cB = nB; ++ui;
        if constexpr (ALIGN_EPI) { if (wr == 1) PG8_BAR; }
    }
    PG8_WAIT_V(0);
    if constexpr (!ALIGN_EPI) { if (wr == 0) PG8_BAR; }
    PG8_BAR;
    if constexpr (Epi::AFTER_DRAIN) { E.fused(acc, cur, wr, wc, fr, fq, lds, wid, lane); S.done(cur); }
#undef PG8_SA
#undef PG8_SB
#undef PG8_STAGE
#undef PG8_LDA
#undef PG8_LDB
#undef PG8_MMA
#undef PG8_WAIT_V
#undef PG8_WAIT_L
#undef PG8_BAR
#undef PG8_SCHED
}
}

constexpr int NT = 512, NWAVES = 8;
constexpr int LDS_BYTES = 147456;
constexpr int MTOK = 65536, DM = 1024, SEQ = 4096, NBATCH = 16;
constexpr int NPROJ = 3584;
constexpr int C_Q = 0, C_ZF = 512, C_ZB = 1024, C_I = 1536, C_G = 2048, C_U = 2560, C_V = 3072;
constexpr int NSC = 2048;
constexpr float ALPHA = 1.189207115002721f;
constexpr float LN_EPS = 1e-5f, RMS_EPS = 1e-6f;

constexpr size_t MiB = 1u << 20;
constexpr size_t WS_WIN = 1 * MiB;
constexpr size_t WS_WOUT = 8 * MiB;
constexpr size_t WS_WSC = 10 * MiB;
constexpr size_t WS_XB = 16 * MiB;
constexpr size_t WS_PROJ = 144 * MiB;
constexpr size_t WS_Y = 592 * MiB;
constexpr size_t WS_OF = 720 * MiB;
constexpr size_t WS_OB = 848 * MiB;
constexpr size_t WS_SC = 144 * MiB;
constexpr size_t WS_EID = 720 * MiB;
constexpr size_t WS_GATE = 752 * MiB;
constexpr size_t WS_END = 976 * MiB;

typedef unsigned short bf16;
typedef float f32x4 __attribute__((ext_vector_type(4)));
typedef unsigned u32x4 __attribute__((ext_vector_type(4)));
#define LAS __attribute__((address_space(3)))

__device__ __forceinline__ unsigned f2bf(float f) { unsigned u = __float_as_uint(f); return (u + 0x7fffu + ((u >> 16) & 1u)) >> 16; }
__device__ __forceinline__ unsigned pk2(float lo, float hi) { return f2bf(lo) | (f2bf(hi) << 16); }
__device__ __forceinline__ float bflo(unsigned w) { return __uint_as_float(w << 16); }
__device__ __forceinline__ float bfhi(unsigned w) { return __uint_as_float(w & 0xffff0000u); }
__device__ __forceinline__ float sigmoidf_(float z) { return 1.0f / (1.0f + __expf(-z)); }
__device__ __forceinline__ float gelu_tanh(float x) { return x / (1.0f + __expf(-1.5957691216057308f * (x + 0.044715f * x * x * x))); }
__device__ __forceinline__ float silu_(float x) { return x / (1.0f + __expf(-x)); }
__device__ __forceinline__ float wave_sum(float v) {
#pragma unroll
    for (int o = 1; o < 64; o <<= 1) v += __shfl_xor(v, o);
    return v;
}

struct Params {
    const float *x, *w_in, *lb_logits, *hg_norm_g, *gm_ln_g, *gm_ln_b, *gm_ws, *gm_bs, *w_out, *ln1_g, *ln1_b, *wq, *k1, *k2, *pu, *pv, *ln2_g, *ln2_b;
    float* out; unsigned char* ws;
};

namespace pg8 {
struct EpiProj {
    static constexpr bool PERM = true, AFTER_DRAIN = false;
    bf16* O;
    __device__ __forceinline__ void operator()(const f32x4 (&acc)[2][2][4][2], const Unit& u, int wr, int wc, int fr, int fq) const {
        const int row0 = u.pm * BM + wr * 64 + fr, col0 = u.pn * BM + wc * 32 + 8 * fq;
        const int act = u.pn >= 10 ? 2 : (u.pn >= 8 ? 1 : 0);
#pragma unroll
        for (int ai = 0; ai < 2; ++ai)
#pragma unroll
            for (int m = 0; m < 4; ++m) { bf16* rowp = O + (size_t)(row0 + ai * HALF + m * 16) * NPROJ + col0;
#pragma unroll
                for (int bj = 0; bj < 2; ++bj) { f32x4 v0 = acc[ai][bj][m][0], v1 = acc[ai][bj][m][1];
                    if (act == 2) {
#pragma unroll
                        for (int j = 0; j < 4; ++j) { v0[j] = gelu_tanh(v0[j]); v1[j] = gelu_tanh(v1[j]); } }
                    else if (act == 1) {
#pragma unroll
                        for (int j = 0; j < 4; ++j) { v0[j] = silu_(v0[j]); v1[j] = silu_(v1[j]); } }
                    u32x4 w; w.x = cvt_pk_bf16(v0[0], v0[1]); w.y = cvt_pk_bf16(v0[2], v0[3]); w.z = cvt_pk_bf16(v1[0], v1[1]); w.w = cvt_pk_bf16(v1[2], v1[3]);
                    *(u32x4*)(rowp + bj * HALF) = w; } }
    }
};
struct EpiPre {
    static constexpr bool PERM = false, AFTER_DRAIN = false;
    const float* X; float* P;
    __device__ __forceinline__ void operator()(const f32x4 (&acc)[2][2][4][2], const Unit& u, int wr, int wc, int fr, int fq) const {
        const int row0 = u.pm * BM + wr * 64 + fr, col0 = u.pn * BM + wc * 32 + 4 * fq;
#pragma unroll
        for (int ai = 0; ai < 2; ++ai)
#pragma unroll
            for (int m = 0; m < 4; ++m) { const size_t off = (size_t)(row0 + ai * HALF + m * 16) * DM + col0;
#pragma unroll
                for (int bj = 0; bj < 2; ++bj)
#pragma unroll
                    for (int n = 0; n < 2; ++n) { const f32x4 xv = *(const f32x4*)(X + off + bj * HALF + n * 16);
                        *(f32x4*)(P + off + bj * HALF + n * 16) = xv * ALPHA + acc[ai][bj][m][n]; } }
    }
};
struct EpiF32 {
    static constexpr bool PERM = false, AFTER_DRAIN = false;
    float* C; int ldc;
    __device__ __forceinline__ void operator()(const f32x4 (&acc)[2][2][4][2], const Unit& u, int wr, int wc, int fr, int fq) const {
        const int row0 = u.pm * BM + wr * 64 + fr, col0 = u.pn * BM + wc * 32 + 4 * fq;
#pragma unroll
        for (int ai = 0; ai < 2; ++ai)
#pragma unroll
            for (int m = 0; m < 4; ++m) { float* rowp = C + (size_t)(row0 + ai * HALF + m * 16) * ldc + col0;
#pragma unroll
                for (int bj = 0; bj < 2; ++bj)
#pragma unroll
                    for (int n = 0; n < 2; ++n) *(f32x4*)(rowp + bj * HALF + n * 16) = acc[ai][bj][m][n]; }
    }
};
}

__device__ __forceinline__ void p0_transpose_item(const float* W, int K, int N, bf16* WT, LAS float* scr, int item, int lane) {
    const int nblk = N / 32, kb = item / nblk, nb = item % nblk, k0 = 64 * kb, n0 = 32 * nb;
#pragma unroll 8
    for (int i = 0; i < 32; ++i) { const int kk = 2 * i + (lane >> 5); scr[kk * 33 + (lane & 31)] = W[(size_t)(k0 + kk) * N + n0 + (lane & 31)]; }
    asm volatile("s_waitcnt lgkmcnt(0)" ::: "memory");
    const int c = lane & 7;
#pragma unroll
    for (int j = 0; j < 4; ++j) { const int n = (lane >> 3) + 8 * j; const LAS float* s = scr + (8 * c) * 33 + n;
        u32x4 o; o.x = pk2(s[0 * 33], s[1 * 33]); o.y = pk2(s[2 * 33], s[3 * 33]); o.z = pk2(s[4 * 33], s[5 * 33]); o.w = pk2(s[6 * 33], s[7 * 33]);
        *(u32x4*)(WT + (size_t)(n0 + n) * K + k0 + 8 * c) = o; }
    asm volatile("s_waitcnt lgkmcnt(0)" ::: "memory");
}

__device__ __forceinline__ void phase0(const Params& p, unsigned char* lds_g) {
    const int tid = threadIdx.x, lane = tid & 63, wave = tid >> 6;
    unsigned char* ws = p.ws;
    {
        const size_t n8 = (size_t)MTOK * DM / 8, gsz = (size_t)gridDim.x * NT;
        const f32x4* x4 = (const f32x4*)p.x; u32x4* o = (u32x4*)(ws + WS_XB);
        for (size_t i = (size_t)blockIdx.x * NT + tid; i < n8; i += gsz) { const f32x4 a = x4[2 * i], b = x4[2 * i + 1];
            u32x4 w; w.x = pk2(a[0], a[1]); w.y = pk2(a[2], a[3]); w.z = pk2(b[0], b[1]); w.w = pk2(b[2], b[3]); o[i] = w; }
    }
    {
        LAS float* scr = (LAS float*)(lds_g + wave * 16384);
        const int gw = blockIdx.x * NWAVES + wave, NGW = gridDim.x * NWAVES;
        constexpr int I_IN = (DM / 64) * (NPROJ / 32), I_OUT = (DM / 64) * (DM / 32);
        for (int it = gw; it < I_IN + I_OUT; it += NGW) {
            if (it < I_IN) p0_transpose_item(p.w_in, DM, NPROJ, (bf16*)(ws + WS_WIN), scr, it, lane);
            else p0_transpose_item(p.w_out, DM, DM, (bf16*)(ws + WS_WOUT), scr, it - I_IN, lane);
        }
    }
    __syncthreads();
    {
        float* Ks = (float*)lds_g;
        float* Ws = (float*)(lds_g + 128 * 132 * 4);
        bf16* WscT = (bf16*)(ws + WS_WSC);
        for (int it = blockIdx.x; it < 256; it += gridDim.x) {
            const int combo = it >> 4, dt = it & 15, h = combo >> 1, half = combo & 1, d0 = dt * 64;
            const float* kp = (half ? p.k2 : p.k1) + (size_t)h * 128 * 128;
            for (int i = tid; i < 128 * 128; i += NT) Ks[(i >> 7) * 132 + (i & 127)] = kp[i];
            for (int i = tid; i < 64 * 128; i += NT) Ws[i] = p.wq[(size_t)(d0 + (i >> 7)) * 2048 + h * 256 + half * 128 + (i & 127)];
            __syncthreads();
            const int key = tid & 127, dg = tid >> 7;
            float acc[16];
#pragma unroll
            for (int i = 0; i < 16; ++i) acc[i] = 0.f;
            for (int j = 0; j < 128; j += 4) {
                const f32x4 kv = *(const f32x4*)(Ks + key * 132 + j);
#pragma unroll
                for (int i = 0; i < 16; ++i) { const f32x4 wv = *(const f32x4*)(Ws + (dg * 16 + i) * 128 + j);
                    acc[i] += kv[0] * wv[0] + kv[1] * wv[1] + kv[2] * wv[2] + kv[3] * wv[3]; }
            }
            bf16* orow = WscT + (size_t)(h * 256 + half * 128 + key) * DM + d0 + dg * 16;
            u32x4 w0, w1; w0.x = pk2(acc[0], acc[1]); w0.y = pk2(acc[2], acc[3]); w0.z = pk2(acc[4], acc[5]); w0.w = pk2(acc[6], acc[7]);
            w1.x = pk2(acc[8], acc[9]); w1.y = pk2(acc[10], acc[11]); w1.z = pk2(acc[12], acc[13]); w1.w = pk2(acc[14], acc[15]);
            *(u32x4*)orow = w0; *(u32x4*)(orow + 8) = w1;
            __syncthreads();
        }
    }
}

__device__ __forceinline__ void hgrn_naive_item(const Params& p, unsigned char* lds_g, int item) {
    const int tid = threadIdx.x, lane = tid & 63, wave = tid >> 6;
    const int b = item >> 3, h = (item >> 1) & 3, dir = item & 1;
    float* F = (float*)lds_g; float* Kk = F + 64 * 128; float* Q = Kk + 64 * 128; float* V = Q + 64 * 128;
    const bf16* proj = (const bf16*)(p.ws + WS_PROJ);
    float* O = (float*)(p.ws + (dir ? WS_OB : WS_OF));
    const int ts = tid >> 3, dg = tid & 7;
    float lb[16];
#pragma unroll
    for (int i = 0; i < 16; ++i) { const int c = h * 128 + dg * 16 + i; const float l0 = p.lb_logits[(dir * 2 + 0) * 512 + c], l1 = p.lb_logits[(dir * 2 + 1) * 512 + c]; lb[i] = 1.0f / (1.0f + __expf(l1 - l0)); }
    const int e = wave * 16 + (lane >> 2), dq = lane & 3;
    float S[32];
#pragma unroll
    for (int i = 0; i < 32; ++i) S[i] = 0.f;
    for (int c = 0; c < SEQ / 64; ++c) {
        {
            const int s = c * 64 + ts, t = dir ? (SEQ - 1 - s) : s; const size_t row = (size_t)b * SEQ + t;
            const bf16* pr = proj + row * NPROJ;
            const u32x4 z0 = *(const u32x4*)(pr + (dir ? C_ZB : C_ZF) + h * 128 + dg * 16), z1 = *(const u32x4*)(pr + (dir ? C_ZB : C_ZF) + h * 128 + dg * 16 + 8);
            const u32x4 q0 = *(const u32x4*)(pr + C_Q + h * 128 + dg * 16), q1 = *(const u32x4*)(pr + C_Q + h * 128 + dg * 16 + 8);
            const u32x4 i0 = *(const u32x4*)(pr + C_I + h * 128 + dg * 16), i1 = *(const u32x4*)(pr + C_I + h * 128 + dg * 16 + 8);
            const unsigned zw[8] = {z0.x, z0.y, z0.z, z0.w, z1.x, z1.y, z1.z, z1.w};
            const unsigned qw[8] = {q0.x, q0.y, q0.z, q0.w, q1.x, q1.y, q1.z, q1.w};
            const unsigned iw[8] = {i0.x, i0.y, i0.z, i0.w, i1.x, i1.y, i1.z, i1.w};
            const int base = ts * 128 + dg * 16;
#pragma unroll
            for (int j = 0; j < 8; ++j) {
                const float za = bflo(zw[j]), zb = bfhi(zw[j]);
                const float sa = sigmoidf_(za), sb = sigmoidf_(zb);
                F[base + 2 * j] = lb[2 * j] + (1.0f - lb[2 * j]) * sa; F[base + 2 * j + 1] = lb[2 * j + 1] + (1.0f - lb[2 * j + 1]) * sb;
                Kk[base + 2 * j] = (1.0f - lb[2 * j]) * (1.0f - sa); Kk[base + 2 * j + 1] = (1.0f - lb[2 * j + 1]) * (1.0f - sb);
                Q[base + 2 * j] = bflo(qw[j]); Q[base + 2 * j + 1] = bfhi(qw[j]);
                V[base + 2 * j] = bflo(iw[j]); V[base + 2 * j + 1] = bfhi(iw[j]);
            }
        }
        __syncthreads();
        for (int s2 = 0; s2 < 64; ++s2) {
            const float v = V[s2 * 128 + e];
            float o = 0.f;
            const float* fp = F + s2 * 128 + dq * 32; const float* kp = Kk + s2 * 128 + dq * 32; const float* qp = Q + s2 * 128 + dq * 32;
#pragma unroll
            for (int i = 0; i < 32; i += 4) {
                const f32x4 fv = *(const f32x4*)(fp + i), kv = *(const f32x4*)(kp + i), qv = *(const f32x4*)(qp + i);
#pragma unroll
                for (int j = 0; j < 4; ++j) { S[i + j] = fv[j] * S[i + j] + kv[j] * v; o += S[i + j] * qv[j]; }
            }
            o += __shfl_xor(o, 1); o += __shfl_xor(o, 2);
            if (dq == 0) { const int s = c * 64 + s2, t = dir ? (SEQ - 1 - s) : s; O[((size_t)b * SEQ + t) * 512 + h * 128 + e] = o; }
        }
        __syncthreads();
    }
}

__device__ __forceinline__ void gmlp_naive_item(const Params& p, unsigned char* lds_g, int item) {
    const int tid = threadIdx.x, lane = tid & 63, wave = tid >> 6;
    const int g = item & 3, n = (item >> 2) & 31, b = item >> 7;
    float* Wt = (float*)lds_g;
    float* vc = Wt + 128 * 132;
    const bf16* proj = (const bf16*)(p.ws + WS_PROJ);
    bf16* Y = (bf16*)(p.ws + WS_Y);
    const float* Wg = p.gm_ws + (size_t)g * 128 * 128;
    for (int i = tid; i < 128 * 128; i += NT) { const int pp = i >> 7, q = i & 127; Wt[q * 132 + pp] = Wg[i]; }
    const size_t row0 = (size_t)b * SEQ + n * 128;
    for (int pos = wave * 16; pos < wave * 16 + 16; ++pos) {
        const unsigned w = *(const unsigned*)(proj + (row0 + pos) * NPROJ + C_V + g * 128 + lane * 2);
        const float a = bflo(w), c = bfhi(w);
        const float mu = wave_sum(a + c) * (1.0f / 128.0f);
        const float da = a - mu, dc = c - mu;
        const float var = wave_sum(da * da + dc * dc) * (1.0f / 128.0f);
        const float rstd = 1.0f / sqrtf(var + LN_EPS);
        vc[pos * 128 + lane * 2] = da * rstd * p.gm_ln_g[g * 128 + lane * 2] + p.gm_ln_b[g * 128 + lane * 2];
        vc[pos * 128 + lane * 2 + 1] = dc * rstd * p.gm_ln_g[g * 128 + lane * 2 + 1] + p.gm_ln_b[g * 128 + lane * 2 + 1];
    }
    __syncthreads();
    const int c = tid & 127, pg = tid >> 7;
    float acc[32];
#pragma unroll
    for (int i = 0; i < 32; ++i) acc[i] = 0.f;
    for (int q = 0; q < 128; ++q) {
        const float xv = vc[q * 128 + c];
        const float* wp = Wt + q * 132 + pg * 32;
#pragma unroll
        for (int i = 0; i < 32; i += 4) { const f32x4 wv = *(const f32x4*)(wp + i);
#pragma unroll
            for (int j = 0; j < 4; ++j) acc[i + j] += wv[j] * xv; }
    }
#pragma unroll
    for (int i = 0; i < 32; ++i) { const int pp = pg * 32 + i; const size_t row = row0 + pp;
        const float uv = __uint_as_float(((unsigned)proj[row * NPROJ + C_U + g * 128 + c]) << 16);
        Y[row * DM + 512 + g * 128 + c] = (bf16)f2bf(uv * (acc[i] + p.gm_bs[g * 128 + pp])); }
    __syncthreads();
}

__device__ __forceinline__ void hgrn_finalize(const Params& p) {
    const int tid = threadIdx.x, lane = tid & 63, wave = tid >> 6;
    const float* OF = (const float*)(p.ws + WS_OF); const float* OB = (const float*)(p.ws + WS_OB);
    const bf16* proj = (const bf16*)(p.ws + WS_PROJ); bf16* Y = (bf16*)(p.ws + WS_Y);
    for (int t = blockIdx.x * NWAVES + wave; t < MTOK; t += gridDim.x * NWAVES) {
        const f32x4 a0 = *(const f32x4*)(OF + (size_t)t * 512 + lane * 8), a1 = *(const f32x4*)(OF + (size_t)t * 512 + lane * 8 + 4);
        const f32x4 b0 = *(const f32x4*)(OB + (size_t)t * 512 + lane * 8), b1 = *(const f32x4*)(OB + (size_t)t * 512 + lane * 8 + 4);
        const f32x4 o0 = a0 + b0, o1 = a1 + b1;
        float ss = o0[0] * o0[0] + o0[1] * o0[1] + o0[2] * o0[2] + o0[3] * o0[3] + o1[0] * o1[0] + o1[1] * o1[1] + o1[2] * o1[2] + o1[3] * o1[3];
        ss += __shfl_xor(ss, 1); ss += __shfl_xor(ss, 2); ss += __shfl_xor(ss, 4); ss += __shfl_xor(ss, 8);
        const float r = 1.0f / sqrtf(ss * (1.0f / 128.0f) + RMS_EPS);
        const u32x4 gw = *(const u32x4*)(proj + (size_t)t * NPROJ + C_G + lane * 8);
        const f32x4 n0 = *(const f32x4*)(p.hg_norm_g + lane * 8), n1 = *(const f32x4*)(p.hg_norm_g + lane * 8 + 4);
        u32x4 w;
        w.x = pk2(o0[0] * r * n0[0] * bflo(gw.x), o0[1] * r * n0[1] * bfhi(gw.x));
        w.y = pk2(o0[2] * r * n0[2] * bflo(gw.y), o0[3] * r * n0[3] * bfhi(gw.y));
        w.z = pk2(o1[0] * r * n1[0] * bflo(gw.z), o1[1] * r * n1[1] * bfhi(gw.z));
        w.w = pk2(o1[2] * r * n1[2] * bflo(gw.w), o1[3] * r * n1[3] * bfhi(gw.w));
        *(u32x4*)(Y + (size_t)t * DM + lane * 8) = w;
    }
}

__device__ __forceinline__ void ln1_pass(const Params& p) {
    const int tid = threadIdx.x, lane = tid & 63, wave = tid >> 6;
    bf16* H1B = (bf16*)(p.ws + WS_XB);
    for (int t = blockIdx.x * NWAVES + wave; t < MTOK; t += gridDim.x * NWAVES) {
        float* row = p.out + (size_t)t * DM;
        f32x4 v[4]; float s = 0.f;
#pragma unroll
        for (int j = 0; j < 4; ++j) { v[j] = *(const f32x4*)(row + j * 256 + lane * 4); s += (v[j][0] + v[j][1]) + (v[j][2] + v[j][3]); }
        const float mean = wave_sum(s) * (1.0f / DM); float s2 = 0.f;
#pragma unroll
        for (int j = 0; j < 4; ++j) { v[j] = v[j] - mean; s2 += (v[j][0] * v[j][0] + v[j][1] * v[j][1]) + (v[j][2] * v[j][2] + v[j][3] * v[j][3]); }
        const float rstd = 1.0f / sqrtf(wave_sum(s2) * (1.0f / DM) + LN_EPS);
#pragma unroll
        for (int j = 0; j < 4; ++j) { const f32x4 gg = *(const f32x4*)(p.ln1_g + j * 256 + lane * 4), bb = *(const f32x4*)(p.ln1_b + j * 256 + lane * 4);
            const f32x4 hv = v[j] * rstd * gg + bb;
            *(f32x4*)(row + j * 256 + lane * 4) = hv;
            unsigned long long w = (unsigned long long)pk2(hv[0], hv[1]) | ((unsigned long long)pk2(hv[2], hv[3]) << 32);
            *(unsigned long long*)(H1B + (size_t)t * DM + j * 256 + lane * 4) = w; }
    }
}

__device__ __forceinline__ unsigned mono_key(float f) { const unsigned u = __float_as_uint(f); return u ^ ((unsigned)((int)u >> 31) | 0x80000000u); }
__device__ __forceinline__ float mono_val(unsigned k) { return __uint_as_float(k ^ ((k >> 31) ? 0x80000000u : 0xFFFFFFFFu)); }
#define CE_DESC(a, b) do { const unsigned _mx = (a) > (b) ? (a) : (b), _mn = (a) > (b) ? (b) : (a); (a) = _mx; (b) = _mn; } while (0)
template <int N> __device__ __forceinline__ void bitonic_sort_desc(unsigned (&k)[N]) {
#pragma unroll
    for (int sz = 2; sz <= N; sz <<= 1)
#pragma unroll
        for (int j = sz >> 1; j > 0; j >>= 1)
#pragma unroll
            for (int i = 0; i < N; ++i) { const int l = i ^ j; if (l > i) { if ((i & sz) == 0) CE_DESC(k[i], k[l]); else CE_DESC(k[l], k[i]); } }
}
template <int N> __device__ __forceinline__ void bitonic_merge_desc(unsigned (&k)[N]) {
#pragma unroll
    for (int j = N >> 1; j > 0; j >>= 1)
#pragma unroll
        for (int i = 0; i < N; ++i) { const int l = i ^ j; if (l > i) CE_DESC(k[i], k[l]); }
}
__device__ __forceinline__ void top16_merge(unsigned (&a)[16], const unsigned (&b)[16]) {
#pragma unroll
    for (int i = 0; i < 16; ++i) a[i] = a[i] > b[15 - i] ? a[i] : b[15 - i];
    bitonic_merge_desc<16>(a);
}
template <int CTRL> __device__ __forceinline__ void top16_merge_dpp(unsigned (&a)[16]) {
    unsigned b[16];
#pragma unroll
    for (int i = 0; i < 16; ++i) b[i] = (unsigned)__builtin_amdgcn_mov_dpp((int)a[i], CTRL, 0xF, 0xF, true);
    top16_merge(a, b);
}
constexpr int TK_SEG = 1088;
constexpr int TK_SCR = 128 * TK_SEG;
__device__ __forceinline__ void topk_phase(const Params& p, unsigned char* lds_g) {
    const int tid = threadIdx.x, lane = tid & 63, wave = __builtin_amdgcn_readfirstlane(tid >> 6);
    const float* SC = (const float*)(p.ws + WS_SC);
    int* EID = (int*)(p.ws + WS_EID); float* GATE = (float*)(p.ws + WS_GATE);
    LAS unsigned char* lds = (LAS unsigned char*)lds_g;
    const int seg = tid >> 2, part = tid & 3;
    for (int bt = blockIdx.x; bt < MTOK / 16; bt += gridDim.x) {
        const float* src = SC + (size_t)bt * 16 * NSC;
#pragma unroll
        for (int i = 0; i < 16; ++i) { const int sg = wave * 16 + i;
            __builtin_amdgcn_global_load_lds((const unsigned*)(src + (size_t)sg * 256 + lane * 4), (LAS unsigned*)(lds + sg * TK_SEG), 16, 0, 0); }
        asm volatile("s_waitcnt vmcnt(0)" ::: "memory");
        __syncthreads();
        unsigned V[2][16];
#pragma unroll
        for (int hh = 0; hh < 2; ++hh) {
            unsigned ka[16], kb[16];
#pragma unroll
            for (int i = 0; i < 4; ++i) { const f32x4 v = *(const LAS f32x4*)(lds + seg * TK_SEG + hh * 512 + (4 * i + part) * 16);
#pragma unroll
                for (int j = 0; j < 4; ++j) ka[4 * i + j] = (mono_key(v[j]) & ~127u) | (unsigned)(127 - (16 * i + 4 * part + j)); }
#pragma unroll
            for (int i = 4; i < 8; ++i) { const f32x4 v = *(const LAS f32x4*)(lds + seg * TK_SEG + hh * 512 + (4 * i + part) * 16);
#pragma unroll
                for (int j = 0; j < 4; ++j) kb[4 * (i - 4) + j] = (mono_key(v[j]) & ~127u) | (unsigned)(127 - (16 * i + 4 * part + j)); }
            bitonic_sort_desc<16>(ka); bitonic_sort_desc<16>(kb);
            top16_merge(ka, kb);
            top16_merge_dpp<0xB1>(ka);
            top16_merge_dpp<0x4E>(ka);
#pragma unroll
            for (int i = 0; i < 16; ++i) V[hh][i] = ka[i];
        }
        LAS unsigned* scr = (LAS unsigned*)(lds + TK_SCR + seg * 32);
        if (part == 0) {
#pragma unroll
            for (int hh = 0; hh < 2; ++hh)
#pragma unroll
                for (int w = 0; w < 4; ++w) scr[hh * 4 + w] = (127u - (V[hh][4 * w] & 127u)) | ((127u - (V[hh][4 * w + 1] & 127u)) << 8) | ((127u - (V[hh][4 * w + 2] & 127u)) << 16) | ((127u - (V[hh][4 * w + 3] & 127u)) << 24);
        }
        float v1[16], v2[16];
#pragma unroll
        for (int i = 0; i < 16; ++i) { v1[i] = mono_val(V[0][i] & ~127u); v2[i] = mono_val(V[1][i] & ~127u); }
#define CKEY(a, b) ((mono_key(v1[a] + v2[b]) & ~255u) | (unsigned)(255 - (16 * (a) + (b))))
        unsigned g0[16], g1[16], g2[16], g3[16];
#pragma unroll
        for (int b = 0; b < 16; ++b) g0[b] = CKEY(0, b);
#pragma unroll
        for (int b = 0; b < 8; ++b) g1[b] = CKEY(1, b);
#pragma unroll
        for (int a = 8; a < 16; ++a) g1[8 + (15 - a)] = CKEY(a, 0);
        bitonic_merge_desc<16>(g1);
        g2[0] = CKEY(2, 0); g2[1] = CKEY(2, 1); g2[2] = CKEY(2, 2); g2[3] = CKEY(2, 3); g2[4] = CKEY(2, 4);
        g2[5] = CKEY(3, 0); g2[6] = CKEY(3, 1); g2[7] = CKEY(3, 2); g2[8] = CKEY(3, 3);
        g2[9] = CKEY(4, 0); g2[10] = CKEY(4, 1); g2[11] = CKEY(4, 2);
        g2[12] = CKEY(5, 0); g2[13] = CKEY(5, 1); g2[14] = CKEY(6, 0); g2[15] = CKEY(6, 1);
        bitonic_sort_desc<16>(g2);
        g3[0] = CKEY(7, 0); g3[1] = CKEY(7, 1);
#pragma unroll
        for (int i = 2; i < 16; ++i) g3[i] = 0u;
        top16_merge(g0, g1); top16_merge(g2, g3); top16_merge(g0, g2);
#undef CKEY
        const float mx = mono_val(g0[0] & ~255u);
        unsigned rk[4]; float ex[4]; float den = 0.f;
#pragma unroll
        for (int i = 0; i < 4; ++i) { rk[i] = part == 0 ? g0[4 * i] : (part == 1 ? g0[4 * i + 1] : (part == 2 ? g0[4 * i + 2] : g0[4 * i + 3]));
            ex[i] = __expf(mono_val(rk[i] & ~255u) - mx); den += ex[i]; }
        den += __builtin_bit_cast(float, __builtin_amdgcn_mov_dpp(__builtin_bit_cast(int, den), 0xB1, 0xF, 0xF, true));
        den += __builtin_bit_cast(float, __builtin_amdgcn_mov_dpp(__builtin_bit_cast(int, den), 0x4E, 0xF, 0xF, true));
        const float rden = 1.0f / den;
        asm volatile("s_waitcnt lgkmcnt(0)" ::: "memory");
        const LAS unsigned char* sb = (const LAS unsigned char*)scr;
        const int tl = seg >> 3, h = seg & 7; const size_t obase = (size_t)(bt * 16 + tl) * 128 + h * 16;
#pragma unroll
        for (int i = 0; i < 4; ++i) { const unsigned flat = 255u - (rk[i] & 255u); const int i1 = sb[flat >> 4], i2 = sb[16 + (flat & 15)];
            EID[obase + 4 * i + part] = i1 * 128 + i2; GATE[obase + 4 * i + part] = ex[i] * rden; }
        __syncthreads();
    }
}

__device__ __forceinline__ void peer_naive(const Params& p) {
    const int tid = threadIdx.x, lane = tid & 63, wave = tid >> 6;
    const int* EID = (const int*)(p.ws + WS_EID); const float* GATE = (const float*)(p.ws + WS_GATE);
    for (int t = blockIdx.x * NWAVES + wave; t < MTOK; t += gridDim.x * NWAVES) {
        float* row = p.out + (size_t)t * DM;
        f32x4 hv[4], acc[4];
#pragma unroll
        for (int j = 0; j < 4; ++j) { hv[j] = *(const f32x4*)(row + j * 256 + lane * 4); acc[j] = (f32x4){0.f, 0.f, 0.f, 0.f}; }
        const int e_lo = EID[(size_t)t * 128 + lane], e_hi = EID[(size_t)t * 128 + 64 + lane];
        const float g_lo = GATE[(size_t)t * 128 + lane], g_hi = GATE[(size_t)t * 128 + 64 + lane];
        for (int k = 0; k < 128; ++k) {
            const int e = __shfl(k < 64 ? e_lo : e_hi, k & 63); const float gt = __shfl(k < 64 ? g_lo : g_hi, k & 63);
            const float* ur = p.pu + (size_t)e * DM; const float* vr = p.pv + (size_t)e * DM;
            float d = 0.f;
#pragma unroll
            for (int j = 0; j < 4; ++j) { const f32x4 uv = *(const f32x4*)(ur + j * 256 + lane * 4); d += (hv[j][0] * uv[0] + hv[j][1] * uv[1]) + (hv[j][2] * uv[2] + hv[j][3] * uv[3]); }
            const float hid = wave_sum(d);
            const float a = gt * gelu_tanh(hid);
#pragma unroll
            for (int j = 0; j < 4; ++j) { const f32x4 vv = *(const f32x4*)(vr + j * 256 + lane * 4); acc[j] += vv * a; }
        }
        float s = 0.f;
#pragma unroll
        for (int j = 0; j < 4; ++j) { acc[j] = hv[j] * ALPHA + acc[j]; s += (acc[j][0] + acc[j][1]) + (acc[j][2] + acc[j][3]); }
        const float mean = wave_sum(s) * (1.0f / DM); float s2 = 0.f;
#pragma unroll
        for (int j = 0; j < 4; ++j) { acc[j] = acc[j] - mean; s2 += (acc[j][0] * acc[j][0] + acc[j][1] * acc[j][1]) + (acc[j][2] * acc[j][2] + acc[j][3] * acc[j][3]); }
        const float rstd = 1.0f / sqrtf(wave_sum(s2) * (1.0f / DM) + LN_EPS);
#pragma unroll
        for (int j = 0; j < 4; ++j) { const f32x4 gg = *(const f32x4*)(p.ln2_g + j * 256 + lane * 4), bb = *(const f32x4*)(p.ln2_b + j * 256 + lane * 4);
            *(f32x4*)(row + j * 256 + lane * 4) = acc[j] * rstd * gg + bb; }
    }
}

__global__ void __launch_bounds__(NT, 2) mega(Params p) {
    extern __shared__ __attribute__((aligned(16))) unsigned char lds[];
    cg::grid_group grid = cg::this_grid();
    unsigned char* ws = p.ws;
    const int G = gridDim.x;

    phase0(p, lds);
    grid.sync();

    {
        pg8::Gemm g{(const bf16*)(ws + WS_XB), (const bf16*)(ws + WS_WIN), MTOK, NPROJ, DM}; pg8::StaticOrder S; S.init(MTOK, NPROJ, G, (int)blockIdx.x);
        pg8::EpiProj E{(bf16*)(ws + WS_PROJ)};
        pg8::gemm_phase<pg8::EpiProj, pg8::StaticOrder, true, true>((PG8_LAS unsigned char*)lds, g, S, E);
    }
    grid.sync();

    {
        const int half = G / 2;
        if ((int)blockIdx.x < half) { for (int it = blockIdx.x; it < 128; it += half) hgrn_naive_item(p, lds, it); }
        else { for (int it = blockIdx.x - half; it < 2048; it += G - half) gmlp_naive_item(p, lds, it); }
    }
    grid.sync();
    hgrn_finalize(p);
    grid.sync();

    {
        pg8::Gemm g{(const bf16*)(ws + WS_Y), (const bf16*)(ws + WS_WOUT), MTOK, DM, DM}; pg8::StaticOrder S; S.init(MTOK, DM, G, (int)blockIdx.x);
        pg8::EpiPre E{p.x, p.out};
        pg8::gemm_phase<pg8::EpiPre, pg8::StaticOrder, true, true>((PG8_LAS unsigned char*)lds, g, S, E);
    }
    grid.sync();
    ln1_pass(p);
    grid.sync();

    {
        pg8::Gemm g{(const bf16*)(ws + WS_XB), (const bf16*)(ws + WS_WSC), MTOK, NSC, DM}; pg8::StaticOrder S; S.init(MTOK, NSC, G, (int)blockIdx.x);
        pg8::EpiF32 E{(float*)(ws + WS_SC), NSC};
        pg8::gemm_phase<pg8::EpiF32, pg8::StaticOrder, true, true>((PG8_LAS unsigned char*)lds, g, S, E);
    }
    grid.sync();
    topk_phase(p, lds);
    grid.sync();
    peer_naive(p);
}

extern "C" void kernel_launch(void* const* d_in, const int* in_sizes, int n_in, void* d_out, int out_size, void* d_ws, size_t ws_size, hipStream_t stream) {
    static int grid = 0;
    if (grid == 0) {
        if (n_in != 18 || in_sizes[0] != MTOK * DM || out_size != MTOK * DM || ws_size < WS_END) {
            fprintf(stderr, "kernel_launch: unexpected shapes (n_in %d, in0 %d, out %d, ws %zu); nothing launched\n", n_in, n_in > 0 ? in_sizes[0] : -1, out_size, ws_size); grid = -1; return; }
        int dev = 0, cus = 0, per_cu = 0;
        if (hipGetDevice(&dev) != hipSuccess || hipDeviceGetAttribute(&cus, hipDeviceAttributeMultiprocessorCount, dev) != hipSuccess) { grid = -1; return; }
        if (hipFuncSetAttribute((const void*)mega, hipFuncAttributeMaxDynamicSharedMemorySize, LDS_BYTES) != hipSuccess) { fprintf(stderr, "kernel_launch: hipFuncSetAttribute failed\n"); grid = -1; return; }
        if (hipOccupancyMaxActiveBlocksPerMultiprocessor(&per_cu, (const void*)mega, NT, LDS_BYTES) != hipSuccess || per_cu < 1) { fprintf(stderr, "kernel_launch: occupancy query says %d\n", per_cu); grid = -1; return; }
        grid = cus;
    }
    if (grid < 0) return;
    Params p{};
    p.x = (const float*)d_in[0]; p.w_in = (const float*)d_in[1]; p.lb_logits = (const float*)d_in[2]; p.hg_norm_g = (const float*)d_in[3];
    p.gm_ln_g = (const float*)d_in[4]; p.gm_ln_b = (const float*)d_in[5]; p.gm_ws = (const float*)d_in[6]; p.gm_bs = (const float*)d_in[7];
    p.w_out = (const float*)d_in[8]; p.ln1_g = (const float*)d_in[9]; p.ln1_b = (const float*)d_in[10]; p.wq = (const float*)d_in[11];
    p.k1 = (const float*)d_in[12]; p.k2 = (const float*)d_in[13]; p.pu = (const float*)d_in[14]; p.pv = (const float*)d_in[15];
    p.ln2_g = (const float*)d_in[16]; p.ln2_b = (const float*)d_in[17];
    p.out = (float*)d_out; p.ws = (unsigned char*)d_ws;
    void* args[] = {&p};
    hipError_t e = hipLaunchCooperativeKernel((const void*)mega, dim3(grid), dim3(NT), args, LDS_BYTES, stream);
    if (e != hipSuccess) fprintf(stderr, "kernel_launch: cooperative launch failed: %s (grid %d)\n", hipGetErrorString(e), grid);
}
```

```cpp
#include <hip/hip_runtime.h>
#include <hip/hip_cooperative_groups.h>
#include <cstdio>
#include <cstdint>
namespace cg = cooperative_groups;

namespace pg8 {
#define PG8_LAS __attribute__((address_space(3)))
typedef unsigned short bf16_t;
typedef short bf16x8 __attribute__((ext_vector_type(8)));
typedef float f32x4 __attribute__((ext_vector_type(4)));
typedef unsigned u32x4 __attribute__((ext_vector_type(4)));
constexpr int BM = 256, BK = 64, HALF = 128, HTB = HALF * BK * 2  , STAGE_BYTES = 8 * HTB, NXCD = 8, WGM = 8;

__host__ __device__ __forceinline__ int lds_byte(int r, int c) { const int st = (r >> 4) * 2 + (c >> 5), rr = r & 15, cc = c & 31, ob = rr * 64 + cc * 2; return st * 1024 + (ob ^ (((ob >> 9) & 1) << 5)); }
__host__ __device__ __forceinline__ void stage_rc(int b, int& R, int& C) { const int st = b / 1024, sb = b % 1024, swz = sb ^ (((sb >> 9) & 1) << 5); R = (st >> 1) * 16 + swz / 64; C = (st & 1) * 32 + (swz % 64) / 2; }
__host__ __device__ __forceinline__ int perm32(int rho) { const int n = rho >> 4, i = rho & 15; return 8 * (i >> 2) + 4 * n + (i & 3); }

struct Unit { int pm, pn; };
struct Gemm { const bf16_t* A; const bf16_t* Bt; int M, N, K; };

struct StaticOrder {
    int nM, nN, nwg, G, c;
    __host__ __device__ void init(int M, int N, int G_, int c_) { nM = M / BM; nN = N / BM; nwg = nM * nN; G = G_; c = c_; }
    __host__ __device__ bool next(int i, Unit& u) const {
        const long L = (long)i * G + c; if (L >= nwg) return false;
        int wgid = (int)L; { const int q = nwg / NXCD, r = nwg % NXCD, xcd = wgid % NXCD, off = wgid / NXCD; wgid = (xcd < r ? xcd * (q + 1) : r * (q + 1) + (xcd - r) * q) + off; }
        const int nig = WGM * nN, gid = wgid / nig, fm = gid * WGM, gsz = (nM - fm) < WGM ? (nM - fm) : WGM;
        u.pm = fm + ((wgid % nig) % gsz); u.pn = (wgid % nig) / gsz; return true;
    }
    __device__ __forceinline__ void a_ready(const Unit&) const {}
    __device__ __forceinline__ void done(const Unit&) const {}
};
__device__ __forceinline__ unsigned cvt_pk_bf16(float lo, float hi) { unsigned r; asm volatile("v_cvt_pk_bf16_f32 %0, %1, %2" : "=v"(r) : "v"(lo), "v"(hi)); return r; }
template <class Epi, class Sched, bool ALIGN_EPI = false, bool SP2 = false>
__device__ __forceinline__ void gemm_phase(PG8_LAS unsigned char* lds, const Gemm g, const Sched& S, const Epi& E) {
    const int tid = threadIdx.x, wid = __builtin_amdgcn_readfirstlane(tid >> 6), lane = tid & 63, wr = wid >> 2, wc = wid & 3, fr = lane & 15, fq = lane >> 4;
    const int K = g.K, nt = K / BK;
    unsigned voffA[2], voffB[2];
#pragma unroll
    for (int i = 0; i < 2; ++i) { int R, C; stage_rc(tid * 16 + i * 8192, R, C); const int Rb = Epi::PERM ? ((R & ~31) + perm32(R & 31)) : R;
        voffA[i] = (unsigned)(R * K + C) * 2u; voffB[i] = (unsigned)(Rb * K + C) * 2u; }
    const size_t kstep = (size_t)(BK * 2);
    const size_t hstep = (size_t)HALF * K * 2;
    const size_t tstep = 2 * hstep;
    const unsigned ldsw = (unsigned)wid * 1024u;
    const int aoff = lds_byte(wr * 64 + fr, fq * 8), boff = lds_byte(wc * 32 + fr, fq * 8);
#define PG8_SA(b, h) (((b) * 2 + (h)) * HTB)
#define PG8_SB(b, h) ((4 + (b) * 2 + (h)) * HTB)
#define PG8_STAGE(bufoff, gbase, voff) do { _Pragma("unroll") for (int _i = 0; _i < 2; ++_i) \
        __builtin_amdgcn_global_load_lds((const unsigned*)((const char*)(gbase) + (voff)[_i]), (PG8_LAS unsigned*)(lds + (bufoff) + ldsw + _i * 8192), 16, 0, 0); } while (0)
#define PG8_LDA(dst, b, h) do { _Pragma("unroll") for (int m = 0; m < 4; ++m) _Pragma("unroll") for (int k = 0; k < 2; ++k) dst[m][k] = *(const PG8_LAS bf16x8*)(lds + PG8_SA(b, h) + aoff + m * 2048 + k * 1024); } while (0)
#define PG8_LDB(dst, b, h) do { _Pragma("unroll") for (int n = 0; n < 2; ++n) _Pragma("unroll") for (int k = 0; k < 2; ++k) dst[n][k] = *(const PG8_LAS bf16x8*)(lds + PG8_SB(b, h) + boff + n * 2048 + k * 1024); } while (0)
#define PG8_MMA(ai, bj, At, Bt) do { __builtin_amdgcn_s_setprio(1); _Pragma("unroll") for (int m = 0; m < 4; ++m) _Pragma("unroll") for (int n = 0; n < 2; ++n) _Pragma("unroll") for (int k = 0; k < 2; ++k) \
        acc[ai][bj][m][n] = __builtin_amdgcn_mfma_f32_16x16x32_bf16(Bt[n][k], At[m][k], acc[ai][bj][m][n], 0, 0, 0); __builtin_amdgcn_s_setprio(0); } while (0)
#define PG8_WAIT_V(n) asm volatile("s_waitcnt vmcnt(" #n ")" ::: "memory")
#define PG8_WAIT_L(n) asm volatile("s_waitcnt lgkmcnt(" #n ")" ::: "memory")
#define PG8_BAR __builtin_amdgcn_s_barrier()
#define PG8_SCHED __builtin_amdgcn_sched_barrier(0)
    Unit cur, nxt; int ui = 0;
    if (!S.next(0, cur)) return;
    f32x4 acc[2][2][4][2];
#pragma unroll
    for (int a = 0; a < 2; ++a)
#pragma unroll
        for (int b = 0; b < 2; ++b)
#pragma unroll
            for (int m = 0; m < 4; ++m)
#pragma unroll
                for (int n = 0; n < 2; ++n) acc[a][b][m][n] = (f32x4){0.f, 0.f, 0.f, 0.f};
    bf16x8 At[4][2], B0[2][2], B1[2][2];
    const char* cA = (const char*)g.A + (size_t)cur.pm * tstep; const char* cB = (const char*)g.Bt + (size_t)cur.pn * tstep;
    S.a_ready(cur);
    if constexpr (SP2) {
        PG8_STAGE(PG8_SB(0, 0), cB, voffB); PG8_STAGE(PG8_SB(0, 1), cB + hstep, voffB); PG8_STAGE(PG8_SA(0, 0), cA, voffA); PG8_STAGE(PG8_SA(0, 1), cA + hstep, voffA);
        if (wr == 1) PG8_BAR;
        PG8_WAIT_V(2); PG8_BAR;
        PG8_STAGE(PG8_SB(1, 0), cB + kstep, voffB); PG8_STAGE(PG8_SA(1, 0), cA + kstep, voffA); PG8_STAGE(PG8_SB(1, 1), cB + hstep + kstep, voffB);
        PG8_WAIT_V(6); PG8_BAR;
    } else {
        PG8_STAGE(PG8_SB(0, 0), cB, voffB); PG8_STAGE(PG8_SA(0, 0), cA, voffA); PG8_STAGE(PG8_SB(0, 1), cB + hstep, voffB); PG8_STAGE(PG8_SA(0, 1), cA + hstep, voffA);
        if (wr == 1) PG8_BAR;
        PG8_WAIT_V(4); PG8_BAR;
        PG8_STAGE(PG8_SB(1, 0), cB + kstep, voffB); PG8_STAGE(PG8_SA(1, 0), cA + kstep, voffA); PG8_STAGE(PG8_SB(1, 1), cB + hstep + kstep, voffB);
        PG8_WAIT_V(6); PG8_BAR;
    }
    for (;;) {
        const bool has_next = S.next(ui + 1, nxt);
        const char* nA = has_next ? (const char*)g.A + (size_t)nxt.pm * tstep : cA; const char* nB = has_next ? (const char*)g.Bt + (size_t)nxt.pn * tstep : cB;
        for (int t = 0; t < nt; t += 2) {
            const bool last = (t == nt - 2);
            const char* a1 = cA + (size_t)(t + 1) * kstep;
            const char* a2 = last ? nA : cA + (size_t)(t + 2) * kstep; const char* b2 = last ? nB : cB + (size_t)(t + 2) * kstep;
            const char* a3 = a2 + kstep; const char* b3 = b2 + kstep;
            if (last && has_next) S.a_ready(nxt);
            if constexpr (SP2) {
            PG8_LDB(B0, 0, 0); PG8_LDB(B1, 0, 1); PG8_SCHED; PG8_LDA(At, 0, 0); PG8_STAGE(PG8_SA(1, 1), a1 + hstep, voffA);
            PG8_WAIT_V(8); PG8_WAIT_L(0); PG8_BAR; PG8_MMA(0, 0, At, B0); PG8_MMA(0, 1, At, B1); PG8_BAR; PG8_SCHED;
            PG8_LDA(At, 0, 1); PG8_STAGE(PG8_SB(0, 0), b2, voffB); PG8_STAGE(PG8_SB(0, 1), b2 + hstep, voffB); PG8_STAGE(PG8_SA(0, 0), a2, voffA);
            PG8_WAIT_V(8); PG8_WAIT_L(0); PG8_BAR; PG8_MMA(1, 0, At, B0); PG8_MMA(1, 1, At, B1); PG8_BAR; PG8_SCHED;
            PG8_LDB(B0, 1, 0); PG8_LDB(B1, 1, 1); PG8_SCHED; PG8_LDA(At, 1, 0); PG8_STAGE(PG8_SA(0, 1), a2 + hstep, voffA);
            PG8_WAIT_V(8); PG8_WAIT_L(0); PG8_BAR; PG8_MMA(0, 0, At, B0); PG8_MMA(0, 1, At, B1); PG8_BAR; PG8_SCHED;
            PG8_LDA(At, 1, 1); PG8_STAGE(PG8_SB(1, 0), b3, voffB); PG8_STAGE(PG8_SB(1, 1), b3 + hstep, voffB); PG8_STAGE(PG8_SA(1, 0), a3, voffA);
            PG8_WAIT_V(8); PG8_WAIT_L(0); PG8_BAR; PG8_MMA(1, 0, At, B0); PG8_MMA(1, 1, At, B1); PG8_BAR; PG8_SCHED;
            } else {
            PG8_LDB(B0, 0, 0); PG8_SCHED; PG8_LDA(At, 0, 0); PG8_STAGE(PG8_SA(1, 1), a1 + hstep, voffA);
            PG8_WAIT_L(8); PG8_BAR; PG8_WAIT_L(0); PG8_MMA(0, 0, At, B0); PG8_BAR; PG8_SCHED;
            PG8_LDB(B1, 0, 1); PG8_STAGE(PG8_SB(0, 0), b2, voffB);
            PG8_BAR; PG8_WAIT_L(0); PG8_MMA(0, 1, At, B1); PG8_BAR;
            PG8_LDA(At, 0, 1); PG8_STAGE(PG8_SA(0, 0), a2, voffA);
            PG8_BAR; PG8_WAIT_L(0); PG8_MMA(1, 0, At, B0); PG8_BAR; PG8_SCHED;
            PG8_STAGE(PG8_SB(0, 1), b2 + hstep, voffB);
            PG8_WAIT_V(6); PG8_BAR; PG8_MMA(1, 1, At, B1); PG8_BAR;
            PG8_LDB(B0, 1, 0); PG8_SCHED; PG8_LDA(At, 1, 0); PG8_STAGE(PG8_SA(0, 1), a2 + hstep, voffA);
            PG8_WAIT_L(8); PG8_BAR; PG8_WAIT_L(0); PG8_MMA(0, 0, At, B0); PG8_BAR; PG8_SCHED;
            PG8_LDB(B1, 1, 1); PG8_STAGE(PG8_SB(1, 0), b3, voffB);
            PG8_BAR; PG8_WAIT_L(0); PG8_MMA(0, 1, At, B1); PG8_BAR;
            PG8_LDA(At, 1, 1); PG8_STAGE(PG8_SA(1, 0), a3, voffA);
            PG8_BAR; PG8_WAIT_L(0); PG8_MMA(1, 0, At, B0); PG8_BAR; PG8_SCHED;
            PG8_STAGE(PG8_SB(1, 1), b3 + hstep, voffB);
            PG8_WAIT_V(6); PG8_BAR; PG8_MMA(1, 1, At, B1); PG8_BAR;
            }
        }
        if constexpr (ALIGN_EPI) { if (wr == 0) PG8_BAR; }
        if constexpr (!Epi::AFTER_DRAIN) { E(acc, cur, wr, wc, fr, fq); S.done(cur); }
        if (!has_next) break;
#pragma unroll
        for (int a = 0; a < 2; ++a)
#pragma unroll
            for (int b = 0; b < 2; ++b)
#pragma unroll
                for (int m = 0; m < 4; ++m)
#pragma unroll
                    for (int n = 0; n < 2; ++n) acc[a][b][m][n] = (f32x4){0.f, 0.f, 0.f, 0.f};
        cur = nxt; cA = nA; cB = nB; ++ui;
        if constexpr (ALIGN_EPI) { if (wr == 1) PG8_BAR; }
    }
    PG8_WAIT_V(0);
    if constexpr (!ALIGN_EPI) { if (wr == 0) PG8_BAR; }
    PG8_BAR;
    if constexpr (Epi::AFTER_DRAIN) { E.fused(acc, cur, wr, wc, fr, fq, lds, wid, lane); S.done(cur); }
#undef PG8_SA
#undef PG8_SB
#undef PG8_STAGE
#undef PG8_LDA
#undef PG8_LDB
#undef PG8_MMA
#undef PG8_WAIT_V
#undef PG8_WAIT_L
#undef PG8_BAR
#undef PG8_SCHED
}
}

constexpr int NT = 512, NWAVES = 8;
constexpr int LDS_BYTES = 147456;
constexpr int MTOK = 65536, DM = 1024, SEQ = 4096, NBATCH = 16;
constexpr int NPROJ = 3584;
constexpr int C_Q = 0, C_ZF = 512, C_ZB = 1024, C_I = 1536, C_G = 2048, C_U = 2560, C_V = 3072;
constexpr int NSC = 2048;
constexpr float ALPHA = 1.189207115002721f;
constexpr float LN_EPS = 1e-5f, RMS_EPS = 1e-6f;

constexpr size_t MiB = 1u << 20;
constexpr size_t WS_WIN = 1 * MiB;
constexpr size_t WS_WOUT = 8 * MiB;
constexpr size_t WS_WSC = 10 * MiB;
constexpr size_t WS_XB = 16 * MiB;
constexpr size_t WS_PROJ = 144 * MiB;
constexpr size_t WS_Y = 592 * MiB;
constexpr size_t WS_OF = 720 * MiB;
constexpr size_t WS_OB = 848 * MiB;
constexpr size_t WS_SC = 144 * MiB;
constexpr size_t WS_EID = 720 * MiB;
constexpr size_t WS_GATE = 752 * MiB;
constexpr size_t WS_UB = 656 * MiB;
constexpr size_t WS_VB = 688 * MiB;
constexpr size_t WS_END = 976 * MiB;

typedef unsigned short bf16;
typedef float f32x4 __attribute__((ext_vector_type(4)));
typedef unsigned u32x4 __attribute__((ext_vector_type(4)));
#define LAS __attribute__((address_space(3)))

__device__ __forceinline__ unsigned f2bf(float f) { unsigned u = __float_as_uint(f); return (u + 0x7fffu + ((u >> 16) & 1u)) >> 16; }
__device__ __forceinline__ unsigned pk2(float lo, float hi) { return f2bf(lo) | (f2bf(hi) << 16); }
__device__ __forceinline__ float bflo(unsigned w) { return __uint_as_float(w << 16); }
__device__ __forceinline__ float bfhi(unsigned w) { return __uint_as_float(w & 0xffff0000u); }
__device__ __forceinline__ float sigmoidf_(float z) { return 1.0f / (1.0f + __expf(-z)); }
__device__ __forceinline__ float gelu_tanh(float x) { return x / (1.0f + __expf(-1.5957691216057308f * (x + 0.044715f * x * x * x))); }
__device__ __forceinline__ float silu_(float x) { return x / (1.0f + __expf(-x)); }
__device__ __forceinline__ float wave_sum(float v) {
#pragma unroll
    for (int o = 1; o < 64; o <<= 1) v += __shfl_xor(v, o);
    return v;
}

struct Params {
    const float *x, *w_in, *lb_logits, *hg_norm_g, *gm_ln_g, *gm_ln_b, *gm_ws, *gm_bs, *w_out, *ln1_g, *ln1_b, *wq, *k1, *k2, *pu, *pv, *ln2_g, *ln2_b;
    float* out; unsigned char* ws;
};

namespace pg8 {
struct EpiProj {
    static constexpr bool PERM = true, AFTER_DRAIN = false;
    bf16* O;
    __device__ __forceinline__ void operator()(const f32x4 (&acc)[2][2][4][2], const Unit& u, int wr, int wc, int fr, int fq) const {
        const int row0 = u.pm * BM + wr * 64 + fr, col0 = u.pn * BM + wc * 32 + 8 * fq;
        const int act = u.pn >= 10 ? 2 : (u.pn >= 8 ? 1 : 0);
#pragma unroll
        for (int ai = 0; ai < 2; ++ai)
#pragma unroll
            for (int m = 0; m < 4; ++m) { bf16* rowp = O + (size_t)(row0 + ai * HALF + m * 16) * NPROJ + col0;
#pragma unroll
                for (int bj = 0; bj < 2; ++bj) { f32x4 v0 = acc[ai][bj][m][0], v1 = acc[ai][bj][m][1];
                    if (act == 2) {
#pragma unroll
                        for (int j = 0; j < 4; ++j) { v0[j] = gelu_tanh(v0[j]); v1[j] = gelu_tanh(v1[j]); } }
                    else if (act == 1) {
#pragma unroll
                        for (int j = 0; j < 4; ++j) { v0[j] = silu_(v0[j]); v1[j] = silu_(v1[j]); } }
                    u32x4 w; w.x = cvt_pk_bf16(v0[0], v0[1]); w.y = cvt_pk_bf16(v0[2], v0[3]); w.z = cvt_pk_bf16(v1[0], v1[1]); w.w = cvt_pk_bf16(v1[2], v1[3]);
                    *(u32x4*)(rowp + bj * HALF) = w; } }
    }
};
struct EpiPre {
    static constexpr bool PERM = false, AFTER_DRAIN = false;
    const float* X; float* P;
    __device__ __forceinline__ void operator()(const f32x4 (&acc)[2][2][4][2], const Unit& u, int wr, int wc, int fr, int fq) const {
        const int row0 = u.pm * BM + wr * 64 + fr, col0 = u.pn * BM + wc * 32 + 4 * fq;
#pragma unroll
        for (int ai = 0; ai < 2; ++ai)
#pragma unroll
            for (int m = 0; m < 4; ++m) { const size_t off = (size_t)(row0 + ai * HALF + m * 16) * DM + col0;
#pragma unroll
                for (int bj = 0; bj < 2; ++bj)
#pragma unroll
                    for (int n = 0; n < 2; ++n) { const f32x4 xv = *(const f32x4*)(X + off + bj * HALF + n * 16);
                        *(f32x4*)(P + off + bj * HALF + n * 16) = xv * ALPHA + acc[ai][bj][m][n]; } }
    }
};
struct EpiF32 {
    static constexpr bool PERM = false, AFTER_DRAIN = false;
    float* C; int ldc;
    __device__ __forceinline__ void operator()(const f32x4 (&acc)[2][2][4][2], const Unit& u, int wr, int wc, int fr, int fq) const {
        const int row0 = u.pm * BM + wr * 64 + fr, col0 = u.pn * BM + wc * 32 + 4 * fq;
#pragma unroll
        for (int ai = 0; ai < 2; ++ai)
#pragma unroll
            for (int m = 0; m < 4; ++m) { float* rowp = C + (size_t)(row0 + ai * HALF + m * 16) * ldc + col0;
#pragma unroll
                for (int bj = 0; bj < 2; ++bj)
#pragma unroll
                    for (int n = 0; n < 2; ++n) *(f32x4*)(rowp + bj * HALF + n * 16) = acc[ai][bj][m][n]; }
    }
};
}

__device__ __forceinline__ void p0_transpose_item(const float* W, int K, int N, bf16* WT, LAS float* scr, int item, int lane) {
    const int nblk = N / 32, kb = item / nblk, nb = item % nblk, k0 = 64 * kb, n0 = 32 * nb;
#pragma unroll 8
    for (int i = 0; i < 32; ++i) { const int kk = 2 * i + (lane >> 5); scr[kk * 33 + (lane & 31)] = W[(size_t)(k0 + kk) * N + n0 + (lane & 31)]; }
    asm volatile("s_waitcnt lgkmcnt(0)" ::: "memory");
    const int c = lane & 7;
#pragma unroll
    for (int j = 0; j < 4; ++j) { const int n = (lane >> 3) + 8 * j; const LAS float* s = scr + (8 * c) * 33 + n;
        u32x4 o; o.x = pk2(s[0 * 33], s[1 * 33]); o.y = pk2(s[2 * 33], s[3 * 33]); o.z = pk2(s[4 * 33], s[5 * 33]); o.w = pk2(s[6 * 33], s[7 * 33]);
        *(u32x4*)(WT + (size_t)(n0 + n) * K + k0 + 8 * c) = o; }
    asm volatile("s_waitcnt lgkmcnt(0)" ::: "memory");
}

__device__ __forceinline__ void phase0(const Params& p, unsigned char* lds_g) {
    const int tid = threadIdx.x, lane = tid & 63, wave = tid >> 6;
    unsigned char* ws = p.ws;
    {
        const size_t n8 = (size_t)MTOK * DM / 8, gsz = (size_t)gridDim.x * NT;
        const f32x4* x4 = (const f32x4*)p.x; u32x4* o = (u32x4*)(ws + WS_XB);
        for (size_t i = (size_t)blockIdx.x * NT + tid; i < n8; i += gsz) { const f32x4 a = x4[2 * i], b = x4[2 * i + 1];
            u32x4 w; w.x = pk2(a[0], a[1]); w.y = pk2(a[2], a[3]); w.z = pk2(b[0], b[1]); w.w = pk2(b[2], b[3]); o[i] = w; }
    }
    {
        LAS float* scr = (LAS float*)(lds_g + wave * 16384);
        const int gw = blockIdx.x * NWAVES + wave, NGW = gridDim.x * NWAVES;
        constexpr int I_IN = (DM / 64) * (NPROJ / 32), I_OUT = (DM / 64) * (DM / 32);
        for (int it = gw; it < I_IN + I_OUT; it += NGW) {
            if (it < I_IN) p0_transpose_item(p.w_in, DM, NPROJ, (bf16*)(ws + WS_WIN), scr, it, lane);
            else p0_transpose_item(p.w_out, DM, DM, (bf16*)(ws + WS_WOUT), scr, it - I_IN, lane);
        }
    }
    __syncthreads();
    {
        float* Ks = (float*)lds_g;
        float* Ws = (float*)(lds_g + 128 * 132 * 4);
        bf16* WscT = (bf16*)(ws + WS_WSC);
        for (int it = blockIdx.x; it < 256; it += gridDim.x) {
            const int combo = it >> 4, dt = it & 15, h = combo >> 1, half = combo & 1, d0 = dt * 64;
            const float* kp = (half ? p.k2 : p.k1) + (size_t)h * 128 * 128;
            for (int i = tid; i < 128 * 128; i += NT) Ks[(i >> 7) * 132 + (i & 127)] = kp[i];
            for (int i = tid; i < 64 * 128; i += NT) Ws[i] = p.wq[(size_t)(d0 + (i >> 7)) * 2048 + h * 256 + half * 128 + (i & 127)];
            __syncthreads();
            const int key = tid & 127, dg = tid >> 7;
            float acc[16];
#pragma unroll
            for (int i = 0; i < 16; ++i) acc[i] = 0.f;
            for (int j = 0; j < 128; j += 4) {
                const f32x4 kv = *(const f32x4*)(Ks + key * 132 + j);
#pragma unroll
                for (int i = 0; i < 16; ++i) { const f32x4 wv = *(const f32x4*)(Ws + (dg * 16 + i) * 128 + j);
                    acc[i] += kv[0] * wv[0] + kv[1] * wv[1] + kv[2] * wv[2] + kv[3] * wv[3]; }
            }
            bf16* orow = WscT + (size_t)(h * 256 + half * 128 + key) * DM + d0 + dg * 16;
            u32x4 w0, w1; w0.x = pk2(acc[0], acc[1]); w0.y = pk2(acc[2], acc[3]); w0.z = pk2(acc[4], acc[5]); w0.w = pk2(acc[6], acc[7]);
            w1.x = pk2(acc[8], acc[9]); w1.y = pk2(acc[10], acc[11]); w1.z = pk2(acc[12], acc[13]); w1.w = pk2(acc[14], acc[15]);
            *(u32x4*)orow = w0; *(u32x4*)(orow + 8) = w1;
            __syncthreads();
        }
    }
}

__device__ __forceinline__ void hgrn_naive_item(const Params& p, unsigned char* lds_g, int item) {
    const int tid = threadIdx.x, lane = tid & 63, wave = tid >> 6;
    const int b = item >> 3, h = (item >> 1) & 3, dir = item & 1;
    float* F = (float*)lds_g; float* Kk = F + 64 * 128; float* Q = Kk + 64 * 128; float* V = Q + 64 * 128;
    const bf16* proj = (const bf16*)(p.ws + WS_PROJ);
    float* O = (float*)(p.ws + (dir ? WS_OB : WS_OF));
    const int ts = tid >> 3, dg = tid & 7;
    float lb[16];
#pragma unroll
    for (int i = 0; i < 16; ++i) { const int c = h * 128 + dg * 16 + i; const float l0 = p.lb_logits[(dir * 2 + 0) * 512 + c], l1 = p.lb_logits[(dir * 2 + 1) * 512 + c]; lb[i] = 1.0f / (1.0f + __expf(l1 - l0)); }
    const int e = wave * 16 + (lane >> 2), dq = lane & 3;
    float S[32];
#pragma unroll
    for (int i = 0; i < 32; ++i) S[i] = 0.f;
    for (int c = 0; c < SEQ / 64; ++c) {
        {
            const int s = c * 64 + ts, t = dir ? (SEQ - 1 - s) : s; const size_t row = (size_t)b * SEQ + t;
            const bf16* pr = proj + row * NPROJ;
            const u32x4 z0 = *(const u32x4*)(pr + (dir ? C_ZB : C_ZF) + h * 128 + dg * 16), z1 = *(const u32x4*)(pr + (dir ? C_ZB : C_ZF) + h * 128 + dg * 16 + 8);
            const u32x4 q0 = *(const u32x4*)(pr + C_Q + h * 128 + dg * 16), q1 = *(const u32x4*)(pr + C_Q + h * 128 + dg * 16 + 8);
            const u32x4 i0 = *(const u32x4*)(pr + C_I + h * 128 + dg * 16), i1 = *(const u32x4*)(pr + C_I + h * 128 + dg * 16 + 8);
            const unsigned zw[8] = {z0.x, z0.y, z0.z, z0.w, z1.x, z1.y, z1.z, z1.w};
            const unsigned qw[8] = {q0.x, q0.y, q0.z, q0.w, q1.x, q1.y, q1.z, q1.w};
            const unsigned iw[8] = {i0.x, i0.y, i0.z, i0.w, i1.x, i1.y, i1.z, i1.w};
            const int base = ts * 128 + dg * 16;
#pragma unroll
            for (int j = 0; j < 8; ++j) {
                const float za = bflo(zw[j]), zb = bfhi(zw[j]);
                const float sa = sigmoidf_(za), sb = sigmoidf_(zb);
                F[base + 2 * j] = lb[2 * j] + (1.0f - lb[2 * j]) * sa; F[base + 2 * j + 1] = lb[2 * j + 1] + (1.0f - lb[2 * j + 1]) * sb;
                Kk[base + 2 * j] = (1.0f - lb[2 * j]) * (1.0f - sa); Kk[base + 2 * j + 1] = (1.0f - lb[2 * j + 1]) * (1.0f - sb);
                Q[base + 2 * j] = bflo(qw[j]); Q[base + 2 * j + 1] = bfhi(qw[j]);
                V[base + 2 * j] = bflo(iw[j]); V[base + 2 * j + 1] = bfhi(iw[j]);
            }
        }
        __syncthreads();
        for (int s2 = 0; s2 < 64; ++s2) {
            const float v = V[s2 * 128 + e];
            float o = 0.f;
            const float* fp = F + s2 * 128 + dq * 32; const float* kp = Kk + s2 * 128 + dq * 32; const float* qp = Q + s2 * 128 + dq * 32;
#pragma unroll
            for (int i = 0; i < 32; i += 4) {
                const f32x4 fv = *(const f32x4*)(fp + i), kv = *(const f32x4*)(kp + i), qv = *(const f32x4*)(qp + i);
#pragma unroll
                for (int j = 0; j < 4; ++j) { S[i + j] = fv[j] * S[i + j] + kv[j] * v; o += S[i + j] * qv[j]; }
            }
            o += __shfl_xor(o, 1); o += __shfl_xor(o, 2);
            if (dq == 0) { const int s = c * 64 + s2, t = dir ? (SEQ - 1 - s) : s; O[((size_t)b * SEQ + t) * 512 + h * 128 + e] = o; }
        }
        __syncthreads();
    }
}

__device__ __forceinline__ void gmlp_naive_item(const Params& p, unsigned char* lds_g, int item) {
    const int tid = threadIdx.x, lane = tid & 63, wave = tid >> 6;
    const int g = item & 3, n = (item >> 2) & 31, b = item >> 7;
    float* Wt = (float*)lds_g;
    float* vc = Wt + 128 * 132;
    const bf16* proj = (const bf16*)(p.ws + WS_PROJ);
    bf16* Y = (bf16*)(p.ws + WS_Y);
    const float* Wg = p.gm_ws + (size_t)g * 128 * 128;
    for (int i = tid; i < 128 * 128; i += NT) { const int pp = i >> 7, q = i & 127; Wt[q * 132 + pp] = Wg[i]; }
    const size_t row0 = (size_t)b * SEQ + n * 128;
    for (int pos = wave * 16; pos < wave * 16 + 16; ++pos) {
        const unsigned w = *(const unsigned*)(proj + (row0 + pos) * NPROJ + C_V + g * 128 + lane * 2);
        const float a = bflo(w), c = bfhi(w);
        const float mu = wave_sum(a + c) * (1.0f / 128.0f);
        const float da = a - mu, dc = c - mu;
        const float var = wave_sum(da * da + dc * dc) * (1.0f / 128.0f);
        const float rstd = 1.0f / sqrtf(var + LN_EPS);
        vc[pos * 128 + lane * 2] = da * rstd * p.gm_ln_g[g * 128 + lane * 2] + p.gm_ln_b[g * 128 + lane * 2];
        vc[pos * 128 + lane * 2 + 1] = dc * rstd * p.gm_ln_g[g * 128 + lane * 2 + 1] + p.gm_ln_b[g * 128 + lane * 2 + 1];
    }
    __syncthreads();
    const int c = tid & 127, pg = tid >> 7;
    float acc[32];
#pragma unroll
    for (int i = 0; i < 32; ++i) acc[i] = 0.f;
    for (int q = 0; q < 128; ++q) {
        const float xv = vc[q * 128 + c];
        const float* wp = Wt + q * 132 + pg * 32;
#pragma unroll
        for (int i = 0; i < 32; i += 4) { const f32x4 wv = *(const f32x4*)(wp + i);
#pragma unroll
            for (int j = 0; j < 4; ++j) acc[i + j] += wv[j] * xv; }
    }
#pragma unroll
    for (int i = 0; i < 32; ++i) { const int pp = pg * 32 + i; const size_t row = row0 + pp;
        const float uv = __uint_as_float(((unsigned)proj[row * NPROJ + C_U + g * 128 + c]) << 16);
        Y[row * DM + 512 + g * 128 + c] = (bf16)f2bf(uv * (acc[i] + p.gm_bs[g * 128 + pp])); }
    __syncthreads();
}

__device__ __forceinline__ void hgrn_finalize(const Params& p) {
    const int tid = threadIdx.x, lane = tid & 63, wave = tid >> 6;
    const float* OF = (const float*)(p.ws + WS_OF); const float* OB = (const float*)(p.ws + WS_OB);
    const bf16* proj = (const bf16*)(p.ws + WS_PROJ); bf16* Y = (bf16*)(p.ws + WS_Y);
    for (int t = blockIdx.x * NWAVES + wave; t < MTOK; t += gridDim.x * NWAVES) {
        const f32x4 a0 = *(const f32x4*)(OF + (size_t)t * 512 + lane * 8), a1 = *(const f32x4*)(OF + (size_t)t * 512 + lane * 8 + 4);
        const f32x4 b0 = *(const f32x4*)(OB + (size_t)t * 512 + lane * 8), b1 = *(const f32x4*)(OB + (size_t)t * 512 + lane * 8 + 4);
        const f32x4 o0 = a0 + b0, o1 = a1 + b1;
        float ss = o0[0] * o0[0] + o0[1] * o0[1] + o0[2] * o0[2] + o0[3] * o0[3] + o1[0] * o1[0] + o1[1] * o1[1] + o1[2] * o1[2] + o1[3] * o1[3];
        ss += __shfl_xor(ss, 1); ss += __shfl_xor(ss, 2); ss += __shfl_xor(ss, 4); ss += __shfl_xor(ss, 8);
        const float r = 1.0f / sqrtf(ss * (1.0f / 128.0f) + RMS_EPS);
        const u32x4 gw = *(const u32x4*)(proj + (size_t)t * NPROJ + C_G + lane * 8);
        const f32x4 n0 = *(const f32x4*)(p.hg_norm_g + lane * 8), n1 = *(const f32x4*)(p.hg_norm_g + lane * 8 + 4);
        u32x4 w;
        w.x = pk2(o0[0] * r * n0[0] * bflo(gw.x), o0[1] * r * n0[1] * bfhi(gw.x));
        w.y = pk2(o0[2] * r * n0[2] * bflo(gw.y), o0[3] * r * n0[3] * bfhi(gw.y));
        w.z = pk2(o1[0] * r * n1[0] * bflo(gw.z), o1[1] * r * n1[1] * bfhi(gw.z));
        w.w = pk2(o1[2] * r * n1[2] * bflo(gw.w), o1[3] * r * n1[3] * bfhi(gw.w));
        *(u32x4*)(Y + (size_t)t * DM + lane * 8) = w;
    }
}

__device__ __forceinline__ void ln1_pass(const Params& p) {
    const int tid = threadIdx.x, lane = tid & 63, wave = tid >> 6;
    bf16* H1B = (bf16*)(p.ws + WS_XB);
    for (int t = blockIdx.x * NWAVES + wave; t < MTOK; t += gridDim.x * NWAVES) {
        float* row = p.out + (size_t)t * DM;
        f32x4 v[4]; float s = 0.f;
#pragma unroll
        for (int j = 0; j < 4; ++j) { v[j] = *(const f32x4*)(row + j * 256 + lane * 4); s += (v[j][0] + v[j][1]) + (v[j][2] + v[j][3]); }
        const float mean = wave_sum(s) * (1.0f / DM); float s2 = 0.f;
#pragma unroll
        for (int j = 0; j < 4; ++j) { v[j] = v[j] - mean; s2 += (v[j][0] * v[j][0] + v[j][1] * v[j][1]) + (v[j][2] * v[j][2] + v[j][3] * v[j][3]); }
        const float rstd = 1.0f / sqrtf(wave_sum(s2) * (1.0f / DM) + LN_EPS);
#pragma unroll
        for (int j = 0; j < 4; ++j) { const f32x4 gg = *(const f32x4*)(p.ln1_g + j * 256 + lane * 4), bb = *(const f32x4*)(p.ln1_b + j * 256 + lane * 4);
            const f32x4 hv = v[j] * rstd * gg + bb;
            *(f32x4*)(row + j * 256 + lane * 4) = hv;
            unsigned long long w = (unsigned long long)pk2(hv[0], hv[1]) | ((unsigned long long)pk2(hv[2], hv[3]) << 32);
            *(unsigned long long*)(H1B + (size_t)t * DM + j * 256 + lane * 4) = w; }
    }
}

__device__ __forceinline__ unsigned mono_key(float f) { const unsigned u = __float_as_uint(f); return u ^ ((unsigned)((int)u >> 31) | 0x80000000u); }
__device__ __forceinline__ float mono_val(unsigned k) { return __uint_as_float(k ^ ((k >> 31) ? 0x80000000u : 0xFFFFFFFFu)); }
#define CE_DESC(a, b) do { const unsigned _mx = (a) > (b) ? (a) : (b), _mn = (a) > (b) ? (b) : (a); (a) = _mx; (b) = _mn; } while (0)
template <int N> __device__ __forceinline__ void bitonic_sort_desc(unsigned (&k)[N]) {
#pragma unroll
    for (int sz = 2; sz <= N; sz <<= 1)
#pragma unroll
        for (int j = sz >> 1; j > 0; j >>= 1)
#pragma unroll
            for (int i = 0; i < N; ++i) { const int l = i ^ j; if (l > i) { if ((i & sz) == 0) CE_DESC(k[i], k[l]); else CE_DESC(k[l], k[i]); } }
}
template <int N> __device__ __forceinline__ void bitonic_merge_desc(unsigned (&k)[N]) {
#pragma unroll
    for (int j = N >> 1; j > 0; j >>= 1)
#pragma unroll
        for (int i = 0; i < N; ++i) { const int l = i ^ j; if (l > i) CE_DESC(k[i], k[l]); }
}
__device__ __forceinline__ void top16_merge(unsigned (&a)[16], const unsigned (&b)[16]) {
#pragma unroll
    for (int i = 0; i < 16; ++i) a[i] = a[i] > b[15 - i] ? a[i] : b[15 - i];
    bitonic_merge_desc<16>(a);
}
template <int CTRL> __device__ __forceinline__ void top16_merge_dpp(unsigned (&a)[16]) {
    unsigned b[16];
#pragma unroll
    for (int i = 0; i < 16; ++i) b[i] = (unsigned)__builtin_amdgcn_mov_dpp((int)a[i], CTRL, 0xF, 0xF, true);
    top16_merge(a, b);
}
constexpr int TK_SEG = 1088;
constexpr int TK_SCR = 128 * TK_SEG;
__device__ __forceinline__ void topk_phase(const Params& p, unsigned char* lds_g) {
    const int tid = threadIdx.x, lane = tid & 63, wave = __builtin_amdgcn_readfirstlane(tid >> 6);
    const float* SC = (const float*)(p.ws + WS_SC);
    int* EID = (int*)(p.ws + WS_EID); float* GATE = (float*)(p.ws + WS_GATE);
    LAS unsigned char* lds = (LAS unsigned char*)lds_g;
    const int seg = tid >> 2, part = tid & 3;
    for (int bt = blockIdx.x; bt < MTOK / 16; bt += gridDim.x) {
        const float* src = SC + (size_t)bt * 16 * NSC;
#pragma unroll
        for (int i = 0; i < 16; ++i) { const int sg = wave * 16 + i;
            __builtin_amdgcn_global_load_lds((const unsigned*)(src + (size_t)sg * 256 + lane * 4), (LAS unsigned*)(lds + sg * TK_SEG), 16, 0, 0); }
        asm volatile("s_waitcnt vmcnt(0)" ::: "memory");
        __syncthreads();
        unsigned V[2][16];
#pragma unroll
        for (int hh = 0; hh < 2; ++hh) {
            unsigned ka[16], kb[16];
#pragma unroll
            for (int i = 0; i < 4; ++i) { const f32x4 v = *(const LAS f32x4*)(lds + seg * TK_SEG + hh * 512 + (4 * i + part) * 16);
#pragma unroll
                for (int j = 0; j < 4; ++j) ka[4 * i + j] = (mono_key(v[j]) & ~127u) | (unsigned)(127 - (16 * i + 4 * part + j)); }
#pragma unroll
            for (int i = 4; i < 8; ++i) { const f32x4 v = *(const LAS f32x4*)(lds + seg * TK_SEG + hh * 512 + (4 * i + part) * 16);
#pragma unroll
                for (int j = 0; j < 4; ++j) kb[4 * (i - 4) + j] = (mono_key(v[j]) & ~127u) | (unsigned)(127 - (16 * i + 4 * part + j)); }
            bitonic_sort_desc<16>(ka); bitonic_sort_desc<16>(kb);
            top16_merge(ka, kb);
            top16_merge_dpp<0xB1>(ka);
            top16_merge_dpp<0x4E>(ka);
#pragma unroll
            for (int i = 0; i < 16; ++i) V[hh][i] = ka[i];
        }
        LAS unsigned* scr = (LAS unsigned*)(lds + TK_SCR + seg * 32);
        if (part == 0) {
#pragma unroll
            for (int hh = 0; hh < 2; ++hh)
#pragma unroll
                for (int w = 0; w < 4; ++w) scr[hh * 4 + w] = (127u - (V[hh][4 * w] & 127u)) | ((127u - (V[hh][4 * w + 1] & 127u)) << 8) | ((127u - (V[hh][4 * w + 2] & 127u)) << 16) | ((127u - (V[hh][4 * w + 3] & 127u)) << 24);
        }
        float v1[16], v2[16];
#pragma unroll
        for (int i = 0; i < 16; ++i) { v1[i] = mono_val(V[0][i] & ~127u); v2[i] = mono_val(V[1][i] & ~127u); }
#define CKEY(a, b) ((mono_key(v1[a] + v2[b]) & ~255u) | (unsigned)(255 - (16 * (a) + (b))))
        unsigned g0[16], g1[16], g2[16], g3[16];
#pragma unroll
        for (int b = 0; b < 16; ++b) g0[b] = CKEY(0, b);
#pragma unroll
        for (int b = 0; b < 8; ++b) g1[b] = CKEY(1, b);
#pragma unroll
        for (int a = 8; a < 16; ++a) g1[8 + (15 - a)] = CKEY(a, 0);
        bitonic_merge_desc<16>(g1);
        g2[0] = CKEY(2, 0); g2[1] = CKEY(2, 1); g2[2] = CKEY(2, 2); g2[3] = CKEY(2, 3); g2[4] = CKEY(2, 4);
        g2[5] = CKEY(3, 0); g2[6] = CKEY(3, 1); g2[7] = CKEY(3, 2); g2[8] = CKEY(3, 3);
        g2[9] = CKEY(4, 0); g2[10] = CKEY(4, 1); g2[11] = CKEY(4, 2);
        g2[12] = CKEY(5, 0); g2[13] = CKEY(5, 1); g2[14] = CKEY(6, 0); g2[15] = CKEY(6, 1);
        bitonic_sort_desc<16>(g2);
        g3[0] = CKEY(7, 0); g3[1] = CKEY(7, 1);
#pragma unroll
        for (int i = 2; i < 16; ++i) g3[i] = 0u;
        top16_merge(g0, g1); top16_merge(g2, g3); top16_merge(g0, g2);
#undef CKEY
        const float mx = mono_val(g0[0] & ~255u);
        unsigned rk[4]; float ex[4]; float den = 0.f;
#pragma unroll
        for (int i = 0; i < 4; ++i) { rk[i] = part == 0 ? g0[4 * i] : (part == 1 ? g0[4 * i + 1] : (part == 2 ? g0[4 * i + 2] : g0[4 * i + 3]));
            ex[i] = __expf(mono_val(rk[i] & ~255u) - mx); den += ex[i]; }
        den += __builtin_bit_cast(float, __builtin_amdgcn_mov_dpp(__builtin_bit_cast(int, den), 0xB1, 0xF, 0xF, true));
        den += __builtin_bit_cast(float, __builtin_amdgcn_mov_dpp(__builtin_bit_cast(int, den), 0x4E, 0xF, 0xF, true));
        const float rden = 1.0f / den;
        asm volatile("s_waitcnt lgkmcnt(0)" ::: "memory");
        const LAS unsigned char* sb = (const LAS unsigned char*)scr;
        const int tl = seg >> 3, h = seg & 7; const size_t obase = (size_t)(bt * 16 + tl) * 128 + h * 16;
#pragma unroll
        for (int i = 0; i < 4; ++i) { const unsigned flat = 255u - (rk[i] & 255u); const int i1 = sb[flat >> 4], i2 = sb[16 + (flat & 15)];
            EID[obase + 4 * i + part] = i1 * 128 + i2; GATE[obase + 4 * i + part] = ex[i] * rden; }
        __syncthreads();
    }
}

__device__ __forceinline__ void tables_to_bf16(const Params& p) {
    const size_t n8 = (size_t)16384 * DM / 8, gsz = (size_t)gridDim.x * NT;
    const f32x4* u4 = (const f32x4*)p.pu; const f32x4* v4 = (const f32x4*)p.pv; u32x4* uo = (u32x4*)(p.ws + WS_UB); u32x4* vo = (u32x4*)(p.ws + WS_VB);
    for (size_t i = (size_t)blockIdx.x * NT + threadIdx.x; i < n8; i += gsz) {
        { const f32x4 a = u4[2 * i], b = u4[2 * i + 1]; u32x4 w; w.x = pk2(a[0], a[1]); w.y = pk2(a[2], a[3]); w.z = pk2(b[0], b[1]); w.w = pk2(b[2], b[3]); uo[i] = w; }
        { const f32x4 a = v4[2 * i], b = v4[2 * i + 1]; u32x4 w; w.x = pk2(a[0], a[1]); w.y = pk2(a[2], a[3]); w.z = pk2(b[0], b[1]); w.w = pk2(b[2], b[3]); vo[i] = w; }
    }
}

typedef short bf16x8 __attribute__((ext_vector_type(8)));
typedef float f32x2 __attribute__((ext_vector_type(2)));
__device__ __forceinline__ void peer_phase(const Params& p, unsigned char* lds_g) {
    const int tid = threadIdx.x, lane = tid & 63, wave = __builtin_amdgcn_readfirstlane(tid >> 6);
    LAS unsigned char* wl = (LAS unsigned char*)lds_g + wave * 4096;
    LAS int* ids = (LAS int*)(wl + 2048); LAS float* gts = (LAS float*)(wl + 2560); LAS float* act = (LAS float*)(wl + 3072);
    const bf16* UB = (const bf16*)(p.ws + WS_UB); const bf16* VB = (const bf16*)(p.ws + WS_VB); const bf16* H1B = (const bf16*)(p.ws + WS_XB);
    const int* EID = (const int*)(p.ws + WS_EID); const float* GATE = (const float*)(p.ws + WS_GATE);
    const int r = lane & 15, q = lane >> 4;
    for (int t = blockIdx.x * NWAVES + wave; t < MTOK; t += gridDim.x * NWAVES) {
        ids[lane] = EID[(size_t)t * 128 + lane]; ids[64 + lane] = EID[(size_t)t * 128 + 64 + lane];
        gts[lane] = GATE[(size_t)t * 128 + lane]; gts[64 + lane] = GATE[(size_t)t * 128 + 64 + lane];
        *(LAS bf16x8*)(wl + lane * 16) = *(const bf16x8*)(H1B + (size_t)t * DM + lane * 8);
        *(LAS bf16x8*)(wl + 1024 + lane * 16) = *(const bf16x8*)(H1B + (size_t)t * DM + 512 + lane * 8);
        asm volatile("s_waitcnt lgkmcnt(0)" ::: "memory");
        const bf16* rp[8];
#pragma unroll
        for (int g = 0; g < 8; ++g) rp[g] = UB + (size_t)ids[16 * g + r] * DM + q * 8;
        f32x4 acc[8];
#pragma unroll
        for (int g = 0; g < 8; ++g) acc[g] = (f32x4){0.f, 0.f, 0.f, 0.f};
#pragma unroll 2
        for (int s = 0; s < 32; ++s) {
            const bf16x8 B = *(const LAS bf16x8*)(wl + s * 64 + q * 16);
#pragma unroll
            for (int g = 0; g < 8; ++g) { const bf16x8 A = *(const bf16x8*)(rp[g] + s * 32); acc[g] = __builtin_amdgcn_mfma_f32_16x16x32_bf16(A, B, acc[g], 0, 0, 0); }
        }
#pragma unroll
        for (int g = 0; g < 8; ++g) { const f32x4 gt = *(const LAS f32x4*)(gts + 16 * g + 4 * q); f32x4 a;
#pragma unroll
            for (int j = 0; j < 4; ++j) a[j] = gt[j] * gelu_tanh(acc[g][j]);
            if (r == 0) *(LAS f32x4*)(act + 16 * g + 4 * q) = a; }
        asm volatile("s_waitcnt lgkmcnt(0)" ::: "memory");
        f32x2 o[8];
#pragma unroll
        for (int i = 0; i < 8; ++i) o[i] = (f32x2){0.f, 0.f};
#pragma unroll 8
        for (int k = 0; k < 128; ++k) {
            const int e = __builtin_amdgcn_readfirstlane(ids[k]); const float a = act[k]; const f32x2 a2 = (f32x2){a, a};
            const bf16* vr = VB + (size_t)e * DM + lane * 8;
            const u32x4 v0 = *(const u32x4*)vr, v1 = *(const u32x4*)(vr + 512);
            o[0] += (f32x2){bflo(v0.x), bfhi(v0.x)} * a2; o[1] += (f32x2){bflo(v0.y), bfhi(v0.y)} * a2; o[2] += (f32x2){bflo(v0.z), bfhi(v0.z)} * a2; o[3] += (f32x2){bflo(v0.w), bfhi(v0.w)} * a2;
            o[4] += (f32x2){bflo(v1.x), bfhi(v1.x)} * a2; o[5] += (f32x2){bflo(v1.y), bfhi(v1.y)} * a2; o[6] += (f32x2){bflo(v1.z), bfhi(v1.z)} * a2; o[7] += (f32x2){bflo(v1.w), bfhi(v1.w)} * a2;
        }
        float* row = p.out + (size_t)t * DM;
        f32x4 y[4];
        y[0] = *(const f32x4*)(row + lane * 8); y[1] = *(const f32x4*)(row + lane * 8 + 4); y[2] = *(const f32x4*)(row + 512 + lane * 8); y[3] = *(const f32x4*)(row + 512 + lane * 8 + 4);
        float sm = 0.f;
#pragma unroll
        for (int j = 0; j < 4; ++j) { y[j] = y[j] * ALPHA + (f32x4){o[2 * j][0], o[2 * j][1], o[2 * j + 1][0], o[2 * j + 1][1]}; sm += (y[j][0] + y[j][1]) + (y[j][2] + y[j][3]); }
        const float mean = wave_sum(sm) * (1.0f / DM); float s2 = 0.f;
#pragma unroll
        for (int j = 0; j < 4; ++j) { y[j] = y[j] - mean; s2 += (y[j][0] * y[j][0] + y[j][1] * y[j][1]) + (y[j][2] * y[j][2] + y[j][3] * y[j][3]); }
        const float rstd = 1.0f / sqrtf(wave_sum(s2) * (1.0f / DM) + LN_EPS);
#pragma unroll
        for (int j = 0; j < 4; ++j) { const int off = (j >> 1) * 512 + lane * 8 + (j & 1) * 4;
            const f32x4 gg = *(const f32x4*)(p.ln2_g + off), bb = *(const f32x4*)(p.ln2_b + off);
            *(f32x4*)(row + off) = y[j] * rstd * gg + bb; }
        asm volatile("s_waitcnt lgkmcnt(0)" ::: "memory");
    }
}

__global__ void __launch_bounds__(NT, 2) mega(Params p) {
    extern __shared__ __attribute__((aligned(16))) unsigned char lds[];
    cg::grid_group grid = cg::this_grid();
    unsigned char* ws = p.ws;
    const int G = gridDim.x;

    phase0(p, lds);
    grid.sync();

    {
        pg8::Gemm g{(const bf16*)(ws + WS_XB), (const bf16*)(ws + WS_WIN), MTOK, NPROJ, DM}; pg8::StaticOrder S; S.init(MTOK, NPROJ, G, (int)blockIdx.x);
        pg8::EpiProj E{(bf16*)(ws + WS_PROJ)};
        pg8::gemm_phase<pg8::EpiProj, pg8::StaticOrder, true, true>((PG8_LAS unsigned char*)lds, g, S, E);
    }
    grid.sync();

    {
        const int half = G / 2;
        if ((int)blockIdx.x < half) { for (int it = blockIdx.x; it < 128; it += half) hgrn_naive_item(p, lds, it); }
        else { for (int it = blockIdx.x - half; it < 2048; it += G - half) gmlp_naive_item(p, lds, it); }
    }
    grid.sync();
    hgrn_finalize(p);
    grid.sync();

    {
        pg8::Gemm g{(const bf16*)(ws + WS_Y), (const bf16*)(ws + WS_WOUT), MTOK, DM, DM}; pg8::StaticOrder S; S.init(MTOK, DM, G, (int)blockIdx.x);
        pg8::EpiPre E{p.x, p.out};
        pg8::gemm_phase<pg8::EpiPre, pg8::StaticOrder, true, true>((PG8_LAS unsigned char*)lds, g, S, E);
    }
    grid.sync();
    ln1_pass(p);
    tables_to_bf16(p);
    grid.sync();

    {
        pg8::Gemm g{(const bf16*)(ws + WS_XB), (const bf16*)(ws + WS_WSC), MTOK, NSC, DM}; pg8::StaticOrder S; S.init(MTOK, NSC, G, (int)blockIdx.x);
        pg8::EpiF32 E{(float*)(ws + WS_SC), NSC};
        pg8::gemm_phase<pg8::EpiF32, pg8::StaticOrder, true, true>((PG8_LAS unsigned char*)lds, g, S, E);
    }
    grid.sync();
    topk_phase(p, lds);
    grid.sync();
    peer_phase(p, lds);
}

extern "C" void kernel_launch(void* const* d_in, const int* in_sizes, int n_in, void* d_out, int out_size, void* d_ws, size_t ws_size, hipStream_t stream) {
    static int grid = 0;
    if (grid == 0) {
        if (n_in != 18 || in_sizes[0] != MTOK * DM || out_size != MTOK * DM || ws_size < WS_END) {
            fprintf(stderr, "kernel_launch: unexpected shapes (n_in %d, in0 %d, out %d, ws %zu); nothing launched\n", n_in, n_in > 0 ? in_sizes[0] : -1, out_size, ws_size); grid = -1; return; }
        int dev = 0, cus = 0, per_cu = 0;
        if (hipGetDevice(&dev) != hipSuccess || hipDeviceGetAttribute(&cus, hipDeviceAttributeMultiprocessorCount, dev) != hipSuccess) { grid = -1; return; }
        if (hipFuncSetAttribute((const void*)mega, hipFuncAttributeMaxDynamicSharedMemorySize, LDS_BYTES) != hipSuccess) { fprintf(stderr, "kernel_launch: hipFuncSetAttribute failed\n"); grid = -1; return; }
        if (hipOccupancyMaxActiveBlocksPerMultiprocessor(&per_cu, (const void*)mega, NT, LDS_BYTES) != hipSuccess || per_cu < 1) { fprintf(stderr, "kernel_launch: occupancy query says %d\n", per_cu); grid = -1; return; }
        grid = cus;
    }
    if (grid < 0) return;
    Params p{};
    p.x = (const float*)d_in[0]; p.w_in = (const float*)d_in[1]; p.lb_logits = (const float*)d_in[2]; p.hg_norm_g = (const float*)d_in[3];
    p.gm_ln_g = (const float*)d_in[4]; p.gm_ln_b = (const float*)d_in[5]; p.gm_ws = (const float*)d_in[6]; p.gm_bs = (const float*)d_in[7];
    p.w_out = (const float*)d_in[8]; p.ln1_g = (const float*)d_in[9]; p.ln1_b = (const float*)d_in[10]; p.wq = (const float*)d_in[11];
    p.k1 = (const float*)d_in[12]; p.k2 = (const float*)d_in[13]; p.pu = (const float*)d_in[14]; p.pv = (const float*)d_in[15];
    p.ln2_g = (const float*)d_in[16]; p.ln2_b = (const float*)d_in[17];
    p.out = (float*)d_out; p.ws = (unsigned char*)d_ws;
    void* args[] = {&p};
    hipError_t e = hipLaunchCooperativeKernel((const void*)mega, dim3(grid), dim3(NT), args, LDS_BYTES, stream);
    if (e != hipSuccess) fprintf(stderr, "kernel_launch: cooperative launch failed: %s (grid %d)\n", hipGetErrorString(e), grid);
}
```

```cpp
#include <hip/hip_runtime.h>
#include <hip/hip_cooperative_groups.h>
#include <cstdio>
#include <cstdint>
namespace cg = cooperative_groups;

namespace pg8 {
#define PG8_LAS __attribute__((address_space(3)))
typedef unsigned short bf16_t;
typedef short bf16x8 __attribute__((ext_vector_type(8)));
typedef float f32x4 __attribute__((ext_vector_type(4)));
typedef unsigned u32x4 __attribute__((ext_vector_type(4)));
constexpr int BM = 256, BK = 64, HALF = 128, HTB = HALF * BK * 2  , STAGE_BYTES = 8 * HTB, NXCD = 8, WGM = 8;

__host__ __device__ __forceinline__ int lds_byte(int r, int c) { const int st = (r >> 4) * 2 + (c >> 5), rr = r & 15, cc = c & 31, ob = rr * 64 + cc * 2; return st * 1024 + (ob ^ (((ob >> 9) & 1) << 5)); }
__host__ __device__ __forceinline__ void stage_rc(int b, int& R, int& C) { const int st = b / 1024, sb = b % 1024, swz = sb ^ (((sb >> 9) & 1) << 5); R = (st >> 1) * 16 + swz / 64; C = (st & 1) * 32 + (swz % 64) / 2; }
__host__ __device__ __forceinline__ int perm32(int rho) { const int n = rho >> 4, i = rho & 15; return 8 * (i >> 2) + 4 * n + (i & 3); }

struct Unit { int pm, pn; };
struct Gemm { const bf16_t* A; const bf16_t* Bt; int M, N, K; };

struct StaticOrder {
    int nM, nN, nwg, G, c;
    __host__ __device__ void init(int M, int N, int G_, int c_) { nM = M / BM; nN = N / BM; nwg = nM * nN; G = G_; c = c_; }
    __host__ __device__ bool next(int i, Unit& u) const {
        const long L = (long)i * G + c; if (L >= nwg) return false;
        int wgid = (int)L; { const int q = nwg / NXCD, r = nwg % NXCD, xcd = wgid % NXCD, off = wgid / NXCD; wgid = (xcd < r ? xcd * (q + 1) : r * (q + 1) + (xcd - r) * q) + off; }
        const int nig = WGM * nN, gid = wgid / nig, fm = gid * WGM, gsz = (nM - fm) < WGM ? (nM - fm) : WGM;
        u.pm = fm + ((wgid % nig) % gsz); u.pn = (wgid % nig) / gsz; return true;
    }
    __device__ __forceinline__ void a_ready(const Unit&) const {}
    __device__ __forceinline__ void done(const Unit&) const {}
};
__device__ __forceinline__ unsigned cvt_pk_bf16(float lo, float hi) { unsigned r; asm volatile("v_cvt_pk_bf16_f32 %0, %1, %2" : "=v"(r) : "v"(lo), "v"(hi)); return r; }
template <class Epi, class Sched, bool ALIGN_EPI = false, bool SP2 = false>
__device__ __forceinline__ void gemm_phase(PG8_LAS unsigned char* lds, const Gemm g, const Sched& S, const Epi& E) {
    const int tid = threadIdx.x, wid = __builtin_amdgcn_readfirstlane(tid >> 6), lane = tid & 63, wr = wid >> 2, wc = wid & 3, fr = lane & 15, fq = lane >> 4;
    const int K = g.K, nt = K / BK;
    unsigned voffA[2], voffB[2];
#pragma unroll
    for (int i = 0; i < 2; ++i) { int R, C; stage_rc(tid * 16 + i * 8192, R, C); const int Rb = Epi::PERM ? ((R & ~31) + perm32(R & 31)) : R;
        voffA[i] = (unsigned)(R * K + C) * 2u; voffB[i] = (unsigned)(Rb * K + C) * 2u; }
    const size_t kstep = (size_t)(BK * 2);
    const size_t hstep = (size_t)HALF * K * 2;
    const size_t tstep = 2 * hstep;
    const unsigned ldsw = (unsigned)wid * 1024u;
    const int aoff = lds_byte(wr * 64 + fr, fq * 8), boff = lds_byte(wc * 32 + fr, fq * 8);
#define PG8_SA(b, h) (((b) * 2 + (h)) * HTB)
#define PG8_SB(b, h) ((4 + (b) * 2 + (h)) * HTB)
#define PG8_STAGE(bufoff, gbase, voff) do { _Pragma("unroll") for (int _i = 0; _i < 2; ++_i) \
        __builtin_amdgcn_global_load_lds((const unsigned*)((const char*)(gbase) + (voff)[_i]), (PG8_LAS unsigned*)(lds + (bufoff) + ldsw + _i * 8192), 16, 0, 0); } while (0)
#define PG8_LDA(dst, b, h) do { _Pragma("unroll") for (int m = 0; m < 4; ++m) _Pragma("unroll") for (int k = 0; k < 2; ++k) dst[m][k] = *(const PG8_LAS bf16x8*)(lds + PG8_SA(b, h) + aoff + m * 2048 + k * 1024); } while (0)
#define PG8_LDB(dst, b, h) do { _Pragma("unroll") for (int n = 0; n < 2; ++n) _Pragma("unroll") for (int k = 0; k < 2; ++k) dst[n][k] = *(const PG8_LAS bf16x8*)(lds + PG8_SB(b, h) + boff + n * 2048 + k * 1024); } while (0)
#define PG8_MMA(ai, bj, At, Bt) do { __builtin_amdgcn_s_setprio(1); _Pragma("unroll") for (int m = 0; m < 4; ++m) _Pragma("unroll") for (int n = 0; n < 2; ++n) _Pragma("unroll") for (int k = 0; k < 2; ++k) \
        acc[ai][bj][m][n] = __builtin_amdgcn_mfma_f32_16x16x32_bf16(Bt[n][k], At[m][k], acc[ai][bj][m][n], 0, 0, 0); __builtin_amdgcn_s_setprio(0); } while (0)
#define PG8_WAIT_V(n) asm volatile("s_waitcnt vmcnt(" #n ")" ::: "memory")
#define PG8_WAIT_L(n) asm volatile("s_waitcnt lgkmcnt(" #n ")" ::: "memory")
#define PG8_BAR __builtin_amdgcn_s_barrier()
#define PG8_SCHED __builtin_amdgcn_sched_barrier(0)
    Unit cur, nxt; int ui = 0;
    if (!S.next(0, cur)) return;
    f32x4 acc[2][2][4][2];
#pragma unroll
    for (int a = 0; a < 2; ++a)
#pragma unroll
        for (int b = 0; b < 2; ++b)
#pragma unroll
            for (int m = 0; m < 4; ++m)
#pragma unroll
                for (int n = 0; n < 2; ++n) acc[a][b][m][n] = (f32x4){0.f, 0.f, 0.f, 0.f};
    bf16x8 At[4][2], B0[2][2], B1[2][2];
    const char* cA = (const char*)g.A + (size_t)cur.pm * tstep; const char* cB = (const char*)g.Bt + (size_t)cur.pn * tstep;
    S.a_ready(cur);
    if constexpr (SP2) {
        PG8_STAGE(PG8_SB(0, 0), cB, voffB); PG8_STAGE(PG8_SB(0, 1), cB + hstep, voffB); PG8_STAGE(PG8_SA(0, 0), cA, voffA); PG8_STAGE(PG8_SA(0, 1), cA + hstep, voffA);
        if (wr == 1) PG8_BAR;
        PG8_WAIT_V(2); PG8_BAR;
        PG8_STAGE(PG8_SB(1, 0), cB + kstep, voffB); PG8_STAGE(PG8_SA(1, 0), cA + kstep, voffA); PG8_STAGE(PG8_SB(1, 1), cB + hstep + kstep, voffB);
        PG8_WAIT_V(6); PG8_BAR;
    } else {
        PG8_STAGE(PG8_SB(0, 0), cB, voffB); PG8_STAGE(PG8_SA(0, 0), cA, voffA); PG8_STAGE(PG8_SB(0, 1), cB + hstep, voffB); PG8_STAGE(PG8_SA(0, 1), cA + hstep, voffA);
        if (wr == 1) PG8_BAR;
        PG8_WAIT_V(4); PG8_BAR;
        PG8_STAGE(PG8_SB(1, 0), cB + kstep, voffB); PG8_STAGE(PG8_SA(1, 0), cA + kstep, voffA); PG8_STAGE(PG8_SB(1, 1), cB + hstep + kstep, voffB);
        PG8_WAIT_V(6); PG8_BAR;
    }
    for (;;) {
        const bool has_next = S.next(ui + 1, nxt);
        const char* nA = has_next ? (const char*)g.A + (size_t)nxt.pm * tstep : cA; const char* nB = has_next ? (const char*)g.Bt + (size_t)nxt.pn * tstep : cB;
        for (int t = 0; t < nt; t += 2) {
            const bool last = (t == nt - 2);
            const char* a1 = cA + (size_t)(t + 1) * kstep;
            const char* a2 = last ? nA : cA + (size_t)(t + 2) * kstep; const char* b2 = last ? nB : cB + (size_t)(t + 2) * kstep;
            const char* a3 = a2 + kstep; const char* b3 = b2 + kstep;
            if (last && has_next) S.a_ready(nxt);
            if constexpr (SP2) {
            PG8_LDB(B0, 0, 0); PG8_LDB(B1, 0, 1); PG8_SCHED; PG8_LDA(At, 0, 0); PG8_STAGE(PG8_SA(1, 1), a1 + hstep, voffA);
            PG8_WAIT_V(8); PG8_WAIT_L(0); PG8_BAR; PG8_MMA(0, 0, At, B0); PG8_MMA(0, 1, At, B1); PG8_BAR; PG8_SCHED;
            PG8_LDA(At, 0, 1); PG8_STAGE(PG8_SB(0, 0), b2, voffB); PG8_STAGE(PG8_SB(0, 1), b2 + hstep, voffB); PG8_STAGE(PG8_SA(0, 0), a2, voffA);
            PG8_WAIT_V(8); PG8_WAIT_L(0); PG8_BAR; PG8_MMA(1, 0, At, B0); PG8_MMA(1, 1, At, B1); PG8_BAR; PG8_SCHED;
            PG8_LDB(B0, 1, 0); PG8_LDB(B1, 1, 1); PG8_SCHED; PG8_LDA(At, 1, 0); PG8_STAGE(PG8_SA(0, 1), a2 + hstep, voffA);
            PG8_WAIT_V(8); PG8_WAIT_L(0); PG8_BAR; PG8_MMA(0, 0, At, B0); PG8_MMA(0, 1, At, B1); PG8_BAR; PG8_SCHED;
            PG8_LDA(At, 1, 1); PG8_STAGE(PG8_SB(1, 0), b3, voffB); PG8_STAGE(PG8_SB(1, 1), b3 + hstep, voffB); PG8_STAGE(PG8_SA(1, 0), a3, voffA);
            PG8_WAIT_V(8); PG8_WAIT_L(0); PG8_BAR; PG8_MMA(1, 0, At, B0); PG8_MMA(1, 1, At, B1); PG8_BAR; PG8_SCHED;
            } else {
            PG8_LDB(B0, 0, 0); PG8_SCHED; PG8_LDA(At, 0, 0); PG8_STAGE(PG8_SA(1, 1), a1 + hstep, voffA);
            PG8_WAIT_L(8); PG8_BAR; PG8_WAIT_L(0); PG8_MMA(0, 0, At, B0); PG8_BAR; PG8_SCHED;
            PG8_LDB(B1, 0, 1); PG8_STAGE(PG8_SB(0, 0), b2, voffB);
            PG8_BAR; PG8_WAIT_L(0); PG8_MMA(0, 1, At, B1); PG8_BAR;
            PG8_LDA(At, 0, 1); PG8_STAGE(PG8_SA(0, 0), a2, voffA);
            PG8_BAR; PG8_WAIT_L(0); PG8_MMA(1, 0, At, B0); PG8_BAR; PG8_SCHED;
            PG8_STAGE(PG8_SB(0, 1), b2 + hstep, voffB);
            PG8_WAIT_V(6); PG8_BAR; PG8_MMA(1, 1, At, B1); PG8_BAR;
            PG8_LDB(B0, 1, 0); PG8_SCHED; PG8_LDA(At, 1, 0); PG8_STAGE(PG8_SA(0, 1), a2 + hstep, voffA);
            PG8_WAIT_L(8); PG8_BAR; PG8_WAIT_L(0); PG8_MMA(0, 0, At, B0); PG8_BAR; PG8_SCHED;
            PG8_LDB(B1, 1, 1); PG8_STAGE(PG8_SB(1, 0), b3, voffB);
            PG8_BAR; PG8_WAIT_L(0); PG8_MMA(0, 1, At, B1); PG8_BAR;
            PG8_LDA(At, 1, 1); PG8_STAGE(PG8_SA(1, 0), a3, voffA);
            PG8_BAR; PG8_WAIT_L(0); PG8_MMA(1, 0, At, B0); PG8_BAR; PG8_SCHED;
            PG8_STAGE(PG8_SB(1, 1), b3 + hstep, voffB);
            PG8_WAIT_V(6); PG8_BAR; PG8_MMA(1, 1, At, B1); PG8_BAR;
            }
        }
        if constexpr (ALIGN_EPI) { if (wr == 0) PG8_BAR; }
        if constexpr (!Epi::AFTER_DRAIN) { E(acc, cur, wr, wc, fr, fq); S.done(cur); }
        if (!has_next) break;
#pragma unroll
        for (int a = 0; a < 2; ++a)
#pragma unroll
            for (int b = 0; b < 2; ++b)
#pragma unroll
                for (int m = 0; m < 4; ++m)
#pragma unroll
                    for (int n = 0; n < 2; ++n) acc[a][b][m][n] = (f32x4){0.f, 0.f, 0.f, 0.f};
        cur = nxt; cA = nA; cB = nB; ++ui;
        if constexpr (ALIGN_EPI) { if (wr == 1) PG8_BAR; }
    }
    PG8_WAIT_V(0);
    if constexpr (!ALIGN_EPI) { if (wr == 0) PG8_BAR; }
    PG8_BAR;
    if constexpr (Epi::AFTER_DRAIN) { E.fused(acc, cur, wr, wc, fr, fq, lds, wid, lane); S.done(cur); }
#undef PG8_SA
#undef PG8_SB
#undef PG8_STAGE
#undef PG8_LDA
#undef PG8_LDB
#undef PG8_MMA
#undef PG8_WAIT_V
#undef PG8_WAIT_L
#undef PG8_BAR
#undef PG8_SCHED
}
}

constexpr int NT = 512, NWAVES = 8;
constexpr int LDS_BYTES = 147456;
constexpr int MTOK = 65536, DM = 1024, SEQ = 4096, NBATCH = 16;
constexpr int NPROJ = 3584;
constexpr int C_Q = 0, C_ZF = 512, C_ZB = 1024, C_I = 1536, C_G = 2048, C_U = 2560, C_V = 3072;
constexpr int NSC = 2048;
constexpr float ALPHA = 1.189207115002721f;
constexpr float LN_EPS = 1e-5f, RMS_EPS = 1e-6f;

constexpr size_t MiB = 1u << 20;
constexpr size_t WS_WIN = 1 * MiB;
constexpr size_t WS_WOUT = 8 * MiB;
constexpr size_t WS_WSC = 10 * MiB;
constexpr size_t WS_XB = 16 * MiB;
constexpr size_t WS_PROJ = 144 * MiB;
constexpr size_t WS_Y = 592 * MiB;
constexpr size_t WS_OF = 720 * MiB;
constexpr size_t WS_OB = 848 * MiB;
constexpr size_t WS_SC = 144 * MiB;
constexpr size_t WS_EID = 720 * MiB;
constexpr size_t WS_GATE = 752 * MiB;
constexpr size_t WS_U8 = 656 * MiB;
constexpr size_t WS_V8 = 672 * MiB;
constexpr size_t WS_SU = 688 * MiB;
constexpr size_t WS_SV = 689 * MiB;
constexpr size_t WS_HS = 690 * MiB;
constexpr size_t WS_H8 = 784 * MiB;
constexpr size_t WS_END = 976 * MiB;

typedef unsigned short bf16;
typedef float f32x4 __attribute__((ext_vector_type(4)));
typedef unsigned u32x4 __attribute__((ext_vector_type(4)));
#define LAS __attribute__((address_space(3)))

__device__ __forceinline__ unsigned f2bf(float f) { unsigned u = __float_as_uint(f); return (u + 0x7fffu + ((u >> 16) & 1u)) >> 16; }
__device__ __forceinline__ unsigned pk2(float lo, float hi) { return f2bf(lo) | (f2bf(hi) << 16); }
__device__ __forceinline__ float bflo(unsigned w) { return __uint_as_float(w << 16); }
__device__ __forceinline__ float bfhi(unsigned w) { return __uint_as_float(w & 0xffff0000u); }
__device__ __forceinline__ float sigmoidf_(float z) { return 1.0f / (1.0f + __expf(-z)); }
__device__ __forceinline__ float gelu_tanh(float x) { return x / (1.0f + __expf(-1.5957691216057308f * (x + 0.044715f * x * x * x))); }
__device__ __forceinline__ float silu_(float x) { return x / (1.0f + __expf(-x)); }
__device__ __forceinline__ float wave_sum(float v) {
#pragma unroll
    for (int o = 1; o < 64; o <<= 1) v += __shfl_xor(v, o);
    return v;
}

__device__ __forceinline__ float wave_max(float v) {
#pragma unroll
    for (int o = 1; o < 64; o <<= 1) v = fmaxf(v, __shfl_xor(v, o));
    return v;
}
__device__ __forceinline__ unsigned pk4_fp8(float a, float b, float c, float d) { int w = __builtin_amdgcn_cvt_pk_fp8_f32(a, b, 0, false); w = __builtin_amdgcn_cvt_pk_fp8_f32(c, d, w, true); return (unsigned)w; }

struct Params {
    const float *x, *w_in, *lb_logits, *hg_norm_g, *gm_ln_g, *gm_ln_b, *gm_ws, *gm_bs, *w_out, *ln1_g, *ln1_b, *wq, *k1, *k2, *pu, *pv, *ln2_g, *ln2_b;
    float* out; unsigned char* ws;
};

namespace pg8 {
struct EpiProj {
    static constexpr bool PERM = true, AFTER_DRAIN = false;
    bf16* O;
    __device__ __forceinline__ void operator()(const f32x4 (&acc)[2][2][4][2], const Unit& u, int wr, int wc, int fr, int fq) const {
        const int row0 = u.pm * BM + wr * 64 + fr, col0 = u.pn * BM + wc * 32 + 8 * fq;
        const int act = u.pn >= 10 ? 2 : (u.pn >= 8 ? 1 : 0);
#pragma unroll
        for (int ai = 0; ai < 2; ++ai)
#pragma unroll
            for (int m = 0; m < 4; ++m) { bf16* rowp = O + (size_t)(row0 + ai * HALF + m * 16) * NPROJ + col0;
#pragma unroll
                for (int bj = 0; bj < 2; ++bj) { f32x4 v0 = acc[ai][bj][m][0], v1 = acc[ai][bj][m][1];
                    if (act == 2) {
#pragma unroll
                        for (int j = 0; j < 4; ++j) { v0[j] = gelu_tanh(v0[j]); v1[j] = gelu_tanh(v1[j]); } }
                    else if (act == 1) {
#pragma unroll
                        for (int j = 0; j < 4; ++j) { v0[j] = silu_(v0[j]); v1[j] = silu_(v1[j]); } }
                    u32x4 w; w.x = cvt_pk_bf16(v0[0], v0[1]); w.y = cvt_pk_bf16(v0[2], v0[3]); w.z = cvt_pk_bf16(v1[0], v1[1]); w.w = cvt_pk_bf16(v1[2], v1[3]);
                    *(u32x4*)(rowp + bj * HALF) = w; } }
    }
};
struct EpiPre {
    static constexpr bool PERM = false, AFTER_DRAIN = false;
    const float* X; float* P;
    __device__ __forceinline__ void operator()(const f32x4 (&acc)[2][2][4][2], const Unit& u, int wr, int wc, int fr, int fq) const {
        const int row0 = u.pm * BM + wr * 64 + fr, col0 = u.pn * BM + wc * 32 + 4 * fq;
#pragma unroll
        for (int ai = 0; ai < 2; ++ai)
#pragma unroll
            for (int m = 0; m < 4; ++m) { const size_t off = (size_t)(row0 + ai * HALF + m * 16) * DM + col0;
#pragma unroll
                for (int bj = 0; bj < 2; ++bj)
#pragma unroll
                    for (int n = 0; n < 2; ++n) { const f32x4 xv = *(const f32x4*)(X + off + bj * HALF + n * 16);
                        *(f32x4*)(P + off + bj * HALF + n * 16) = xv * ALPHA + acc[ai][bj][m][n]; } }
    }
};
struct EpiF32 {
    static constexpr bool PERM = false, AFTER_DRAIN = false;
    float* C; int ldc;
    __device__ __forceinline__ void operator()(const f32x4 (&acc)[2][2][4][2], const Unit& u, int wr, int wc, int fr, int fq) const {
        const int row0 = u.pm * BM + wr * 64 + fr, col0 = u.pn * BM + wc * 32 + 4 * fq;
#pragma unroll
        for (int ai = 0; ai < 2; ++ai)
#pragma unroll
            for (int m = 0; m < 4; ++m) { float* rowp = C + (size_t)(row0 + ai * HALF + m * 16) * ldc + col0;
#pragma unroll
                for (int bj = 0; bj < 2; ++bj)
#pragma unroll
                    for (int n = 0; n < 2; ++n) *(f32x4*)(rowp + bj * HALF + n * 16) = acc[ai][bj][m][n]; }
    }
};
}

__device__ __forceinline__ void p0_transpose_item(const float* W, int K, int N, bf16* WT, LAS float* scr, int item, int lane) {
    const int nblk = N / 32, kb = item / nblk, nb = item % nblk, k0 = 64 * kb, n0 = 32 * nb;
#pragma unroll 8
    for (int i = 0; i < 32; ++i) { const int kk = 2 * i + (lane >> 5); scr[kk * 33 + (lane & 31)] = W[(size_t)(k0 + kk) * N + n0 + (lane & 31)]; }
    asm volatile("s_waitcnt lgkmcnt(0)" ::: "memory");
    const int c = lane & 7;
#pragma unroll
    for (int j = 0; j < 4; ++j) { const int n = (lane >> 3) + 8 * j; const LAS float* s = scr + (8 * c) * 33 + n;
        u32x4 o; o.x = pk2(s[0 * 33], s[1 * 33]); o.y = pk2(s[2 * 33], s[3 * 33]); o.z = pk2(s[4 * 33], s[5 * 33]); o.w = pk2(s[6 * 33], s[7 * 33]);
        *(u32x4*)(WT + (size_t)(n0 + n) * K + k0 + 8 * c) = o; }
    asm volatile("s_waitcnt lgkmcnt(0)" ::: "memory");
}

__device__ __forceinline__ void phase0(const Params& p, unsigned char* lds_g) {
    const int tid = threadIdx.x, lane = tid & 63, wave = tid >> 6;
    unsigned char* ws = p.ws;
    {
        const size_t n8 = (size_t)MTOK * DM / 8, gsz = (size_t)gridDim.x * NT;
        const f32x4* x4 = (const f32x4*)p.x; u32x4* o = (u32x4*)(ws + WS_XB);
        for (size_t i = (size_t)blockIdx.x * NT + tid; i < n8; i += gsz) { const f32x4 a = x4[2 * i], b = x4[2 * i + 1];
            u32x4 w; w.x = pk2(a[0], a[1]); w.y = pk2(a[2], a[3]); w.z = pk2(b[0], b[1]); w.w = pk2(b[2], b[3]); o[i] = w; }
    }
    {
        LAS float* scr = (LAS float*)(lds_g + wave * 16384);
        const int gw = blockIdx.x * NWAVES + wave, NGW = gridDim.x * NWAVES;
        constexpr int I_IN = (DM / 64) * (NPROJ / 32), I_OUT = (DM / 64) * (DM / 32);
        for (int it = gw; it < I_IN + I_OUT; it += NGW) {
            if (it < I_IN) p0_transpose_item(p.w_in, DM, NPROJ, (bf16*)(ws + WS_WIN), scr, it, lane);
            else p0_transpose_item(p.w_out, DM, DM, (bf16*)(ws + WS_WOUT), scr, it - I_IN, lane);
        }
    }
    __syncthreads();
    {
        float* Ks = (float*)lds_g;
        float* Ws = (float*)(lds_g + 128 * 132 * 4);
        bf16* WscT = (bf16*)(ws + WS_WSC);
        for (int it = blockIdx.x; it < 256; it += gridDim.x) {
            const int combo = it >> 4, dt = it & 15, h = combo >> 1, half = combo & 1, d0 = dt * 64;
            const float* kp = (half ? p.k2 : p.k1) + (size_t)h * 128 * 128;
            for (int i = tid; i < 128 * 128; i += NT) Ks[(i >> 7) * 132 + (i & 127)] = kp[i];
            for (int i = tid; i < 64 * 128; i += NT) Ws[i] = p.wq[(size_t)(d0 + (i >> 7)) * 2048 + h * 256 + half * 128 + (i & 127)];
            __syncthreads();
            const int key = tid & 127, dg = tid >> 7;
            float acc[16];
#pragma unroll
            for (int i = 0; i < 16; ++i) acc[i] = 0.f;
            for (int j = 0; j < 128; j += 4) {
                const f32x4 kv = *(const f32x4*)(Ks + key * 132 + j);
#pragma unroll
                for (int i = 0; i < 16; ++i) { const f32x4 wv = *(const f32x4*)(Ws + (dg * 16 + i) * 128 + j);
                    acc[i] += kv[0] * wv[0] + kv[1] * wv[1] + kv[2] * wv[2] + kv[3] * wv[3]; }
            }
            bf16* orow = WscT + (size_t)(h * 256 + half * 128 + key) * DM + d0 + dg * 16;
            u32x4 w0, w1; w0.x = pk2(acc[0], acc[1]); w0.y = pk2(acc[2], acc[3]); w0.z = pk2(acc[4], acc[5]); w0.w = pk2(acc[6], acc[7]);
            w1.x = pk2(acc[8], acc[9]); w1.y = pk2(acc[10], acc[11]); w1.z = pk2(acc[12], acc[13]); w1.w = pk2(acc[14], acc[15]);
            *(u32x4*)orow = w0; *(u32x4*)(orow + 8) = w1;
            __syncthreads();
        }
    }
}

__device__ __forceinline__ void hgrn_naive_item(const Params& p, unsigned char* lds_g, int item) {
    const int tid = threadIdx.x, lane = tid & 63, wave = tid >> 6;
    const int b = item >> 3, h = (item >> 1) & 3, dir = item & 1;
    float* F = (float*)lds_g; float* Kk = F + 64 * 128; float* Q = Kk + 64 * 128; float* V = Q + 64 * 128;
    const bf16* proj = (const bf16*)(p.ws + WS_PROJ);
    float* O = (float*)(p.ws + (dir ? WS_OB : WS_OF));
    const int ts = tid >> 3, dg = tid & 7;
    float lb[16];
#pragma unroll
    for (int i = 0; i < 16; ++i) { const int c = h * 128 + dg * 16 + i; const float l0 = p.lb_logits[(dir * 2 + 0) * 512 + c], l1 = p.lb_logits[(dir * 2 + 1) * 512 + c]; lb[i] = 1.0f / (1.0f + __expf(l1 - l0)); }
    const int e = wave * 16 + (lane >> 2), dq = lane & 3;
    float S[32];
#pragma unroll
    for (int i = 0; i < 32; ++i) S[i] = 0.f;
    for (int c = 0; c < SEQ / 64; ++c) {
        {
            const int s = c * 64 + ts, t = dir ? (SEQ - 1 - s) : s; const size_t row = (size_t)b * SEQ + t;
            const bf16* pr = proj + row * NPROJ;
            const u32x4 z0 = *(const u32x4*)(pr + (dir ? C_ZB : C_ZF) + h * 128 + dg * 16), z1 = *(const u32x4*)(pr + (dir ? C_ZB : C_ZF) + h * 128 + dg * 16 + 8);
            const u32x4 q0 = *(const u32x4*)(pr + C_Q + h * 128 + dg * 16), q1 = *(const u32x4*)(pr + C_Q + h * 128 + dg * 16 + 8);
            const u32x4 i0 = *(const u32x4*)(pr + C_I + h * 128 + dg * 16), i1 = *(const u32x4*)(pr + C_I + h * 128 + dg * 16 + 8);
            const unsigned zw[8] = {z0.x, z0.y, z0.z, z0.w, z1.x, z1.y, z1.z, z1.w};
            const unsigned qw[8] = {q0.x, q0.y, q0.z, q0.w, q1.x, q1.y, q1.z, q1.w};
            const unsigned iw[8] = {i0.x, i0.y, i0.z, i0.w, i1.x, i1.y, i1.z, i1.w};
            const int base = ts * 128 + dg * 16;
#pragma unroll
            for (int j = 0; j < 8; ++j) {
                const float za = bflo(zw[j]), zb = bfhi(zw[j]);
                const float sa = sigmoidf_(za), sb = sigmoidf_(zb);
                F[base + 2 * j] = lb[2 * j] + (1.0f - lb[2 * j]) * sa; F[base + 2 * j + 1] = lb[2 * j + 1] + (1.0f - lb[2 * j + 1]) * sb;
                Kk[base + 2 * j] = (1.0f - lb[2 * j]) * (1.0f - sa); Kk[base + 2 * j + 1] = (1.0f - lb[2 * j + 1]) * (1.0f - sb);
                Q[base + 2 * j] = bflo(qw[j]); Q[base + 2 * j + 1] = bfhi(qw[j]);
                V[base + 2 * j] = bflo(iw[j]); V[base + 2 * j + 1] = bfhi(iw[j]);
            }
        }
        __syncthreads();
        for (int s2 = 0; s2 < 64; ++s2) {
            const float v = V[s2 * 128 + e];
            float o = 0.f;
            const float* fp = F + s2 * 128 + dq * 32; const float* kp = Kk + s2 * 128 + dq * 32; const float* qp = Q + s2 * 128 + dq * 32;
#pragma unroll
            for (int i = 0; i < 32; i += 4) {
                const f32x4 fv = *(const f32x4*)(fp + i), kv = *(const f32x4*)(kp + i), qv = *(const f32x4*)(qp + i);
#pragma unroll
                for (int j = 0; j < 4; ++j) { S[i + j] = fv[j] * S[i + j] + kv[j] * v; o += S[i + j] * qv[j]; }
            }
            o += __shfl_xor(o, 1); o += __shfl_xor(o, 2);
            if (dq == 0) { const int s = c * 64 + s2, t = dir ? (SEQ - 1 - s) : s; O[((size_t)b * SEQ + t) * 512 + h * 128 + e] = o; }
        }
        __syncthreads();
    }
}

__device__ __forceinline__ void gmlp_naive_item(const Params& p, unsigned char* lds_g, int item) {
    const int tid = threadIdx.x, lane = tid & 63, wave = tid >> 6;
    const int g = item & 3, n = (item >> 2) & 31, b = item >> 7;
    float* Wt = (float*)lds_g;
    float* vc = Wt + 128 * 132;
    const bf16* proj = (const bf16*)(p.ws + WS_PROJ);
    bf16* Y = (bf16*)(p.ws + WS_Y);
    const float* Wg = p.gm_ws + (size_t)g * 128 * 128;
    for (int i = tid; i < 128 * 128; i += NT) { const int pp = i >> 7, q = i & 127; Wt[q * 132 + pp] = Wg[i]; }
    const size_t row0 = (size_t)b * SEQ + n * 128;
    for (int pos = wave * 16; pos < wave * 16 + 16; ++pos) {
        const unsigned w = *(const unsigned*)(proj + (row0 + pos) * NPROJ + C_V + g * 128 + lane * 2);
        const float a = bflo(w), c = bfhi(w);
        const float mu = wave_sum(a + c) * (1.0f / 128.0f);
        const float da = a - mu, dc = c - mu;
        const float var = wave_sum(da * da + dc * dc) * (1.0f / 128.0f);
        const float rstd = 1.0f / sqrtf(var + LN_EPS);
        vc[pos * 128 + lane * 2] = da * rstd * p.gm_ln_g[g * 128 + lane * 2] + p.gm_ln_b[g * 128 + lane * 2];
        vc[pos * 128 + lane * 2 + 1] = dc * rstd * p.gm_ln_g[g * 128 + lane * 2 + 1] + p.gm_ln_b[g * 128 + lane * 2 + 1];
    }
    __syncthreads();
    const int c = tid & 127, pg = tid >> 7;
    float acc[32];
#pragma unroll
    for (int i = 0; i < 32; ++i) acc[i] = 0.f;
    for (int q = 0; q < 128; ++q) {
        const float xv = vc[q * 128 + c];
        const float* wp = Wt + q * 132 + pg * 32;
#pragma unroll
        for (int i = 0; i < 32; i += 4) { const f32x4 wv = *(const f32x4*)(wp + i);
#pragma unroll
            for (int j = 0; j < 4; ++j) acc[i + j] += wv[j] * xv; }
    }
#pragma unroll
    for (int i = 0; i < 32; ++i) { const int pp = pg * 32 + i; const size_t row = row0 + pp;
        const float uv = __uint_as_float(((unsigned)proj[row * NPROJ + C_U + g * 128 + c]) << 16);
        Y[row * DM + 512 + g * 128 + c] = (bf16)f2bf(uv * (acc[i] + p.gm_bs[g * 128 + pp])); }
    __syncthreads();
}

__device__ __forceinline__ void hgrn_finalize(const Params& p) {
    const int tid = threadIdx.x, lane = tid & 63, wave = tid >> 6;
    const float* OF = (const float*)(p.ws + WS_OF); const float* OB = (const float*)(p.ws + WS_OB);
    const bf16* proj = (const bf16*)(p.ws + WS_PROJ); bf16* Y = (bf16*)(p.ws + WS_Y);
    for (int t = blockIdx.x * NWAVES + wave; t < MTOK; t += gridDim.x * NWAVES) {
        const f32x4 a0 = *(const f32x4*)(OF + (size_t)t * 512 + lane * 8), a1 = *(const f32x4*)(OF + (size_t)t * 512 + lane * 8 + 4);
        const f32x4 b0 = *(const f32x4*)(OB + (size_t)t * 512 + lane * 8), b1 = *(const f32x4*)(OB + (size_t)t * 512 + lane * 8 + 4);
        const f32x4 o0 = a0 + b0, o1 = a1 + b1;
        float ss = o0[0] * o0[0] + o0[1] * o0[1] + o0[2] * o0[2] + o0[3] * o0[3] + o1[0] * o1[0] + o1[1] * o1[1] + o1[2] * o1[2] + o1[3] * o1[3];
        ss += __shfl_xor(ss, 1); ss += __shfl_xor(ss, 2); ss += __shfl_xor(ss, 4); ss += __shfl_xor(ss, 8);
        const float r = 1.0f / sqrtf(ss * (1.0f / 128.0f) + RMS_EPS);
        const u32x4 gw = *(const u32x4*)(proj + (size_t)t * NPROJ + C_G + lane * 8);
        const f32x4 n0 = *(const f32x4*)(p.hg_norm_g + lane * 8), n1 = *(const f32x4*)(p.hg_norm_g + lane * 8 + 4);
        u32x4 w;
        w.x = pk2(o0[0] * r * n0[0] * bflo(gw.x), o0[1] * r * n0[1] * bfhi(gw.x));
        w.y = pk2(o0[2] * r * n0[2] * bflo(gw.y), o0[3] * r * n0[3] * bfhi(gw.y));
        w.z = pk2(o1[0] * r * n1[0] * bflo(gw.z), o1[1] * r * n1[1] * bfhi(gw.z));
        w.w = pk2(o1[2] * r * n1[2] * bflo(gw.w), o1[3] * r * n1[3] * bfhi(gw.w));
        *(u32x4*)(Y + (size_t)t * DM + lane * 8) = w;
    }
}

__device__ __forceinline__ void ln1_pass(const Params& p) {
    const int tid = threadIdx.x, lane = tid & 63, wave = tid >> 6;
    bf16* H1B = (bf16*)(p.ws + WS_XB);
    for (int t = blockIdx.x * NWAVES + wave; t < MTOK; t += gridDim.x * NWAVES) {
        float* row = p.out + (size_t)t * DM;
        f32x4 v[4]; float s = 0.f;
#pragma unroll
        for (int j = 0; j < 4; ++j) { v[j] = *(const f32x4*)(row + j * 256 + lane * 4); s += (v[j][0] + v[j][1]) + (v[j][2] + v[j][3]); }
        const float mean = wave_sum(s) * (1.0f / DM); float s2 = 0.f;
#pragma unroll
        for (int j = 0; j < 4; ++j) { v[j] = v[j] - mean; s2 += (v[j][0] * v[j][0] + v[j][1] * v[j][1]) + (v[j][2] * v[j][2] + v[j][3] * v[j][3]); }
        const float rstd = 1.0f / sqrtf(wave_sum(s2) * (1.0f / DM) + LN_EPS);
        float amax = 0.f;
#pragma unroll
        for (int j = 0; j < 4; ++j) { const f32x4 gg = *(const f32x4*)(p.ln1_g + j * 256 + lane * 4), bb = *(const f32x4*)(p.ln1_b + j * 256 + lane * 4);
            const f32x4 hv = v[j] * rstd * gg + bb;
            *(f32x4*)(row + j * 256 + lane * 4) = hv;
            unsigned long long w = (unsigned long long)pk2(hv[0], hv[1]) | ((unsigned long long)pk2(hv[2], hv[3]) << 32);
            *(unsigned long long*)(H1B + (size_t)t * DM + j * 256 + lane * 4) = w;
            v[j] = hv; amax = fmaxf(amax, fmaxf(fmaxf(fabsf(hv[0]), fabsf(hv[1])), fmaxf(fabsf(hv[2]), fabsf(hv[3])))); }
        amax = wave_max(amax);
        const float inv = amax > 0.f ? 448.0f / amax : 0.f;
#pragma unroll
        for (int j = 0; j < 4; ++j) *(unsigned*)(p.ws + WS_H8 + (size_t)t * DM + j * 256 + lane * 4) = pk4_fp8(v[j][0] * inv, v[j][1] * inv, v[j][2] * inv, v[j][3] * inv);
        if (lane == 0) ((float*)(p.ws + WS_HS))[t] = amax * (1.0f / 448.0f);
    }
}

__device__ __forceinline__ unsigned mono_key(float f) { const unsigned u = __float_as_uint(f); return u ^ ((unsigned)((int)u >> 31) | 0x80000000u); }
__device__ __forceinline__ float mono_val(unsigned k) { return __uint_as_float(k ^ ((k >> 31) ? 0x80000000u : 0xFFFFFFFFu)); }
#define CE_DESC(a, b) do { const unsigned _mx = (a) > (b) ? (a) : (b), _mn = (a) > (b) ? (b) : (a); (a) = _mx; (b) = _mn; } while (0)
template <int N> __device__ __forceinline__ void bitonic_sort_desc(unsigned (&k)[N]) {
#pragma unroll
    for (int sz = 2; sz <= N; sz <<= 1)
#pragma unroll
        for (int j = sz >> 1; j > 0; j >>= 1)
#pragma unroll
            for (int i = 0; i < N; ++i) { const int l = i ^ j; if (l > i) { if ((i & sz) == 0) CE_DESC(k[i], k[l]); else CE_DESC(k[l], k[i]); } }
}
template <int N> __device__ __forceinline__ void bitonic_merge_desc(unsigned (&k)[N]) {
#pragma unroll
    for (int j = N >> 1; j > 0; j >>= 1)
#pragma unroll
        for (int i = 0; i < N; ++i) { const int l = i ^ j; if (l > i) CE_DESC(k[i], k[l]); }
}
__device__ __forceinline__ void top16_merge(unsigned (&a)[16], const unsigned (&b)[16]) {
#pragma unroll
    for (int i = 0; i < 16; ++i) a[i] = a[i] > b[15 - i] ? a[i] : b[15 - i];
    bitonic_merge_desc<16>(a);
}
template <int CTRL> __device__ __forceinline__ void top16_merge_dpp(unsigned (&a)[16]) {
    unsigned b[16];
#pragma unroll
    for (int i = 0; i < 16; ++i) b[i] = (unsigned)__builtin_amdgcn_mov_dpp((int)a[i], CTRL, 0xF, 0xF, true);
    top16_merge(a, b);
}
constexpr int TK_SEG = 1088;
constexpr int TK_SCR = 128 * TK_SEG;
__device__ __forceinline__ void topk_phase(const Params& p, unsigned char* lds_g) {
    const int tid = threadIdx.x, lane = tid & 63, wave = __builtin_amdgcn_readfirstlane(tid >> 6);
    const float* SC = (const float*)(p.ws + WS_SC);
    int* EID = (int*)(p.ws + WS_EID); float* GATE = (float*)(p.ws + WS_GATE);
    LAS unsigned char* lds = (LAS unsigned char*)lds_g;
    const int seg = tid >> 2, part = tid & 3;
    for (int bt = blockIdx.x; bt < MTOK / 16; bt += gridDim.x) {
        const float* src = SC + (size_t)bt * 16 * NSC;
#pragma unroll
        for (int i = 0; i < 16; ++i) { const int sg = wave * 16 + i;
            __builtin_amdgcn_global_load_lds((const unsigned*)(src + (size_t)sg * 256 + lane * 4), (LAS unsigned*)(lds + sg * TK_SEG), 16, 0, 0); }
        asm volatile("s_waitcnt vmcnt(0)" ::: "memory");
        __syncthreads();
        unsigned V[2][16];
#pragma unroll
        for (int hh = 0; hh < 2; ++hh) {
            unsigned ka[16], kb[16];
#pragma unroll
            for (int i = 0; i < 4; ++i) { const f32x4 v = *(const LAS f32x4*)(lds + seg * TK_SEG + hh * 512 + (4 * i + part) * 16);
#pragma unroll
                for (int j = 0; j < 4; ++j) ka[4 * i + j] = (mono_key(v[j]) & ~127u) | (unsigned)(127 - (16 * i + 4 * part + j)); }
#pragma unroll
            for (int i = 4; i < 8; ++i) { const f32x4 v = *(const LAS f32x4*)(lds + seg * TK_SEG + hh * 512 + (4 * i + part) * 16);
#pragma unroll
                for (int j = 0; j < 4; ++j) kb[4 * (i - 4) + j] = (mono_key(v[j]) & ~127u) | (unsigned)(127 - (16 * i + 4 * part + j)); }
            bitonic_sort_desc<16>(ka); bitonic_sort_desc<16>(kb);
            top16_merge(ka, kb);
            top16_merge_dpp<0xB1>(ka);
            top16_merge_dpp<0x4E>(ka);
#pragma unroll
            for (int i = 0; i < 16; ++i) V[hh][i] = ka[i];
        }
        LAS unsigned* scr = (LAS unsigned*)(lds + TK_SCR + seg * 32);
        if (part == 0) {
#pragma unroll
            for (int hh = 0; hh < 2; ++hh)
#pragma unroll
                for (int w = 0; w < 4; ++w) scr[hh * 4 + w] = (127u - (V[hh][4 * w] & 127u)) | ((127u - (V[hh][4 * w + 1] & 127u)) << 8) | ((127u - (V[hh][4 * w + 2] & 127u)) << 16) | ((127u - (V[hh][4 * w + 3] & 127u)) << 24);
        }
        float v1[16], v2[16];
#pragma unroll
        for (int i = 0; i < 16; ++i) { v1[i] = mono_val(V[0][i] & ~127u); v2[i] = mono_val(V[1][i] & ~127u); }
#define CKEY(a, b) ((mono_key(v1[a] + v2[b]) & ~255u) | (unsigned)(255 - (16 * (a) + (b))))
        unsigned g0[16], g1[16], g2[16], g3[16];
#pragma unroll
        for (int b = 0; b < 16; ++b) g0[b] = CKEY(0, b);
#pragma unroll
        for (int b = 0; b < 8; ++b) g1[b] = CKEY(1, b);
#pragma unroll
        for (int a = 8; a < 16; ++a) g1[8 + (15 - a)] = CKEY(a, 0);
        bitonic_merge_desc<16>(g1);
        g2[0] = CKEY(2, 0); g2[1] = CKEY(2, 1); g2[2] = CKEY(2, 2); g2[3] = CKEY(2, 3); g2[4] = CKEY(2, 4);
        g2[5] = CKEY(3, 0); g2[6] = CKEY(3, 1); g2[7] = CKEY(3, 2); g2[8] = CKEY(3, 3);
        g2[9] = CKEY(4, 0); g2[10] = CKEY(4, 1); g2[11] = CKEY(4, 2);
        g2[12] = CKEY(5, 0); g2[13] = CKEY(5, 1); g2[14] = CKEY(6, 0); g2[15] = CKEY(6, 1);
        bitonic_sort_desc<16>(g2);
        g3[0] = CKEY(7, 0); g3[1] = CKEY(7, 1);
#pragma unroll
        for (int i = 2; i < 16; ++i) g3[i] = 0u;
        top16_merge(g0, g1); top16_merge(g2, g3); top16_merge(g0, g2);
#undef CKEY
        const float mx = mono_val(g0[0] & ~255u);
        unsigned rk[4]; float ex[4]; float den = 0.f;
#pragma unroll
        for (int i = 0; i < 4; ++i) { rk[i] = part == 0 ? g0[4 * i] : (part == 1 ? g0[4 * i + 1] : (part == 2 ? g0[4 * i + 2] : g0[4 * i + 3]));
            ex[i] = __expf(mono_val(rk[i] & ~255u) - mx); den += ex[i]; }
        den += __builtin_bit_cast(float, __builtin_amdgcn_mov_dpp(__builtin_bit_cast(int, den), 0xB1, 0xF, 0xF, true));
        den += __builtin_bit_cast(float, __builtin_amdgcn_mov_dpp(__builtin_bit_cast(int, den), 0x4E, 0xF, 0xF, true));
        const float rden = 1.0f / den;
        asm volatile("s_waitcnt lgkmcnt(0)" ::: "memory");
        const LAS unsigned char* sb = (const LAS unsigned char*)scr;
        const int tl = seg >> 3, h = seg & 7; const size_t obase = (size_t)(bt * 16 + tl) * 128 + h * 16;
#pragma unroll
        for (int i = 0; i < 4; ++i) { const unsigned flat = 255u - (rk[i] & 255u); const int i1 = sb[flat >> 4], i2 = sb[16 + (flat & 15)];
            EID[obase + 4 * i + part] = i1 * 128 + i2; GATE[obase + 4 * i + part] = ex[i] * rden; }
        __syncthreads();
    }
}

__device__ __forceinline__ void tables_to_fp8(const Params& p) {
    const int lane = threadIdx.x & 63, wave = threadIdx.x >> 6;
    for (int rw = blockIdx.x * NWAVES + wave; rw < 2 * 16384; rw += gridDim.x * NWAVES) {
        const int tb = rw >= 16384, e = rw & 16383;
        const float* src = (tb ? p.pv : p.pu) + (size_t)e * DM + lane * 16;
        f32x4 v[4]; float mx = 0.f;
#pragma unroll
        for (int j = 0; j < 4; ++j) { v[j] = *(const f32x4*)(src + 4 * j); mx = fmaxf(mx, fmaxf(fmaxf(fabsf(v[j][0]), fabsf(v[j][1])), fmaxf(fabsf(v[j][2]), fabsf(v[j][3])))); }
        mx = wave_max(mx);
        const float inv = mx > 0.f ? 448.0f / mx : 0.f;
        u32x4 w; w.x = pk4_fp8(v[0][0] * inv, v[0][1] * inv, v[0][2] * inv, v[0][3] * inv); w.y = pk4_fp8(v[1][0] * inv, v[1][1] * inv, v[1][2] * inv, v[1][3] * inv);
        w.z = pk4_fp8(v[2][0] * inv, v[2][1] * inv, v[2][2] * inv, v[2][3] * inv); w.w = pk4_fp8(v[3][0] * inv, v[3][1] * inv, v[3][2] * inv, v[3][3] * inv);
        *(u32x4*)(p.ws + (tb ? WS_V8 : WS_U8) + (size_t)e * DM + lane * 16) = w;
        if (lane == 0) ((float*)(p.ws + (tb ? WS_SV : WS_SU)))[e] = mx * (1.0f / 448.0f);
    }
}

typedef float f32x2 __attribute__((ext_vector_type(2)));
typedef long i64x2 __attribute__((ext_vector_type(2)));
__device__ __forceinline__ void peer_phase(const Params& p, unsigned char* lds_g) {
    const int tid = threadIdx.x, lane = tid & 63, wave = __builtin_amdgcn_readfirstlane(tid >> 6);
    LAS unsigned char* wl = (LAS unsigned char*)lds_g + wave * 4096;
    LAS int* ids = (LAS int*)(wl + 1024); LAS float* gts = (LAS float*)(wl + 1536); LAS float* act = (LAS float*)(wl + 2048); LAS float* sus = (LAS float*)(wl + 2560);
    const unsigned char* U8 = p.ws + WS_U8; const unsigned char* V8 = p.ws + WS_V8; const unsigned char* H8 = p.ws + WS_H8;
    const float* SU = (const float*)(p.ws + WS_SU); const float* SV = (const float*)(p.ws + WS_SV); const float* HS = (const float*)(p.ws + WS_HS);
    const int* EID = (const int*)(p.ws + WS_EID); const float* GATE = (const float*)(p.ws + WS_GATE);
    const int r = lane & 15, q = lane >> 4;
    for (int t = blockIdx.x * NWAVES + wave; t < MTOK; t += gridDim.x * NWAVES) {
        const int e_lo = EID[(size_t)t * 128 + lane], e_hi = EID[(size_t)t * 128 + 64 + lane];
        ids[lane] = e_lo; ids[64 + lane] = e_hi;
        gts[lane] = GATE[(size_t)t * 128 + lane] * SV[e_lo]; gts[64 + lane] = GATE[(size_t)t * 128 + 64 + lane] * SV[e_hi];
        const float hs = HS[t];
        sus[lane] = SU[e_lo] * hs; sus[64 + lane] = SU[e_hi] * hs;
        *(LAS u32x4*)(wl + lane * 16) = *(const u32x4*)(H8 + (size_t)t * DM + lane * 16);
        asm volatile("s_waitcnt lgkmcnt(0)" ::: "memory");
        const unsigned char* rp[8];
#pragma unroll
        for (int g = 0; g < 8; ++g) rp[g] = U8 + (size_t)ids[16 * g + r] * DM + q * 16;
        f32x4 acc[8];
#pragma unroll
        for (int g = 0; g < 8; ++g) acc[g] = (f32x4){0.f, 0.f, 0.f, 0.f};
#pragma unroll 2
        for (int s = 0; s < 16; ++s) {
            const i64x2 B = *(const LAS i64x2*)(wl + s * 64 + q * 16);
#pragma unroll
            for (int g = 0; g < 8; ++g) { const i64x2 A = *(const i64x2*)(rp[g] + s * 64);
                acc[g] = __builtin_amdgcn_mfma_f32_16x16x32_fp8_fp8(A[0], B[0], acc[g], 0, 0, 0);
                acc[g] = __builtin_amdgcn_mfma_f32_16x16x32_fp8_fp8(A[1], B[1], acc[g], 0, 0, 0); }
        }
#pragma unroll
        for (int g = 0; g < 8; ++g) { const f32x4 gt = *(const LAS f32x4*)(gts + 16 * g + 4 * q), su = *(const LAS f32x4*)(sus + 16 * g + 4 * q); f32x4 a;
#pragma unroll
            for (int j = 0; j < 4; ++j) a[j] = gt[j] * gelu_tanh(acc[g][j] * su[j]);
            if (r == 0) *(LAS f32x4*)(act + 16 * g + 4 * q) = a; }
        asm volatile("s_waitcnt lgkmcnt(0)" ::: "memory");
        f32x2 o[8];
#pragma unroll
        for (int i = 0; i < 8; ++i) o[i] = (f32x2){0.f, 0.f};
#pragma unroll 8
        for (int k = 0; k < 128; ++k) {
            const int e = __builtin_amdgcn_readfirstlane(ids[k]); const float a = act[k]; const f32x2 a2 = (f32x2){a, a};
            const u32x4 v = *(const u32x4*)(V8 + (size_t)e * DM + lane * 16);
            o[0] += __builtin_amdgcn_cvt_pk_f32_fp8((int)v.x, false) * a2; o[1] += __builtin_amdgcn_cvt_pk_f32_fp8((int)v.x, true) * a2;
            o[2] += __builtin_amdgcn_cvt_pk_f32_fp8((int)v.y, false) * a2; o[3] += __builtin_amdgcn_cvt_pk_f32_fp8((int)v.y, true) * a2;
            o[4] += __builtin_amdgcn_cvt_pk_f32_fp8((int)v.z, false) * a2; o[5] += __builtin_amdgcn_cvt_pk_f32_fp8((int)v.z, true) * a2;
            o[6] += __builtin_amdgcn_cvt_pk_f32_fp8((int)v.w, false) * a2; o[7] += __builtin_amdgcn_cvt_pk_f32_fp8((int)v.w, true) * a2;
        }
        float* row = p.out + (size_t)t * DM + lane * 16;
        f32x4 y[4]; float sm = 0.f;
#pragma unroll
        for (int j = 0; j < 4; ++j) { y[j] = *(const f32x4*)(row + 4 * j) * ALPHA + (f32x4){o[2 * j][0], o[2 * j][1], o[2 * j + 1][0], o[2 * j + 1][1]}; sm += (y[j][0] + y[j][1]) + (y[j][2] + y[j][3]); }
        const float mean = wave_sum(sm) * (1.0f / DM); float s2 = 0.f;
#pragma unroll
        for (int j = 0; j < 4; ++j) { y[j] = y[j] - mean; s2 += (y[j][0] * y[j][0] + y[j][1] * y[j][1]) + (y[j][2] * y[j][2] + y[j][3] * y[j][3]); }
        const float rstd = 1.0f / sqrtf(wave_sum(s2) * (1.0f / DM) + LN_EPS);
#pragma unroll
        for (int j = 0; j < 4; ++j) { const f32x4 gg = *(const f32x4*)(p.ln2_g + lane * 16 + 4 * j), bb = *(const f32x4*)(p.ln2_b + lane * 16 + 4 * j);
            *(f32x4*)(row + 4 * j) = y[j] * rstd * gg + bb; }
        asm volatile("s_waitcnt lgkmcnt(0)" ::: "memory");
    }
}

__global__ void __launch_bounds__(NT, 2) mega(Params p) {
    extern __shared__ __attribute__((aligned(16))) unsigned char lds[];
    cg::grid_group grid = cg::this_grid();
    unsigned char* ws = p.ws;
    const int G = gridDim.x;

    phase0(p, lds);
    grid.sync();

    {
        pg8::Gemm g{(const bf16*)(ws + WS_XB), (const bf16*)(ws + WS_WIN), MTOK, NPROJ, DM}; pg8::StaticOrder S; S.init(MTOK, NPROJ, G, (int)blockIdx.x);
        pg8::EpiProj E{(bf16*)(ws + WS_PROJ)};
        pg8::gemm_phase<pg8::EpiProj, pg8::StaticOrder, true, true>((PG8_LAS unsigned char*)lds, g, S, E);
    }
    grid.sync();

    {
        const int half = G / 2;
        if ((int)blockIdx.x < half) { for (int it = blockIdx.x; it < 128; it += half) hgrn_naive_item(p, lds, it); }
        else { for (int it = blockIdx.x - half; it < 2048; it += G - half) gmlp_naive_item(p, lds, it); }
    }
    grid.sync();
    hgrn_finalize(p);
    grid.sync();

    {
        pg8::Gemm g{(const bf16*)(ws + WS_Y), (const bf16*)(ws + WS_WOUT), MTOK, DM, DM}; pg8::StaticOrder S; S.init(MTOK, DM, G, (int)blockIdx.x);
        pg8::EpiPre E{p.x, p.out};
        pg8::gemm_phase<pg8::EpiPre, pg8::StaticOrder, true, true>((PG8_LAS unsigned char*)lds, g, S, E);
    }
    grid.sync();
    ln1_pass(p);
    tables_to_fp8(p);
    grid.sync();

    {
        pg8::Gemm g{(const bf16*)(ws + WS_XB), (const bf16*)(ws + WS_WSC), MTOK, NSC, DM}; pg8::StaticOrder S; S.init(MTOK, NSC, G, (int)blockIdx.x);
        pg8::EpiF32 E{(float*)(ws + WS_SC), NSC};
        pg8::gemm_phase<pg8::EpiF32, pg8::StaticOrder, true, true>((PG8_LAS unsigned char*)lds, g, S, E);
    }
    grid.sync();
    topk_phase(p, lds);
    grid.sync();
    peer_phase(p, lds);
}

extern "C" void kernel_launch(void* const* d_in, const int* in_sizes, int n_in, void* d_out, int out_size, void* d_ws, size_t ws_size, hipStream_t stream) {
    static int grid = 0;
    if (grid == 0) {
        if (n_in != 18 || in_sizes[0] != MTOK * DM || out_size != MTOK * DM || ws_size < WS_END) {
            fprintf(stderr, "kernel_launch: unexpected shapes (n_in %d, in0 %d, out %d, ws %zu); nothing launched\n", n_in, n_in > 0 ? in_sizes[0] : -1, out_size, ws_size); grid = -1; return; }
        int dev = 0, cus = 0, per_cu = 0;
        if (hipGetDevice(&dev) != hipSuccess || hipDeviceGetAttribute(&cus, hipDeviceAttributeMultiprocessorCount, dev) != hipSuccess) { grid = -1; return; }
        if (hipFuncSetAttribute((const void*)mega, hipFuncAttributeMaxDynamicSharedMemorySize, LDS_BYTES) != hipSuccess) { fprintf(stderr, "kernel_launch: hipFuncSetAttribute failed\n"); grid = -1; return; }
        if (hipOccupancyMaxActiveBlocksPerMultiprocessor(&per_cu, (const void*)mega, NT, LDS_BYTES) != hipSuccess || per_cu < 1) { fprintf(stderr, "kernel_launch: occupancy query says %d\n", per_cu); grid = -1; return; }
        grid = cus;
    }
    if (grid < 0) return;
    Params p{};
    p.x = (const float*)d_in[0]; p.w_in = (const float*)d_in[1]; p.lb_logits = (const float*)d_in[2]; p.hg_norm_g = (const float*)d_in[3];
    p.gm_ln_g = (const float*)d_in[4]; p.gm_ln_b = (const float*)d_in[5]; p.gm_ws = (const float*)d_in[6]; p.gm_bs = (const float*)d_in[7];
    p.w_out = (const float*)d_in[8]; p.ln1_g = (const float*)d_in[9]; p.ln1_b = (const float*)d_in[10]; p.wq = (const float*)d_in[11];
    p.k1 = (const float*)d_in[12]; p.k2 = (const float*)d_in[13]; p.pu = (const float*)d_in[14]; p.pv = (const float*)d_in[15];
    p.ln2_g = (const float*)d_in[16]; p.ln2_b = (const float*)d_in[17];
    p.out = (float*)d_out; p.ws = (unsigned char*)d_ws;
    void* args[] = {&p};
    hipError_t e = hipLaunchCooperativeKernel((const void*)mega, dim3(grid), dim3(NT), args, LDS_BYTES, stream);
    if (e != hipSuccess) fprintf(stderr, "kernel_launch: cooperative launch failed: %s (grid %d)\n", hipGetErrorString(e), grid);
}
```

```cpp
#include <hip/hip_runtime.h>
#include <hip/hip_cooperative_groups.h>
#include <cstdio>
#include <cstdint>
namespace cg = cooperative_groups;

namespace pg8 {
#define PG8_LAS __attribute__((address_space(3)))
typedef unsigned short bf16_t;
typedef short bf16x8 __attribute__((ext_vector_type(8)));
typedef float f32x4 __attribute__((ext_vector_type(4)));
typedef unsigned u32x4 __attribute__((ext_vector_type(4)));
constexpr int BM = 256, BK = 64, HALF = 128, HTB = HALF * BK * 2  , STAGE_BYTES = 8 * HTB, NXCD = 8, WGM = 8;

__host__ __device__ __forceinline__ int lds_byte(int r, int c) { const int st = (r >> 4) * 2 + (c >> 5), rr = r & 15, cc = c & 31, ob = rr * 64 + cc * 2; return st * 1024 + (ob ^ (((ob >> 9) & 1) << 5)); }
__host__ __device__ __forceinline__ void stage_rc(int b, int& R, int& C) { const int st = b / 1024, sb = b % 1024, swz = sb ^ (((sb >> 9) & 1) << 5); R = (st >> 1) * 16 + swz / 64; C = (st & 1) * 32 + (swz % 64) / 2; }
__host__ __device__ __forceinline__ int perm32(int rho) { const int n = rho >> 4, i = rho & 15; return 8 * (i >> 2) + 4 * n + (i & 3); }

struct Unit { int pm, pn; };
struct Gemm { const bf16_t* A; const bf16_t* Bt; int M, N, K; };

struct StaticOrder {
    int nM, nN, nwg, G, c;
    __host__ __device__ void init(int M, int N, int G_, int c_) { nM = M / BM; nN = N / BM; nwg = nM * nN; G = G_; c = c_; }
    __host__ __device__ bool next(int i, Unit& u) const {
        const long L = (long)i * G + c; if (L >= nwg) return false;
        int wgid = (int)L; { const int q = nwg / NXCD, r = nwg % NXCD, xcd = wgid % NXCD, off = wgid / NXCD; wgid = (xcd < r ? xcd * (q + 1) : r * (q + 1) + (xcd - r) * q) + off; }
        const int nig = WGM * nN, gid = wgid / nig, fm = gid * WGM, gsz = (nM - fm) < WGM ? (nM - fm) : WGM;
        u.pm = fm + ((wgid % nig) % gsz); u.pn = (wgid % nig) / gsz; return true;
    }
    __device__ __forceinline__ void a_ready(const Unit&) const {}
    __device__ __forceinline__ void done(const Unit&) const {}
};
__device__ __forceinline__ unsigned cvt_pk_bf16(float lo, float hi) { unsigned r; asm volatile("v_cvt_pk_bf16_f32 %0, %1, %2" : "=v"(r) : "v"(lo), "v"(hi)); return r; }
template <class Epi, class Sched, bool ALIGN_EPI = false, bool SP2 = false>
__device__ __forceinline__ void gemm_phase(PG8_LAS unsigned char* lds, const Gemm g, const Sched& S, const Epi& E) {
    const int tid = threadIdx.x, wid = __builtin_amdgcn_readfirstlane(tid >> 6), lane = tid & 63, wr = wid >> 2, wc = wid & 3, fr = lane & 15, fq = lane >> 4;
    const int K = g.K, nt = K / BK;
    unsigned voffA[2], voffB[2];
#pragma unroll
    for (int i = 0; i < 2; ++i) { int R, C; stage_rc(tid * 16 + i * 8192, R, C); const int Rb = Epi::PERM ? ((R & ~31) + perm32(R & 31)) : R;
        voffA[i] = (unsigned)(R * K + C) * 2u; voffB[i] = (unsigned)(Rb * K + C) * 2u; }
    const size_t kstep = (size_t)(BK * 2);
    const size_t hstep = (size_t)HALF * K * 2;
    const size_t tstep = 2 * hstep;
    const unsigned ldsw = (unsigned)wid * 1024u;
    const int aoff = lds_byte(wr * 64 + fr, fq * 8), boff = lds_byte(wc * 32 + fr, fq * 8);
#define PG8_SA(b, h) (((b) * 2 + (h)) * HTB)
#define PG8_SB(b, h) ((4 + (b) * 2 + (h)) * HTB)
#define PG8_STAGE(bufoff, gbase, voff) do { _Pragma("unroll") for (int _i = 0; _i < 2; ++_i) \
        __builtin_amdgcn_global_load_lds((const unsigned*)((const char*)(gbase) + (voff)[_i]), (PG8_LAS unsigned*)(lds + (bufoff) + ldsw + _i * 8192), 16, 0, 0); } while (0)
#define PG8_LDA(dst, b, h) do { _Pragma("unroll") for (int m = 0; m < 4; ++m) _Pragma("unroll") for (int k = 0; k < 2; ++k) dst[m][k] = *(const PG8_LAS bf16x8*)(lds + PG8_SA(b, h) + aoff + m * 2048 + k * 1024); } while (0)
#define PG8_LDB(dst, b, h) do { _Pragma("unroll") for (int n = 0; n < 2; ++n) _Pragma("unroll") for (int k = 0; k < 2; ++k) dst[n][k] = *(const PG8_LAS bf16x8*)(lds + PG8_SB(b, h) + boff + n * 2048 + k * 1024); } while (0)
#define PG8_MMA(ai, bj, At, Bt) do { __builtin_amdgcn_s_setprio(1); _Pragma("unroll") for (int m = 0; m < 4; ++m) _Pragma("unroll") for (int n = 0; n < 2; ++n) _Pragma("unroll") for (int k = 0; k < 2; ++k) \
        acc[ai][bj][m][n] = __builtin_amdgcn_mfma_f32_16x16x32_bf16(Bt[n][k], At[m][k], acc[ai][bj][m][n], 0, 0, 0); __builtin_amdgcn_s_setprio(0); } while (0)
#define PG8_WAIT_V(n) asm volatile("s_waitcnt vmcnt(" #n ")" ::: "memory")
#define PG8_WAIT_L(n) asm volatile("s_waitcnt lgkmcnt(" #n ")" ::: "memory")
#define PG8_BAR __builtin_amdgcn_s_barrier()
#define PG8_SCHED __builtin_amdgcn_sched_barrier(0)
    Unit cur, nxt; int ui = 0;
    if (!S.next(0, cur)) return;
    f32x4 acc[2][2][4][2];
#pragma unroll
    for (int a = 0; a < 2; ++a)
#pragma unroll
        for (int b = 0; b < 2; ++b)
#pragma unroll
            for (int m = 0; m < 4; ++m)
#pragma unroll
                for (int n = 0; n < 2; ++n) acc[a][b][m][n] = (f32x4){0.f, 0.f, 0.f, 0.f};
    bf16x8 At[4][2], B0[2][2], B1[2][2];
    const char* cA = (const char*)g.A + (size_t)cur.pm * tstep; const char* cB = (const char*)g.Bt + (size_t)cur.pn * tstep;
    S.a_ready(cur);
    if constexpr (SP2) {
        PG8_STAGE(PG8_SB(0, 0), cB, voffB); PG8_STAGE(PG8_SB(0, 1), cB + hstep, voffB); PG8_STAGE(PG8_SA(0, 0), cA, voffA); PG8_STAGE(PG8_SA(0, 1), cA + hstep, voffA);
        if (wr == 1) PG8_BAR;
        PG8_WAIT_V(2); PG8_BAR;
        PG8_STAGE(PG8_SB(1, 0), cB + kstep, voffB); PG8_STAGE(PG8_SA(1, 0), cA + kstep, voffA); PG8_STAGE(PG8_SB(1, 1), cB + hstep + kstep, voffB);
        PG8_WAIT_V(6); PG8_BAR;
    } else {
        PG8_STAGE(PG8_SB(0, 0), cB, voffB); PG8_STAGE(PG8_SA(0, 0), cA, voffA); PG8_STAGE(PG8_SB(0, 1), cB + hstep, voffB); PG8_STAGE(PG8_SA(0, 1), cA + hstep, voffA);
        if (wr == 1) PG8_BAR;
        PG8_WAIT_V(4); PG8_BAR;
        PG8_STAGE(PG8_SB(1, 0), cB + kstep, voffB); PG8_STAGE(PG8_SA(1, 0), cA + kstep, voffA); PG8_STAGE(PG8_SB(1, 1), cB + hstep + kstep, voffB);
        PG8_WAIT_V(6); PG8_BAR;
    }
    for (;;) {
        const bool has_next = S.next(ui + 1, nxt);
        const char* nA = has_next ? (const char*)g.A + (size_t)nxt.pm * tstep : cA; const char* nB = has_next ? (const char*)g.Bt + (size_t)nxt.pn * tstep : cB;
        for (int t = 0; t < nt; t += 2) {
            const bool last = (t == nt - 2);
            const char* a1 = cA + (size_t)(t + 1) * kstep;
            const char* a2 = last ? nA : cA + (size_t)(t + 2) * kstep; const char* b2 = last ? nB : cB + (size_t)(t + 2) * kstep;
            const char* a3 = a2 + kstep; const char* b3 = b2 + kstep;
            if (last && has_next) S.a_ready(nxt);
            if constexpr (SP2) {
            PG8_LDB(B0, 0, 0); PG8_LDB(B1, 0, 1); PG8_SCHED; PG8_LDA(At, 0, 0); PG8_STAGE(PG8_SA(1, 1), a1 + hstep, voffA);
            PG8_WAIT_V(8); PG8_WAIT_L(0); PG8_BAR; PG8_MMA(0, 0, At, B0); PG8_MMA(0, 1, At, B1); PG8_BAR; PG8_SCHED;
            PG8_LDA(At, 0, 1); PG8_STAGE(PG8_SB(0, 0), b2, voffB); PG8_STAGE(PG8_SB(0, 1), b2 + hstep, voffB); PG8_STAGE(PG8_SA(0, 0), a2, voffA);
            PG8_WAIT_V(8); PG8_WAIT_L(0); PG8_BAR; PG8_MMA(1, 0, At, B0); PG8_MMA(1, 1, At, B1); PG8_BAR; PG8_SCHED;
            PG8_LDB(B0, 1, 0); PG8_LDB(B1, 1, 1); PG8_SCHED; PG8_LDA(At, 1, 0); PG8_STAGE(PG8_SA(0, 1), a2 + hstep, voffA);
            PG8_WAIT_V(8); PG8_WAIT_L(0); PG8_BAR; PG8_MMA(0, 0, At, B0); PG8_MMA(0, 1, At, B1); PG8_BAR; PG8_SCHED;
            PG8_LDA(At, 1, 1); PG8_STAGE(PG8_SB(1, 0), b3, voffB); PG8_STAGE(PG8_SB(1, 1), b3 + hstep, voffB); PG8_STAGE(PG8_SA(1, 0), a3, voffA);
            PG8_WAIT_V(8); PG8_WAIT_L(0); PG8_BAR; PG8_MMA(1, 0, At, B0); PG8_MMA(1, 1, At, B1); PG8_BAR; PG8_SCHED;
            } else {
            PG8_LDB(B0, 0, 0); PG8_SCHED; PG8_LDA(At, 0, 0); PG8_STAGE(PG8_SA(1, 1), a1 + hstep, voffA);
            PG8_WAIT_L(8); PG8_BAR; PG8_WAIT_L(0); PG8_MMA(0, 0, At, B0); PG8_BAR; PG8_SCHED;
            PG8_LDB(B1, 0, 1); PG8_STAGE(PG8_SB(0, 0), b2, voffB);
            PG8_BAR; PG8_WAIT_L(0); PG8_MMA(0, 1, At, B1); PG8_BAR;
            PG8_LDA(At, 0, 1); PG8_STAGE(PG8_SA(0, 0), a2, voffA);
            PG8_BAR; PG8_WAIT_L(0); PG8_MMA(1, 0, At, B0); PG8_BAR; PG8_SCHED;
            PG8_STAGE(PG8_SB(0, 1), b2 + hstep, voffB);
            PG8_WAIT_V(6); PG8_BAR; PG8_MMA(1, 1, At, B1); PG8_BAR;
            PG8_LDB(B0, 1, 0); PG8_SCHED; PG8_LDA(At, 1, 0); PG8_STAGE(PG8_SA(0, 1), a2 + hstep, voffA);
            PG8_WAIT_L(8); PG8_BAR; PG8_WAIT_L(0); PG8_MMA(0, 0, At, B0); PG8_BAR; PG8_SCHED;
            PG8_LDB(B1, 1, 1); PG8_STAGE(PG8_SB(1, 0), b3, voffB);
            PG8_BAR; PG8_WAIT_L(0); PG8_MMA(0, 1, At, B1); PG8_BAR;
            PG8_LDA(At, 1, 1); PG8_STAGE(PG8_SA(1, 0), a3, voffA);
            PG8_BAR; PG8_WAIT_L(0); PG8_MMA(1, 0, At, B0); PG8_BAR; PG8_SCHED;
            PG8_STAGE(PG8_SB(1, 1), b3 + hstep, voffB);
            PG8_WAIT_V(6); PG8_BAR; PG8_MMA(1, 1, At, B1); PG8_BAR;
            }
        }
        if constexpr (ALIGN_EPI) { if (wr == 0) PG8_BAR; }
        if constexpr (!Epi::AFTER_DRAIN) { E(acc, cur, wr, wc, fr, fq); S.done(cur); }
        if (!has_next) break;
#pragma unroll
        for (int a = 0; a < 2; ++a)
#pragma unroll
            for (int b = 0; b < 2; ++b)
#pragma unroll
                for (int m = 0; m < 4; ++m)
#pragma unroll
                    for (int n = 0; n < 2; ++n) acc[a][b][m][n] = (f32x4){0.f, 0.f, 0.f, 0.f};
        cur = nxt; cA = nA; cB = nB; ++ui;
        if constexpr (ALIGN_EPI) { if (wr == 1) PG8_BAR; }
    }
    PG8_WAIT_V(0);
    if constexpr (!ALIGN_EPI) { if (wr == 0) PG8_BAR; }
    PG8_BAR;
    if constexpr (Epi::AFTER_DRAIN) { E.fused(acc, cur, wr, wc, fr, fq, lds, wid, lane); S.done(cur); }
#undef PG8_SA
#undef PG8_SB
#undef PG8_STAGE
#undef PG8_LDA
#undef PG8_LDB
#undef PG8_MMA
#undef PG8_WAIT_V
#undef PG8_WAIT_L
#undef PG8_BAR
#undef PG8_SCHED
}
}

constexpr int NT = 512, NWAVES = 8;
constexpr int LDS_BYTES = 147456;
constexpr int MTOK = 65536, DM = 1024, SEQ = 4096, NBATCH = 16;
constexpr int NPROJ = 3584;
constexpr int C_Q = 0, C_ZF = 512, C_ZB = 1024, C_I = 1536, C_G = 2048, C_U = 2560, C_V = 3072;
constexpr int NSC = 2048;
constexpr float ALPHA = 1.189207115002721f;
constexpr float LN_EPS = 1e-5f, RMS_EPS = 1e-6f;

constexpr size_t MiB = 1u << 20;
constexpr size_t WS_WIN = 1 * MiB;
constexpr size_t WS_WOUT = 8 * MiB;
constexpr size_t WS_WSC = 10 * MiB;
constexpr size_t WS_XB = 16 * MiB;
constexpr size_t WS_PROJ = 144 * MiB;
constexpr size_t WS_Y = 592 * MiB;
constexpr size_t WS_OF = 720 * MiB;
constexpr size_t WS_OB = 848 * MiB;
constexpr size_t WS_SC = 144 * MiB;
constexpr size_t WS_EID = 720 * MiB;
constexpr size_t WS_GATE = 752 * MiB;
constexpr size_t WS_U8 = 656 * MiB;
constexpr size_t WS_V8 = 672 * MiB;
constexpr size_t WS_SU = 688 * MiB;
constexpr size_t WS_SV = 689 * MiB;
constexpr size_t WS_HS = 690 * MiB;
constexpr size_t WS_H8 = 784 * MiB;
constexpr size_t WS_END = 976 * MiB;

typedef unsigned short bf16;
typedef float f32x4 __attribute__((ext_vector_type(4)));
typedef unsigned u32x4 __attribute__((ext_vector_type(4)));
#define LAS __attribute__((address_space(3)))

__device__ __forceinline__ unsigned f2bf(float f) { unsigned u = __float_as_uint(f); return (u + 0x7fffu + ((u >> 16) & 1u)) >> 16; }
__device__ __forceinline__ unsigned pk2(float lo, float hi) { return f2bf(lo) | (f2bf(hi) << 16); }
__device__ __forceinline__ float bflo(unsigned w) { return __uint_as_float(w << 16); }
__device__ __forceinline__ float bfhi(unsigned w) { return __uint_as_float(w & 0xffff0000u); }
__device__ __forceinline__ float sigmoidf_(float z) { return 1.0f / (1.0f + __expf(-z)); }
__device__ __forceinline__ float gelu_tanh(float x) { return x / (1.0f + __expf(-1.5957691216057308f * (x + 0.044715f * x * x * x))); }
__device__ __forceinline__ float silu_(float x) { return x / (1.0f + __expf(-x)); }
__device__ __forceinline__ float wave_sum(float v) {
#pragma unroll
    for (int o = 1; o < 64; o <<= 1) v += __shfl_xor(v, o);
    return v;
}

__device__ __forceinline__ float wave_max(float v) {
#pragma unroll
    for (int o = 1; o < 64; o <<= 1) v = fmaxf(v, __shfl_xor(v, o));
    return v;
}
__device__ __forceinline__ unsigned pk4_fp8(float a, float b, float c, float d) { int w = __builtin_amdgcn_cvt_pk_fp8_f32(a, b, 0, false); w = __builtin_amdgcn_cvt_pk_fp8_f32(c, d, w, true); return (unsigned)w; }

struct Params {
    const float *x, *w_in, *lb_logits, *hg_norm_g, *gm_ln_g, *gm_ln_b, *gm_ws, *gm_bs, *w_out, *ln1_g, *ln1_b, *wq, *k1, *k2, *pu, *pv, *ln2_g, *ln2_b;
    float* out; unsigned char* ws;
};

namespace pg8 {
struct EpiProj {
    static constexpr bool PERM = true, AFTER_DRAIN = false;
    bf16* O;
    __device__ __forceinline__ void operator()(const f32x4 (&acc)[2][2][4][2], const Unit& u, int wr, int wc, int fr, int fq) const {
        const int row0 = u.pm * BM + wr * 64 + fr, col0 = u.pn * BM + wc * 32 + 8 * fq;
        const int act = u.pn >= 10 ? 2 : (u.pn >= 8 ? 1 : 0);
#pragma unroll
        for (int ai = 0; ai < 2; ++ai)
#pragma unroll
            for (int m = 0; m < 4; ++m) { bf16* rowp = O + (size_t)(row0 + ai * HALF + m * 16) * NPROJ + col0;
#pragma unroll
                for (int bj = 0; bj < 2; ++bj) { f32x4 v0 = acc[ai][bj][m][0], v1 = acc[ai][bj][m][1];
                    if (act == 2) {
#pragma unroll
                        for (int j = 0; j < 4; ++j) { v0[j] = gelu_tanh(v0[j]); v1[j] = gelu_tanh(v1[j]); } }
                    else if (act == 1) {
#pragma unroll
                        for (int j = 0; j < 4; ++j) { v0[j] = silu_(v0[j]); v1[j] = silu_(v1[j]); } }
                    u32x4 w; w.x = cvt_pk_bf16(v0[0], v0[1]); w.y = cvt_pk_bf16(v0[2], v0[3]); w.z = cvt_pk_bf16(v1[0], v1[1]); w.w = cvt_pk_bf16(v1[2], v1[3]);
                    *(u32x4*)(rowp + bj * HALF) = w; } }
    }
};
struct EpiPre {
    static constexpr bool PERM = false, AFTER_DRAIN = false;
    const float* X; float* P;
    __device__ __forceinline__ void operator()(const f32x4 (&acc)[2][2][4][2], const Unit& u, int wr, int wc, int fr, int fq) const {
        const int row0 = u.pm * BM + wr * 64 + fr, col0 = u.pn * BM + wc * 32 + 4 * fq;
#pragma unroll
        for (int ai = 0; ai < 2; ++ai)
#pragma unroll
            for (int m = 0; m < 4; ++m) { const size_t off = (size_t)(row0 + ai * HALF + m * 16) * DM + col0;
#pragma unroll
                for (int bj = 0; bj < 2; ++bj)
#pragma unroll
                    for (int n = 0; n < 2; ++n) { const f32x4 xv = *(const f32x4*)(X + off + bj * HALF + n * 16);
                        *(f32x4*)(P + off + bj * HALF + n * 16) = xv * ALPHA + acc[ai][bj][m][n]; } }
    }
};
struct EpiF32 {
    static constexpr bool PERM = false, AFTER_DRAIN = false;
    float* C; int ldc;
    __device__ __forceinline__ void operator()(const f32x4 (&acc)[2][2][4][2], const Unit& u, int wr, int wc, int fr, int fq) const {
        const int row0 = u.pm * BM + wr * 64 + fr, col0 = u.pn * BM + wc * 32 + 4 * fq;
#pragma unroll
        for (int ai = 0; ai < 2; ++ai)
#pragma unroll
            for (int m = 0; m < 4; ++m) { float* rowp = C + (size_t)(row0 + ai * HALF + m * 16) * ldc + col0;
#pragma unroll
                for (int bj = 0; bj < 2; ++bj)
#pragma unroll
                    for (int n = 0; n < 2; ++n) *(f32x4*)(rowp + bj * HALF + n * 16) = acc[ai][bj][m][n]; }
    }
};
}

__device__ __forceinline__ void p0_transpose_item(const float* W, int K, int N, bf16* WT, LAS float* scr, int item, int lane) {
    const int nblk = N / 32, kb = item / nblk, nb = item % nblk, k0 = 64 * kb, n0 = 32 * nb;
#pragma unroll 8
    for (int i = 0; i < 32; ++i) { const int kk = 2 * i + (lane >> 5); scr[kk * 33 + (lane & 31)] = W[(size_t)(k0 + kk) * N + n0 + (lane & 31)]; }
    asm volatile("s_waitcnt lgkmcnt(0)" ::: "memory");
    const int c = lane & 7;
#pragma unroll
    for (int j = 0; j < 4; ++j) { const int n = (lane >> 3) + 8 * j; const LAS float* s = scr + (8 * c) * 33 + n;
        u32x4 o; o.x = pk2(s[0 * 33], s[1 * 33]); o.y = pk2(s[2 * 33], s[3 * 33]); o.z = pk2(s[4 * 33], s[5 * 33]); o.w = pk2(s[6 * 33], s[7 * 33]);
        *(u32x4*)(WT + (size_t)(n0 + n) * K + k0 + 8 * c) = o; }
    asm volatile("s_waitcnt lgkmcnt(0)" ::: "memory");
}

__device__ __forceinline__ void phase0(const Params& p, unsigned char* lds_g) {
    const int tid = threadIdx.x, lane = tid & 63, wave = tid >> 6;
    unsigned char* ws = p.ws;
    {
        const size_t n8 = (size_t)MTOK * DM / 8, gsz = (size_t)gridDim.x * NT;
        const f32x4* x4 = (const f32x4*)p.x; u32x4* o = (u32x4*)(ws + WS_XB);
        for (size_t i = (size_t)blockIdx.x * NT + tid; i < n8; i += gsz) { const f32x4 a = x4[2 * i], b = x4[2 * i + 1];
            u32x4 w; w.x = pk2(a[0], a[1]); w.y = pk2(a[2], a[3]); w.z = pk2(b[0], b[1]); w.w = pk2(b[2], b[3]); o[i] = w; }
    }
    {
        LAS float* scr = (LAS float*)(lds_g + wave * 16384);
        const int gw = blockIdx.x * NWAVES + wave, NGW = gridDim.x * NWAVES;
        constexpr int I_IN = (DM / 64) * (NPROJ / 32), I_OUT = (DM / 64) * (DM / 32);
        for (int it = gw; it < I_IN + I_OUT; it += NGW) {
            if (it < I_IN) p0_transpose_item(p.w_in, DM, NPROJ, (bf16*)(ws + WS_WIN), scr, it, lane);
            else p0_transpose_item(p.w_out, DM, DM, (bf16*)(ws + WS_WOUT), scr, it - I_IN, lane);
        }
    }
    __syncthreads();
    {
        float* Ks = (float*)lds_g;
        float* Ws = (float*)(lds_g + 128 * 132 * 4);
        bf16* WscT = (bf16*)(ws + WS_WSC);
        for (int it = blockIdx.x; it < 256; it += gridDim.x) {
            const int combo = it >> 4, dt = it & 15, h = combo >> 1, half = combo & 1, d0 = dt * 64;
            const float* kp = (half ? p.k2 : p.k1) + (size_t)h * 128 * 128;
            for (int i = tid; i < 128 * 128; i += NT) Ks[(i >> 7) * 132 + (i & 127)] = kp[i];
            for (int i = tid; i < 64 * 128; i += NT) Ws[i] = p.wq[(size_t)(d0 + (i >> 7)) * 2048 + h * 256 + half * 128 + (i & 127)];
            __syncthreads();
            const int key = tid & 127, dg = tid >> 7;
            float acc[16];
#pragma unroll
            for (int i = 0; i < 16; ++i) acc[i] = 0.f;
            for (int j = 0; j < 128; j += 4) {
                const f32x4 kv = *(const f32x4*)(Ks + key * 132 + j);
#pragma unroll
                for (int i = 0; i < 16; ++i) { const f32x4 wv = *(const f32x4*)(Ws + (dg * 16 + i) * 128 + j);
                    acc[i] += kv[0] * wv[0] + kv[1] * wv[1] + kv[2] * wv[2] + kv[3] * wv[3]; }
            }
            bf16* orow = WscT + (size_t)(h * 256 + half * 128 + key) * DM + d0 + dg * 16;
            u32x4 w0, w1; w0.x = pk2(acc[0], acc[1]); w0.y = pk2(acc[2], acc[3]); w0.z = pk2(acc[4], acc[5]); w0.w = pk2(acc[6], acc[7]);
            w1.x = pk2(acc[8], acc[9]); w1.y = pk2(acc[10], acc[11]); w1.z = pk2(acc[12], acc[13]); w1.w = pk2(acc[14], acc[15]);
            *(u32x4*)orow = w0; *(u32x4*)(orow + 8) = w1;
            __syncthreads();
        }
    }
}

typedef float f32x16 __attribute__((ext_vector_type(16)));
typedef float f32x2v __attribute__((ext_vector_type(2)));
typedef __bf16 bf16x2v __attribute__((ext_vector_type(2)));
typedef short s16x8 __attribute__((ext_vector_type(8)));
typedef short s16x4 __attribute__((ext_vector_type(4)));
typedef unsigned u32x2 __attribute__((ext_vector_type(2)));
__device__ __forceinline__ unsigned pkbf(float lo, float hi) { return __builtin_bit_cast(unsigned, __builtin_convertvector((f32x2v){lo, hi}, bf16x2v)); }
#define MFMA32(a, b, c) __builtin_amdgcn_mfma_f32_32x32x16_bf16((a), (b), (c), 0, 0, 0)
#define DPP_MULSTEP(v, ctrl, rmask) v *= __builtin_bit_cast(float, __builtin_amdgcn_update_dpp(0x3f800000, __builtin_bit_cast(int, v), ctrl, rmask, 0xf, false))
constexpr int HG_QT = 0, HG_KT = 17408, HG_QH = 34816;
constexpr int HG_KTT = 52224, HG_VT = 70656;
constexpr int HG_ST = 89088;
constexpr int HG_DEC = 123904;
__device__ __forceinline__ void hgrn_chunk_item(const Params& p, unsigned char* lds_g, int item) {
    const int tid = threadIdx.x, lane = tid & 63, wave = __builtin_amdgcn_readfirstlane(tid >> 6);
    const int b = item >> 3, h = (item >> 1) & 3, dir = item & 1;
    LAS unsigned char* lds = (LAS unsigned char*)lds_g;
    const bf16* proj = (const bf16*)(p.ws + WS_PROJ);
    float* O = (float*)(p.ws + (dir ? WS_OB : WS_OF));
    const int zc = (dir ? C_ZB : C_ZF) + h * 128 + 16 * wave, qc = C_Q + h * 128 + 16 * wave, vc = C_I + h * 128 + 16 * wave;
    float lb[16];
#pragma unroll
    for (int i = 0; i < 16; ++i) { const int c = h * 128 + 16 * wave + i; const float l0 = p.lb_logits[(dir * 2 + 0) * 512 + c], l1 = p.lb_logits[(dir * 2 + 1) * 512 + c]; lb[i] = 1.0f / (1.0f + __expf(l1 - l0)); }
    const int eb = wave >> 1, tb = wave & 1, r32 = lane & 31, hq = lane >> 5;
#define HG_TOKROW(c_, l_) ((size_t)b * SEQ + (dir ? (SEQ - 1 - ((c_) * 64 + (l_))) : ((c_) * 64 + (l_))))
    u32x4 zr0, zr1, qr0, qr1, vr0, vr1;
#define HG_LOAD(c_) do { const bf16* pr_ = proj + HG_TOKROW(c_, lane) * NPROJ; zr0 = *(const u32x4*)(pr_ + zc); zr1 = *(const u32x4*)(pr_ + zc + 8); \
        qr0 = *(const u32x4*)(pr_ + qc); qr1 = *(const u32x4*)(pr_ + qc + 8); vr0 = *(const u32x4*)(pr_ + vc); vr1 = *(const u32x4*)(pr_ + vc + 8); } while (0)
    HG_LOAD(0);
    f32x16 S0, S1;
#pragma unroll
    for (int i = 0; i < 16; ++i) { S0[i] = 0.f; S1[i] = 0.f; }
    for (int c = 0; c < SEQ / 64; ++c) {
        {
            const unsigned zw[8] = {zr0.x, zr0.y, zr0.z, zr0.w, zr1.x, zr1.y, zr1.z, zr1.w};
            const unsigned qw[8] = {qr0.x, qr0.y, qr0.z, qr0.w, qr1.x, qr1.y, qr1.z, qr1.w};
            const unsigned vw[8] = {vr0.x, vr0.y, vr0.z, vr0.w, vr1.x, vr1.y, vr1.z, vr1.w};
            unsigned qtw[8], ktw[8], qhw[8]; float dec[16];
#pragma unroll
            for (int j = 0; j < 8; ++j) {
                float qt2[2], kt2[2], qh2[2];
#pragma unroll
                for (int u = 0; u < 2; ++u) {
                    const int d = 2 * j + u;
                    const float z = fminf(fmaxf(u ? bfhi(zw[j]) : bflo(zw[j]), -80.0f), 80.0f), q = u ? bfhi(qw[j]) : bflo(qw[j]);
                    const float ez = __expf(-z), sg = __builtin_amdgcn_rcpf(1.0f + ez), oml = 1.0f - lb[d];
                    const float f = lb[d] + oml * sg, kk = oml * ez * sg;
                    float P = f;
                    DPP_MULSTEP(P, 0x111, 0xf); DPP_MULSTEP(P, 0x112, 0xf); DPP_MULSTEP(P, 0x114, 0xf); DPP_MULSTEP(P, 0x118, 0xf);
                    DPP_MULSTEP(P, 0x142, 0xa); DPP_MULSTEP(P, 0x143, 0xc);
                    const float P63 = __builtin_bit_cast(float, __builtin_amdgcn_readlane(__builtin_bit_cast(int, P), 63));
                    const float iP63 = __builtin_amdgcn_rcpf(P63);
                    qh2[u] = q * P; qt2[u] = qh2[u] * iP63; kt2[u] = kk * P63 * __builtin_amdgcn_rcpf(P); dec[d] = P63;
                }
                qtw[j] = pkbf(qt2[0], qt2[1]); ktw[j] = pkbf(kt2[0], kt2[1]); qhw[j] = pkbf(qh2[0], qh2[1]);
            }
            const int ro = lane * 272 + wave * 32;
            *(LAS u32x4*)(lds + HG_QT + ro) = (u32x4){qtw[0], qtw[1], qtw[2], qtw[3]}; *(LAS u32x4*)(lds + HG_QT + ro + 16) = (u32x4){qtw[4], qtw[5], qtw[6], qtw[7]};
            *(LAS u32x4*)(lds + HG_KT + ro) = (u32x4){ktw[0], ktw[1], ktw[2], ktw[3]}; *(LAS u32x4*)(lds + HG_KT + ro + 16) = (u32x4){ktw[4], ktw[5], ktw[6], ktw[7]};
            *(LAS u32x4*)(lds + HG_QH + ro) = (u32x4){qhw[0], qhw[1], qhw[2], qhw[3]}; *(LAS u32x4*)(lds + HG_QH + ro + 16) = (u32x4){qhw[4], qhw[5], qhw[6], qhw[7]};
#pragma unroll
            for (int j = 0; j < 8; ++j) {
                *(LAS unsigned short*)(lds + HG_KTT + (16 * wave + 2 * j) * 144 + 2 * lane) = (unsigned short)(ktw[j] & 0xffffu);
                *(LAS unsigned short*)(lds + HG_KTT + (16 * wave + 2 * j + 1) * 144 + 2 * lane) = (unsigned short)(ktw[j] >> 16);
                *(LAS unsigned short*)(lds + HG_VT + (16 * wave + 2 * j) * 144 + 2 * lane) = (unsigned short)(vw[j] & 0xffffu);
                *(LAS unsigned short*)(lds + HG_VT + (16 * wave + 2 * j + 1) * 144 + 2 * lane) = (unsigned short)(vw[j] >> 16);
            }
            if (lane == 0) {
#pragma unroll
                for (int g = 0; g < 4; ++g) *(LAS f32x4*)(lds + HG_DEC + (16 * wave + 4 * g) * 4) = (f32x4){dec[4 * g], dec[4 * g + 1], dec[4 * g + 2], dec[4 * g + 3]};
            }
#pragma unroll
            for (int g = 0; g < 4; ++g) {
                *(LAS u32x2*)(lds + HG_ST + (32 * eb + r32) * 272 + (32 * (2 * tb) + 8 * g + 4 * hq) * 2) = (u32x2){pkbf(S0[4 * g], S0[4 * g + 1]), pkbf(S0[4 * g + 2], S0[4 * g + 3])};
                *(LAS u32x2*)(lds + HG_ST + (32 * eb + r32) * 272 + (32 * (2 * tb + 1) + 8 * g + 4 * hq) * 2) = (u32x2){pkbf(S1[4 * g], S1[4 * g + 1]), pkbf(S1[4 * g + 2], S1[4 * g + 3])};
            }
        }
        if (c + 1 < SEQ / 64) HG_LOAD(c + 1);
        __syncthreads();
        {
            f32x4 dv0[4], dv1[4];
#pragma unroll
            for (int g = 0; g < 4; ++g) { dv0[g] = *(const LAS f32x4*)(lds + HG_DEC + (32 * (2 * tb) + 8 * g + 4 * hq) * 4); dv1[g] = *(const LAS f32x4*)(lds + HG_DEC + (32 * (2 * tb + 1) + 8 * g + 4 * hq) * 4); }
#pragma unroll
            for (int g = 0; g < 4; ++g)
#pragma unroll
                for (int j = 0; j < 4; ++j) { S0[4 * g + j] *= dv0[g][j]; S1[4 * g + j] *= dv1[g][j]; }
#pragma unroll
            for (int ks = 0; ks < 4; ++ks) {
                const s16x8 Bv = *(const LAS s16x8*)(lds + HG_VT + (32 * eb + r32) * 144 + (16 * ks + 8 * hq) * 2);
                const s16x8 A0 = *(const LAS s16x8*)(lds + HG_KTT + (32 * (2 * tb) + r32) * 144 + (16 * ks + 8 * hq) * 2);
                const s16x8 A1 = *(const LAS s16x8*)(lds + HG_KTT + (32 * (2 * tb + 1) + r32) * 144 + (16 * ks + 8 * hq) * 2);
                S0 = MFMA32(A0, Bv, S0); S1 = MFMA32(A1, Bv, S1);
            }
        }
        f32x16 Oa;
#pragma unroll
        for (int i = 0; i < 16; ++i) Oa[i] = 0.f;
#pragma unroll
        for (int sb = 0; sb < 2; ++sb) {
            if (sb <= tb) {
                f32x16 X;
#pragma unroll
                for (int i = 0; i < 16; ++i) X[i] = 0.f;
#pragma unroll
                for (int ks = 0; ks < 8; ++ks) {
                    const s16x8 A = *(const LAS s16x8*)(lds + HG_KT + (32 * sb + r32) * 272 + (16 * ks + 8 * hq) * 2);
                    const s16x8 B = *(const LAS s16x8*)(lds + HG_QT + (32 * tb + r32) * 272 + (16 * ks + 8 * hq) * 2);
                    X = MFMA32(A, B, X);
                }
                if (sb == tb) {
#pragma unroll
                    for (int i = 0; i < 16; ++i) { const int srow = (i & 3) + 8 * (i >> 2) + 4 * hq; X[i] = srow <= r32 ? X[i] : 0.f; }
                }
#pragma unroll
                for (int ks = 0; ks < 2; ++ks) {
                    const u32x4 xp = (u32x4){pkbf(X[8 * ks], X[8 * ks + 1]), pkbf(X[8 * ks + 2], X[8 * ks + 3]), pkbf(X[8 * ks + 4], X[8 * ks + 5]), pkbf(X[8 * ks + 6], X[8 * ks + 7])};
                    const s16x4 alo = *(const LAS s16x4*)(lds + HG_VT + (32 * eb + r32) * 144 + (32 * sb + 16 * ks + 4 * hq) * 2);
                    const s16x4 ahi = *(const LAS s16x4*)(lds + HG_VT + (32 * eb + r32) * 144 + (32 * sb + 16 * ks + 8 + 4 * hq) * 2);
                    const s16x8 A = __builtin_shufflevector(alo, ahi, 0, 1, 2, 3, 4, 5, 6, 7);
                    Oa = MFMA32(A, __builtin_bit_cast(s16x8, xp), Oa);
                }
            }
        }
#pragma unroll
        for (int ks = 0; ks < 8; ++ks) {
            const s16x8 A = *(const LAS s16x8*)(lds + HG_ST + (32 * eb + r32) * 272 + (16 * ks + 8 * hq) * 2);
            const s16x8 B = *(const LAS s16x8*)(lds + HG_QH + (32 * tb + r32) * 272 + (16 * ks + 8 * hq) * 2);
            Oa = MFMA32(A, B, Oa);
        }
        {
            float* orow = O + HG_TOKROW(c, 32 * tb + r32) * 512 + h * 128 + 32 * eb + 4 * hq;
#pragma unroll
            for (int g = 0; g < 4; ++g) *(f32x4*)(orow + 8 * g) = (f32x4){Oa[4 * g], Oa[4 * g + 1], Oa[4 * g + 2], Oa[4 * g + 3]};
        }
        __syncthreads();
    }
#undef HG_LOAD
#undef HG_TOKROW
}

__device__ __forceinline__ void gmlp_naive_item(const Params& p, unsigned char* lds_g, int item) {
    const int tid = threadIdx.x, lane = tid & 63, wave = tid >> 6;
    const int g = item & 3, n = (item >> 2) & 31, b = item >> 7;
    float* Wt = (float*)lds_g;
    float* vc = Wt + 128 * 132;
    const bf16* proj = (const bf16*)(p.ws + WS_PROJ);
    bf16* Y = (bf16*)(p.ws + WS_Y);
    const float* Wg = p.gm_ws + (size_t)g * 128 * 128;
    for (int i = tid; i < 128 * 128; i += NT) { const int pp = i >> 7, q = i & 127; Wt[q * 132 + pp] = Wg[i]; }
    const size_t row0 = (size_t)b * SEQ + n * 128;
    for (int pos = wave * 16; pos < wave * 16 + 16; ++pos) {
        const unsigned w = *(const unsigned*)(proj + (row0 + pos) * NPROJ + C_V + g * 128 + lane * 2);
        const float a = bflo(w), c = bfhi(w);
        const float mu = wave_sum(a + c) * (1.0f / 128.0f);
        const float da = a - mu, dc = c - mu;
        const float var = wave_sum(da * da + dc * dc) * (1.0f / 128.0f);
        const float rstd = 1.0f / sqrtf(var + LN_EPS);
        vc[pos * 128 + lane * 2] = da * rstd * p.gm_ln_g[g * 128 + lane * 2] + p.gm_ln_b[g * 128 + lane * 2];
        vc[pos * 128 + lane * 2 + 1] = dc * rstd * p.gm_ln_g[g * 128 + lane * 2 + 1] + p.gm_ln_b[g * 128 + lane * 2 + 1];
    }
    __syncthreads();
    const int c = tid & 127, pg = tid >> 7;
    float acc[32];
#pragma unroll
    for (int i = 0; i < 32; ++i) acc[i] = 0.f;
    for (int q = 0; q < 128; ++q) {
        const float xv = vc[q * 128 + c];
        const float* wp = Wt + q * 132 + pg * 32;
#pragma unroll
        for (int i = 0; i < 32; i += 4) { const f32x4 wv = *(const f32x4*)(wp + i);
#pragma unroll
            for (int j = 0; j < 4; ++j) acc[i + j] += wv[j] * xv; }
    }
#pragma unroll
    for (int i = 0; i < 32; ++i) { const int pp = pg * 32 + i; const size_t row = row0 + pp;
        const float uv = __uint_as_float(((unsigned)proj[row * NPROJ + C_U + g * 128 + c]) << 16);
        Y[row * DM + 512 + g * 128 + c] = (bf16)f2bf(uv * (acc[i] + p.gm_bs[g * 128 + pp])); }
    __syncthreads();
}

__device__ __forceinline__ void hgrn_finalize(const Params& p) {
    const int tid = threadIdx.x, lane = tid & 63, wave = tid >> 6;
    const float* OF = (const float*)(p.ws + WS_OF); const float* OB = (const float*)(p.ws + WS_OB);
    const bf16* proj = (const bf16*)(p.ws + WS_PROJ); bf16* Y = (bf16*)(p.ws + WS_Y);
    for (int t = blockIdx.x * NWAVES + wave; t < MTOK; t += gridDim.x * NWAVES) {
        const f32x4 a0 = *(const f32x4*)(OF + (size_t)t * 512 + lane * 8), a1 = *(const f32x4*)(OF + (size_t)t * 512 + lane * 8 + 4);
        const f32x4 b0 = *(const f32x4*)(OB + (size_t)t * 512 + lane * 8), b1 = *(const f32x4*)(OB + (size_t)t * 512 + lane * 8 + 4);
        const f32x4 o0 = a0 + b0, o1 = a1 + b1;
        float ss = o0[0] * o0[0] + o0[1] * o0[1] + o0[2] * o0[2] + o0[3] * o0[3] + o1[0] * o1[0] + o1[1] * o1[1] + o1[2] * o1[2] + o1[3] * o1[3];
        ss += __shfl_xor(ss, 1); ss += __shfl_xor(ss, 2); ss += __shfl_xor(ss, 4); ss += __shfl_xor(ss, 8);
        const float r = 1.0f / sqrtf(ss * (1.0f / 128.0f) + RMS_EPS);
        const u32x4 gw = *(const u32x4*)(proj + (size_t)t * NPROJ + C_G + lane * 8);
        const f32x4 n0 = *(const f32x4*)(p.hg_norm_g + lane * 8), n1 = *(const f32x4*)(p.hg_norm_g + lane * 8 + 4);
        u32x4 w;
        w.x = pk2(o0[0] * r * n0[0] * bflo(gw.x), o0[1] * r * n0[1] * bfhi(gw.x));
        w.y = pk2(o0[2] * r * n0[2] * bflo(gw.y), o0[3] * r * n0[3] * bfhi(gw.y));
        w.z = pk2(o1[0] * r * n1[0] * bflo(gw.z), o1[1] * r * n1[1] * bfhi(gw.z));
        w.w = pk2(o1[2] * r * n1[2] * bflo(gw.w), o1[3] * r * n1[3] * bfhi(gw.w));
        *(u32x4*)(Y + (size_t)t * DM + lane * 8) = w;
    }
}

__device__ __forceinline__ void ln1_pass(const Params& p) {
    const int tid = threadIdx.x, lane = tid & 63, wave = tid >> 6;
    bf16* H1B = (bf16*)(p.ws + WS_XB);
    for (int t = blockIdx.x * NWAVES + wave; t < MTOK; t += gridDim.x * NWAVES) {
        float* row = p.out + (size_t)t * DM;
        f32x4 v[4]; float s = 0.f;
#pragma unroll
        for (int j = 0; j < 4; ++j) { v[j] = *(const f32x4*)(row + j * 256 + lane * 4); s += (v[j][0] + v[j][1]) + (v[j][2] + v[j][3]); }
        const float mean = wave_sum(s) * (1.0f / DM); float s2 = 0.f;
#pragma unroll
        for (int j = 0; j < 4; ++j) { v[j] = v[j] - mean; s2 += (v[j][0] * v[j][0] + v[j][1] * v[j][1]) + (v[j][2] * v[j][2] + v[j][3] * v[j][3]); }
        const float rstd = 1.0f / sqrtf(wave_sum(s2) * (1.0f / DM) + LN_EPS);
        float amax = 0.f;
#pragma unroll
        for (int j = 0; j < 4; ++j) { const f32x4 gg = *(const f32x4*)(p.ln1_g + j * 256 + lane * 4), bb = *(const f32x4*)(p.ln1_b + j * 256 + lane * 4);
            const f32x4 hv = v[j] * rstd * gg + bb;
            *(f32x4*)(row + j * 256 + lane * 4) = hv;
            unsigned long long w = (unsigned long long)pk2(hv[0], hv[1]) | ((unsigned long long)pk2(hv[2], hv[3]) << 32);
            *(unsigned long long*)(H1B + (size_t)t * DM + j * 256 + lane * 4) = w;
            v[j] = hv; amax = fmaxf(amax, fmaxf(fmaxf(fabsf(hv[0]), fabsf(hv[1])), fmaxf(fabsf(hv[2]), fabsf(hv[3])))); }
        amax = wave_max(amax);
        const float inv = amax > 0.f ? 448.0f / amax : 0.f;
#pragma unroll
        for (int j = 0; j < 4; ++j) *(unsigned*)(p.ws + WS_H8 + (size_t)t * DM + j * 256 + lane * 4) = pk4_fp8(v[j][0] * inv, v[j][1] * inv, v[j][2] * inv, v[j][3] * inv);
        if (lane == 0) ((float*)(p.ws + WS_HS))[t] = amax * (1.0f / 448.0f);
    }
}

__device__ __forceinline__ unsigned mono_key(float f) { const unsigned u = __float_as_uint(f); return u ^ ((unsigned)((int)u >> 31) | 0x80000000u); }
__device__ __forceinline__ float mono_val(unsigned k) { return __uint_as_float(k ^ ((k >> 31) ? 0x80000000u : 0xFFFFFFFFu)); }
#define CE_DESC(a, b) do { const unsigned _mx = (a) > (b) ? (a) : (b), _mn = (a) > (b) ? (b) : (a); (a) = _mx; (b) = _mn; } while (0)
template <int N> __device__ __forceinline__ void bitonic_sort_desc(unsigned (&k)[N]) {
#pragma unroll
    for (int sz = 2; sz <= N; sz <<= 1)
#pragma unroll
        for (int j = sz >> 1; j > 0; j >>= 1)
#pragma unroll
            for (int i = 0; i < N; ++i) { const int l = i ^ j; if (l > i) { if ((i & sz) == 0) CE_DESC(k[i], k[l]); else CE_DESC(k[l], k[i]); } }
}
template <int N> __device__ __forceinline__ void bitonic_merge_desc(unsigned (&k)[N]) {
#pragma unroll
    for (int j = N >> 1; j > 0; j >>= 1)
#pragma unroll
        for (int i = 0; i < N; ++i) { const int l = i ^ j; if (l > i) CE_DESC(k[i], k[l]); }
}
__device__ __forceinline__ void top16_merge(unsigned (&a)[16], const unsigned (&b)[16]) {
#pragma unroll
    for (int i = 0; i < 16; ++i) a[i] = a[i] > b[15 - i] ? a[i] : b[15 - i];
    bitonic_merge_desc<16>(a);
}
template <int CTRL> __device__ __forceinline__ void top16_merge_dpp(unsigned (&a)[16]) {
    unsigned b[16];
#pragma unroll
    for (int i = 0; i < 16; ++i) b[i] = (unsigned)__builtin_amdgcn_mov_dpp((int)a[i], CTRL, 0xF, 0xF, true);
    top16_merge(a, b);
}
constexpr int TK_SEG = 1088;
constexpr int TK_SCR = 128 * TK_SEG;
__device__ __forceinline__ void topk_phase(const Params& p, unsigned char* lds_g) {
    const int tid = threadIdx.x, lane = tid & 63, wave = __builtin_amdgcn_readfirstlane(tid >> 6);
    const float* SC = (const float*)(p.ws + WS_SC);
    int* EID = (int*)(p.ws + WS_EID); float* GATE = (float*)(p.ws + WS_GATE);
    LAS unsigned char* lds = (LAS unsigned char*)lds_g;
    const int seg = tid >> 2, part = tid & 3;
    for (int bt = blockIdx.x; bt < MTOK / 16; bt += gridDim.x) {
        const float* src = SC + (size_t)bt * 16 * NSC;
#pragma unroll
        for (int i = 0; i < 16; ++i) { const int sg = wave * 16 + i;
            __builtin_amdgcn_global_load_lds((const unsigned*)(src + (size_t)sg * 256 + lane * 4), (LAS unsigned*)(lds + sg * TK_SEG), 16, 0, 0); }
        asm volatile("s_waitcnt vmcnt(0)" ::: "memory");
        __syncthreads();
        unsigned V[2][16];
#pragma unroll
        for (int hh = 0; hh < 2; ++hh) {
            unsigned ka[16], kb[16];
#pragma unroll
            for (int i = 0; i < 4; ++i) { const f32x4 v = *(const LAS f32x4*)(lds + seg * TK_SEG + hh * 512 + (4 * i + part) * 16);
#pragma unroll
                for (int j = 0; j < 4; ++j) ka[4 * i + j] = (mono_key(v[j]) & ~127u) | (unsigned)(127 - (16 * i + 4 * part + j)); }
#pragma unroll
            for (int i = 4; i < 8; ++i) { const f32x4 v = *(const LAS f32x4*)(lds + seg * TK_SEG + hh * 512 + (4 * i + part) * 16);
#pragma unroll
                for (int j = 0; j < 4; ++j) kb[4 * (i - 4) + j] = (mono_key(v[j]) & ~127u) | (unsigned)(127 - (16 * i + 4 * part + j)); }
            bitonic_sort_desc<16>(ka); bitonic_sort_desc<16>(kb);
            top16_merge(ka, kb);
            top16_merge_dpp<0xB1>(ka);
            top16_merge_dpp<0x4E>(ka);
#pragma unroll
            for (int i = 0; i < 16; ++i) V[hh][i] = ka[i];
        }
        LAS unsigned* scr = (LAS unsigned*)(lds + TK_SCR + seg * 32);
        if (part == 0) {
#pragma unroll
            for (int hh = 0; hh < 2; ++hh)
#pragma unroll
                for (int w = 0; w < 4; ++w) scr[hh * 4 + w] = (127u - (V[hh][4 * w] & 127u)) | ((127u - (V[hh][4 * w + 1] & 127u)) << 8) | ((127u - (V[hh][4 * w + 2] & 127u)) << 16) | ((127u - (V[hh][4 * w + 3] & 127u)) << 24);
        }
        float v1[16], v2[16];
#pragma unroll
        for (int i = 0; i < 16; ++i) { v1[i] = mono_val(V[0][i] & ~127u); v2[i] = mono_val(V[1][i] & ~127u); }
#define CKEY(a, b) ((mono_key(v1[a] + v2[b]) & ~255u) | (unsigned)(255 - (16 * (a) + (b))))
        unsigned g0[16], g1[16], g2[16], g3[16];
#pragma unroll
        for (int b = 0; b < 16; ++b) g0[b] = CKEY(0, b);
#pragma unroll
        for (int b = 0; b < 8; ++b) g1[b] = CKEY(1, b);
#pragma unroll
        for (int a = 8; a < 16; ++a) g1[8 + (15 - a)] = CKEY(a, 0);
        bitonic_merge_desc<16>(g1);
        g2[0] = CKEY(2, 0); g2[1] = CKEY(2, 1); g2[2] = CKEY(2, 2); g2[3] = CKEY(2, 3); g2[4] = CKEY(2, 4);
        g2[5] = CKEY(3, 0); g2[6] = CKEY(3, 1); g2[7] = CKEY(3, 2); g2[8] = CKEY(3, 3);
        g2[9] = CKEY(4, 0); g2[10] = CKEY(4, 1); g2[11] = CKEY(4, 2);
        g2[12] = CKEY(5, 0); g2[13] = CKEY(5, 1); g2[14] = CKEY(6, 0); g2[15] = CKEY(6, 1);
        bitonic_sort_desc<16>(g2);
        g3[0] = CKEY(7, 0); g3[1] = CKEY(7, 1);
#pragma unroll
        for (int i = 2; i < 16; ++i) g3[i] = 0u;
        top16_merge(g0, g1); top16_merge(g2, g3); top16_merge(g0, g2);
#undef CKEY
        const float mx = mono_val(g0[0] & ~255u);
        unsigned rk[4]; float ex[4]; float den = 0.f;
#pragma unroll
        for (int i = 0; i < 4; ++i) { rk[i] = part == 0 ? g0[4 * i] : (part == 1 ? g0[4 * i + 1] : (part == 2 ? g0[4 * i + 2] : g0[4 * i + 3]));
            ex[i] = __expf(mono_val(rk[i] & ~255u) - mx); den += ex[i]; }
        den += __builtin_bit_cast(float, __builtin_amdgcn_mov_dpp(__builtin_bit_cast(int, den), 0xB1, 0xF, 0xF, true));
        den += __builtin_bit_cast(float, __builtin_amdgcn_mov_dpp(__builtin_bit_cast(int, den), 0x4E, 0xF, 0xF, true));
        const float rden = 1.0f / den;
        asm volatile("s_waitcnt lgkmcnt(0)" ::: "memory");
        const LAS unsigned char* sb = (const LAS unsigned char*)scr;
        const int tl = seg >> 3, h = seg & 7; const size_t obase = (size_t)(bt * 16 + tl) * 128 + h * 16;
#pragma unroll
        for (int i = 0; i < 4; ++i) { const unsigned flat = 255u - (rk[i] & 255u); const int i1 = sb[flat >> 4], i2 = sb[16 + (flat & 15)];
            EID[obase + 4 * i + part] = i1 * 128 + i2; GATE[obase + 4 * i + part] = ex[i] * rden; }
        __syncthreads();
    }
}

__device__ __forceinline__ void tables_to_fp8(const Params& p) {
    const int lane = threadIdx.x & 63, wave = threadIdx.x >> 6;
    for (int rw = blockIdx.x * NWAVES + wave; rw < 2 * 16384; rw += gridDim.x * NWAVES) {
        const int tb = rw >= 16384, e = rw & 16383;
        const float* src = (tb ? p.pv : p.pu) + (size_t)e * DM + lane * 16;
        f32x4 v[4]; float mx = 0.f;
#pragma unroll
        for (int j = 0; j < 4; ++j) { v[j] = *(const f32x4*)(src + 4 * j); mx = fmaxf(mx, fmaxf(fmaxf(fabsf(v[j][0]), fabsf(v[j][1])), fmaxf(fabsf(v[j][2]), fabsf(v[j][3])))); }
        mx = wave_max(mx);
        const float inv = mx > 0.f ? 448.0f / mx : 0.f;
        u32x4 w; w.x = pk4_fp8(v[0][0] * inv, v[0][1] * inv, v[0][2] * inv, v[0][3] * inv); w.y = pk4_fp8(v[1][0] * inv, v[1][1] * inv, v[1][2] * inv, v[1][3] * inv);
        w.z = pk4_fp8(v[2][0] * inv, v[2][1] * inv, v[2][2] * inv, v[2][3] * inv); w.w = pk4_fp8(v[3][0] * inv, v[3][1] * inv, v[3][2] * inv, v[3][3] * inv);
        *(u32x4*)(p.ws + (tb ? WS_V8 : WS_U8) + (size_t)e * DM + lane * 16) = w;
        if (lane == 0) ((float*)(p.ws + (tb ? WS_SV : WS_SU)))[e] = mx * (1.0f / 448.0f);
    }
}

typedef float f32x2 __attribute__((ext_vector_type(2)));
typedef long i64x2 __attribute__((ext_vector_type(2)));
__device__ __forceinline__ void peer_phase(const Params& p, unsigned char* lds_g) {
    const int tid = threadIdx.x, lane = tid & 63, wave = __builtin_amdgcn_readfirstlane(tid >> 6);
    LAS unsigned char* wl = (LAS unsigned char*)lds_g + wave * 4096;
    LAS int* ids = (LAS int*)(wl + 1024); LAS float* gts = (LAS float*)(wl + 1536); LAS float* act = (LAS float*)(wl + 2048); LAS float* sus = (LAS float*)(wl + 2560);
    const unsigned char* U8 = p.ws + WS_U8; const unsigned char* V8 = p.ws + WS_V8; const unsigned char* H8 = p.ws + WS_H8;
    const float* SU = (const float*)(p.ws + WS_SU); const float* SV = (const float*)(p.ws + WS_SV); const float* HS = (const float*)(p.ws + WS_HS);
    const int* EID = (const int*)(p.ws + WS_EID); const float* GATE = (const float*)(p.ws + WS_GATE);
    const int r = lane & 15, q = lane >> 4;
    for (int t = blockIdx.x * NWAVES + wave; t < MTOK; t += gridDim.x * NWAVES) {
        const int e_lo = EID[(size_t)t * 128 + lane], e_hi = EID[(size_t)t * 128 + 64 + lane];
        ids[lane] = e_lo; ids[64 + lane] = e_hi;
        gts[lane] = GATE[(size_t)t * 128 + lane] * SV[e_lo]; gts[64 + lane] = GATE[(size_t)t * 128 + 64 + lane] * SV[e_hi];
        const float hs = HS[t];
        sus[lane] = SU[e_lo] * hs; sus[64 + lane] = SU[e_hi] * hs;
        *(LAS u32x4*)(wl + lane * 16) = *(const u32x4*)(H8 + (size_t)t * DM + lane * 16);
        asm volatile("s_waitcnt lgkmcnt(0)" ::: "memory");
        const unsigned char* rp[8];
#pragma unroll
        for (int g = 0; g < 8; ++g) rp[g] = U8 + (size_t)ids[16 * g + r] * DM + q * 16;
        f32x4 acc[8];
#pragma unroll
        for (int g = 0; g < 8; ++g) acc[g] = (f32x4){0.f, 0.f, 0.f, 0.f};
#pragma unroll 2
        for (int s = 0; s < 16; ++s) {
            const i64x2 B = *(const LAS i64x2*)(wl + s * 64 + q * 16);
#pragma unroll
            for (int g = 0; g < 8; ++g) { const i64x2 A = *(const i64x2*)(rp[g] + s * 64);
                acc[g] = __builtin_amdgcn_mfma_f32_16x16x32_fp8_fp8(A[0], B[0], acc[g], 0, 0, 0);
                acc[g] = __builtin_amdgcn_mfma_f32_16x16x32_fp8_fp8(A[1], B[1], acc[g], 0, 0, 0); }
        }
#pragma unroll
        for (int g = 0; g < 8; ++g) { const f32x4 gt = *(const LAS f32x4*)(gts + 16 * g + 4 * q), su = *(const LAS f32x4*)(sus + 16 * g + 4 * q); f32x4 a;
#pragma unroll
            for (int j = 0; j < 4; ++j) a[j] = gt[j] * gelu_tanh(acc[g][j] * su[j]);
            if (r == 0) *(LAS f32x4*)(act + 16 * g + 4 * q) = a; }
        asm volatile("s_waitcnt lgkmcnt(0)" ::: "memory");
        f32x2 o[8];
#pragma unroll
        for (int i = 0; i < 8; ++i) o[i] = (f32x2){0.f, 0.f};
#pragma unroll 8
        for (int k = 0; k < 128; ++k) {
            const int e = __builtin_amdgcn_readfirstlane(ids[k]); const float a = act[k]; const f32x2 a2 = (f32x2){a, a};
            const u32x4 v = *(const u32x4*)(V8 + (size_t)e * DM + lane * 16);
            o[0] += __builtin_amdgcn_cvt_pk_f32_fp8((int)v.x, false) * a2; o[1] += __builtin_amdgcn_cvt_pk_f32_fp8((int)v.x, true) * a2;
            o[2] += __builtin_amdgcn_cvt_pk_f32_fp8((int)v.y, false) * a2; o[3] += __builtin_amdgcn_cvt_pk_f32_fp8((int)v.y, true) * a2;
            o[4] += __builtin_amdgcn_cvt_pk_f32_fp8((int)v.z, false) * a2; o[5] += __builtin_amdgcn_cvt_pk_f32_fp8((int)v.z, true) * a2;
            o[6] += __builtin_amdgcn_cvt_pk_f32_fp8((int)v.w, false) * a2; o[7] += __builtin_amdgcn_cvt_pk_f32_fp8((int)v.w, true) * a2;
        }
        float* row = p.out + (size_t)t * DM + lane * 16;
        f32x4 y[4]; float sm = 0.f;
#pragma unroll
        for (int j = 0; j < 4; ++j) { y[j] = *(const f32x4*)(row + 4 * j) * ALPHA + (f32x4){o[2 * j][0], o[2 * j][1], o[2 * j + 1][0], o[2 * j + 1][1]}; sm += (y[j][0] + y[j][1]) + (y[j][2] + y[j][3]); }
        const float mean = wave_sum(sm) * (1.0f / DM); float s2 = 0.f;
#pragma unroll
        for (int j = 0; j < 4; ++j) { y[j] = y[j] - mean; s2 += (y[j][0] * y[j][0] + y[j][1] * y[j][1]) + (y[j][2] * y[j][2] + y[j][3] * y[j][3]); }
        const float rstd = 1.0f / sqrtf(wave_sum(s2) * (1.0f / DM) + LN_EPS);
#pragma unroll
        for (int j = 0; j < 4; ++j) { const f32x4 gg = *(const f32x4*)(p.ln2_g + lane * 16 + 4 * j), bb = *(const f32x4*)(p.ln2_b + lane * 16 + 4 * j);
            *(f32x4*)(row + 4 * j) = y[j] * rstd * gg + bb; }
        asm volatile("s_waitcnt lgkmcnt(0)" ::: "memory");
    }
}

__global__ void __launch_bounds__(NT, 2) mega(Params p) {
    extern __shared__ __attribute__((aligned(16))) unsigned char lds[];
    cg::grid_group grid = cg::this_grid();
    unsigned char* ws = p.ws;
    const int G = gridDim.x;

    phase0(p, lds);
    grid.sync();

    {
        pg8::Gemm g{(const bf16*)(ws + WS_XB), (const bf16*)(ws + WS_WIN), MTOK, NPROJ, DM}; pg8::StaticOrder S; S.init(MTOK, NPROJ, G, (int)blockIdx.x);
        pg8::EpiProj E{(bf16*)(ws + WS_PROJ)};
        pg8::gemm_phase<pg8::EpiProj, pg8::StaticOrder, true, true>((PG8_LAS unsigned char*)lds, g, S, E);
    }
    grid.sync();

    {
        const int half = G / 2;
        if ((int)blockIdx.x < half) { for (int it = blockIdx.x; it < 128; it += half) hgrn_chunk_item(p, lds, it); }
        else { for (int it = blockIdx.x - half; it < 2048; it += G - half) gmlp_naive_item(p, lds, it); }
    }
    grid.sync();
    hgrn_finalize(p);
    grid.sync();

    {
        pg8::Gemm g{(const bf16*)(ws + WS_Y), (const bf16*)(ws + WS_WOUT), MTOK, DM, DM}; pg8::StaticOrder S; S.init(MTOK, DM, G, (int)blockIdx.x);
        pg8::EpiPre E{p.x, p.out};
        pg8::gemm_phase<pg8::EpiPre, pg8::StaticOrder, true, true>((PG8_LAS unsigned char*)lds, g, S, E);
    }
    grid.sync();
    ln1_pass(p);
    tables_to_fp8(p);
    grid.sync();

    {
        pg8::Gemm g{(const bf16*)(ws + WS_XB), (const bf16*)(ws + WS_WSC), MTOK, NSC, DM}; pg8::StaticOrder S; S.init(MTOK, NSC, G, (int)blockIdx.x);
        pg8::EpiF32 E{(float*)(ws + WS_SC), NSC};
        pg8::gemm_phase<pg8::EpiF32, pg8::StaticOrder, true, true>((PG8_LAS unsigned char*)lds, g, S, E);
    }
    grid.sync();
    topk_phase(p, lds);
    grid.sync();
    peer_phase(p, lds);
}

extern "C" void kernel_launch(void* const* d_in, const int* in_sizes, int n_in, void* d_out, int out_size, void* d_ws, size_t ws_size, hipStream_t stream) {
    static int grid = 0;
    if (grid == 0) {
        if (n_in != 18 || in_sizes[0] != MTOK * DM || out_size != MTOK * DM || ws_size < WS_END) {
            fprintf(stderr, "kernel_launch: unexpected shapes (n_in %d, in0 %d, out %d, ws %zu); nothing launched\n", n_in, n_in > 0 ? in_sizes[0] : -1, out_size, ws_size); grid = -1; return; }
        int dev = 0, cus = 0, per_cu = 0;
        if (hipGetDevice(&dev) != hipSuccess || hipDeviceGetAttribute(&cus, hipDeviceAttributeMultiprocessorCount, dev) != hipSuccess) { grid = -1; return; }
        if (hipFuncSetAttribute((const void*)mega, hipFuncAttributeMaxDynamicSharedMemorySize, LDS_BYTES) != hipSuccess) { fprintf(stderr, "kernel_launch: hipFuncSetAttribute failed\n"); grid = -1; return; }
        if (hipOccupancyMaxActiveBlocksPerMultiprocessor(&per_cu, (const void*)mega, NT, LDS_BYTES) != hipSuccess || per_cu < 1) { fprintf(stderr, "kernel_launch: occupancy query says %d\n", per_cu); grid = -1; return; }
        grid = cus;
    }
    if (grid < 0) return;
    Params p{};
    p.x = (const float*)d_in[0]; p.w_in = (const float*)d_in[1]; p.lb_logits = (const float*)d_in[2]; p.hg_norm_g = (const float*)d_in[3];
    p.gm_ln_g = (const float*)d_in[4]; p.gm_ln_b = (const float*)d_in[5]; p.gm_ws = (const float*)d_in[6]; p.gm_bs = (const float*)d_in[7];
    p.w_out = (const float*)d_in[8]; p.ln1_g = (const float*)d_in[9]; p.ln1_b = (const float*)d_in[10]; p.wq = (const float*)d_in[11];
    p.k1 = (const float*)d_in[12]; p.k2 = (const float*)d_in[13]; p.pu = (const float*)d_in[14]; p.pv = (const float*)d_in[15];
    p.ln2_g = (const float*)d_in[16]; p.ln2_b = (const float*)d_in[17];
    p.out = (float*)d_out; p.ws = (unsigned char*)d_ws;
    void* args[] = {&p};
    hipError_t e = hipLaunchCooperativeKernel((const void*)mega, dim3(grid), dim3(NT), args, LDS_BYTES, stream);
    if (e != hipSuccess) fprintf(stderr, "kernel_launch: cooperative launch failed: %s (grid %d)\n", hipGetErrorString(e), grid);
}
```

```cpp
#include <hip/hip_runtime.h>
#include <hip/hip_cooperative_groups.h>
#include <cstdio>
#include <cstdint>
namespace cg = cooperative_groups;

namespace pg8 {
#define PG8_LAS __attribute__((address_space(3)))
typedef unsigned short bf16_t;
typedef short bf16x8 __attribute__((ext_vector_type(8)));
typedef float f32x4 __attribute__((ext_vector_type(4)));
typedef unsigned u32x4 __attribute__((ext_vector_type(4)));
constexpr int BM = 256, BK = 64, HALF = 128, HTB = HALF * BK * 2  , STAGE_BYTES = 8 * HTB, NXCD = 8, WGM = 8;

__host__ __device__ __forceinline__ int lds_byte(int r, int c) { const int st = (r >> 4) * 2 + (c >> 5), rr = r & 15, cc = c & 31, ob = rr * 64 + cc * 2; return st * 1024 + (ob ^ (((ob >> 9) & 1) << 5)); }
__host__ __device__ __forceinline__ void stage_rc(int b, int& R, int& C) { const int st = b / 1024, sb = b % 1024, swz = sb ^ (((sb >> 9) & 1) << 5); R = (st >> 1) * 16 + swz / 64; C = (st & 1) * 32 + (swz % 64) / 2; }
__host__ __device__ __forceinline__ int perm32(int rho) { const int n = rho >> 4, i = rho & 15; return 8 * (i >> 2) + 4 * n + (i & 3); }

struct Unit { int pm, pn; };
struct Gemm { const bf16_t* A; const bf16_t* Bt; int M, N, K; };

struct StaticOrder {
    int nM, nN, nwg, G, c;
    __host__ __device__ void init(int M, int N, int G_, int c_) { nM = M / BM; nN = N / BM; nwg = nM * nN; G = G_; c = c_; }
    __host__ __device__ bool next(int i, Unit& u) const {
        const long L = (long)i * G + c; if (L >= nwg) return false;
        int wgid = (int)L; { const int q = nwg / NXCD, r = nwg % NXCD, xcd = wgid % NXCD, off = wgid / NXCD; wgid = (xcd < r ? xcd * (q + 1) : r * (q + 1) + (xcd - r) * q) + off; }
        const int nig = WGM * nN, gid = wgid / nig, fm = gid * WGM, gsz = (nM - fm) < WGM ? (nM - fm) : WGM;
        u.pm = fm + ((wgid % nig) % gsz); u.pn = (wgid % nig) / gsz; return true;
    }
    __device__ __forceinline__ void a_ready(const Unit&) const {}
    __device__ __forceinline__ void done(const Unit&) const {}
};
__device__ __forceinline__ unsigned cvt_pk_bf16(float lo, float hi) { unsigned r; asm volatile("v_cvt_pk_bf16_f32 %0, %1, %2" : "=v"(r) : "v"(lo), "v"(hi)); return r; }
template <class Epi, class Sched, bool ALIGN_EPI = false, bool SP2 = false>
__device__ __forceinline__ void gemm_phase(PG8_LAS unsigned char* lds, const Gemm g, const Sched& S, const Epi& E) {
    const int tid = threadIdx.x, wid = __builtin_amdgcn_readfirstlane(tid >> 6), lane = tid & 63, wr = wid >> 2, wc = wid & 3, fr = lane & 15, fq = lane >> 4;
    const int K = g.K, nt = K / BK;
    unsigned voffA[2], voffB[2];
#pragma unroll
    for (int i = 0; i < 2; ++i) { int R, C; stage_rc(tid * 16 + i * 8192, R, C); const int Rb = Epi::PERM ? ((R & ~31) + perm32(R & 31)) : R;
        voffA[i] = (unsigned)(R * K + C) * 2u; voffB[i] = (unsigned)(Rb * K + C) * 2u; }
    const size_t kstep = (size_t)(BK * 2);
    const size_t hstep = (size_t)HALF * K * 2;
    const size_t tstep = 2 * hstep;
    const unsigned ldsw = (unsigned)wid * 1024u;
    const int aoff = lds_byte(wr * 64 + fr, fq * 8), boff = lds_byte(wc * 32 + fr, fq * 8);
#define PG8_SA(b, h) (((b) * 2 + (h)) * HTB)
#define PG8_SB(b, h) ((4 + (b) * 2 + (h)) * HTB)
#define PG8_STAGE(bufoff, gbase, voff) do { _Pragma("unroll") for (int _i = 0; _i < 2; ++_i) \
        __builtin_amdgcn_global_load_lds((const unsigned*)((const char*)(gbase) + (voff)[_i]), (PG8_LAS unsigned*)(lds + (bufoff) + ldsw + _i * 8192), 16, 0, 0); } while (0)
#define PG8_LDA(dst, b, h) do { _Pragma("unroll") for (int m = 0; m < 4; ++m) _Pragma("unroll") for (int k = 0; k < 2; ++k) dst[m][k] = *(const PG8_LAS bf16x8*)(lds + PG8_SA(b, h) + aoff + m * 2048 + k * 1024); } while (0)
#define PG8_LDB(dst, b, h) do { _Pragma("unroll") for (int n = 0; n < 2; ++n) _Pragma("unroll") for (int k = 0; k < 2; ++k) dst[n][k] = *(const PG8_LAS bf16x8*)(lds + PG8_SB(b, h) + boff + n * 2048 + k * 1024); } while (0)
#define PG8_MMA(ai, bj, At, Bt) do { __builtin_amdgcn_s_setprio(1); _Pragma("unroll") for (int m = 0; m < 4; ++m) _Pragma("unroll") for (int n = 0; n < 2; ++n) _Pragma("unroll") for (int k = 0; k < 2; ++k) \
        acc[ai][bj][m][n] = __builtin_amdgcn_mfma_f32_16x16x32_bf16(Bt[n][k], At[m][k], acc[ai][bj][m][n], 0, 0, 0); __builtin_amdgcn_s_setprio(0); } while (0)
#define PG8_WAIT_V(n) asm volatile("s_waitcnt vmcnt(" #n ")" ::: "memory")
#define PG8_WAIT_L(n) asm volatile("s_waitcnt lgkmcnt(" #n ")" ::: "memory")
#define PG8_BAR __builtin_amdgcn_s_barrier()
#define PG8_SCHED __builtin_amdgcn_sched_barrier(0)
    Unit cur, nxt; int ui = 0;
    if (!S.next(0, cur)) return;
    f32x4 acc[2][2][4][2];
#pragma unroll
    for (int a = 0; a < 2; ++a)
#pragma unroll
        for (int b = 0; b < 2; ++b)
#pragma unroll
            for (int m = 0; m < 4; ++m)
#pragma unroll
                for (int n = 0; n < 2; ++n) acc[a][b][m][n] = (f32x4){0.f, 0.f, 0.f, 0.f};
    bf16x8 At[4][2], B0[2][2], B1[2][2];
    const char* cA = (const char*)g.A + (size_t)cur.pm * tstep; const char* cB = (const char*)g.Bt + (size_t)cur.pn * tstep;
    S.a_ready(cur);
    if constexpr (SP2) {
        PG8_STAGE(PG8_SB(0, 0), cB, voffB); PG8_STAGE(PG8_SB(0, 1), cB + hstep, voffB); PG8_STAGE(PG8_SA(0, 0), cA, voffA); PG8_STAGE(PG8_SA(0, 1), cA + hstep, voffA);
        if (wr == 1) PG8_BAR;
        PG8_WAIT_V(2); PG8_BAR;
        PG8_STAGE(PG8_SB(1, 0), cB + kstep, voffB); PG8_STAGE(PG8_SA(1, 0), cA + kstep, voffA); PG8_STAGE(PG8_SB(1, 1), cB + hstep + kstep, voffB);
        PG8_WAIT_V(6); PG8_BAR;
    } else {
        PG8_STAGE(PG8_SB(0, 0), cB, voffB); PG8_STAGE(PG8_SA(0, 0), cA, voffA); PG8_STAGE(PG8_SB(0, 1), cB + hstep, voffB); PG8_STAGE(PG8_SA(0, 1), cA + hstep, voffA);
        if (wr == 1) PG8_BAR;
        PG8_WAIT_V(4); PG8_BAR;
        PG8_STAGE(PG8_SB(1, 0), cB + kstep, voffB); PG8_STAGE(PG8_SA(1, 0), cA + kstep, voffA); PG8_STAGE(PG8_SB(1, 1), cB + hstep + kstep, voffB);
        PG8_WAIT_V(6); PG8_BAR;
    }
    for (;;) {
        const bool has_next = S.next(ui + 1, nxt);
        const char* nA = has_next ? (const char*)g.A + (size_t)nxt.pm * tstep : cA; const char* nB = has_next ? (const char*)g.Bt + (size_t)nxt.pn * tstep : cB;
        for (int t = 0; t < nt; t += 2) {
            const bool last = (t == nt - 2);
            const char* a1 = cA + (size_t)(t + 1) * kstep;
            const char* a2 = last ? nA : cA + (size_t)(t + 2) * kstep; const char* b2 = last ? nB : cB + (size_t)(t + 2) * kstep;
            const char* a3 = a2 + kstep; const char* b3 = b2 + kstep;
            if (last && has_next) S.a_ready(nxt);
            if constexpr (SP2) {
            PG8_LDB(B0, 0, 0); PG8_LDB(B1, 0, 1); PG8_SCHED; PG8_LDA(At, 0, 0); PG8_STAGE(PG8_SA(1, 1), a1 + hstep, voffA);
            PG8_WAIT_V(8); PG8_WAIT_L(0); PG8_BAR; PG8_MMA(0, 0, At, B0); PG8_MMA(0, 1, At, B1); PG8_BAR; PG8_SCHED;
            PG8_LDA(At, 0, 1); PG8_STAGE(PG8_SB(0, 0), b2, voffB); PG8_STAGE(PG8_SB(0, 1), b2 + hstep, voffB); PG8_STAGE(PG8_SA(0, 0), a2, voffA);
            PG8_WAIT_V(8); PG8_WAIT_L(0); PG8_BAR; PG8_MMA(1, 0, At, B0); PG8_MMA(1, 1, At, B1); PG8_BAR; PG8_SCHED;
            PG8_LDB(B0, 1, 0); PG8_LDB(B1, 1, 1); PG8_SCHED; PG8_LDA(At, 1, 0); PG8_STAGE(PG8_SA(0, 1), a2 + hstep, voffA);
            PG8_WAIT_V(8); PG8_WAIT_L(0); PG8_BAR; PG8_MMA(0, 0, At, B0); PG8_MMA(0, 1, At, B1); PG8_BAR; PG8_SCHED;
            PG8_LDA(At, 1, 1); PG8_STAGE(PG8_SB(1, 0), b3, voffB); PG8_STAGE(PG8_SB(1, 1), b3 + hstep, voffB); PG8_STAGE(PG8_SA(1, 0), a3, voffA);
            PG8_WAIT_V(8); PG8_WAIT_L(0); PG8_BAR; PG8_MMA(1, 0, At, B0); PG8_MMA(1, 1, At, B1); PG8_BAR; PG8_SCHED;
            } else {
            PG8_LDB(B0, 0, 0); PG8_SCHED; PG8_LDA(At, 0, 0); PG8_STAGE(PG8_SA(1, 1), a1 + hstep, voffA);
            PG8_WAIT_L(8); PG8_BAR; PG8_WAIT_L(0); PG8_MMA(0, 0, At, B0); PG8_BAR; PG8_SCHED;
            PG8_LDB(B1, 0, 1); PG8_STAGE(PG8_SB(0, 0), b2, voffB);
            PG8_BAR; PG8_WAIT_L(0); PG8_MMA(0, 1, At, B1); PG8_BAR;
            PG8_LDA(At, 0, 1); PG8_STAGE(PG8_SA(0, 0), a2, voffA);
            PG8_BAR; PG8_WAIT_L(0); PG8_MMA(1, 0, At, B0); PG8_BAR; PG8_SCHED;
            PG8_STAGE(PG8_SB(0, 1), b2 + hstep, voffB);
            PG8_WAIT_V(6); PG8_BAR; PG8_MMA(1, 1, At, B1); PG8_BAR;
            PG8_LDB(B0, 1, 0); PG8_SCHED; PG8_LDA(At, 1, 0); PG8_STAGE(PG8_SA(0, 1), a2 + hstep, voffA);
            PG8_WAIT_L(8); PG8_BAR; PG8_WAIT_L(0); PG8_MMA(0, 0, At, B0); PG8_BAR; PG8_SCHED;
            PG8_LDB(B1, 1, 1); PG8_STAGE(PG8_SB(1, 0), b3, voffB);
            PG8_BAR; PG8_WAIT_L(0); PG8_MMA(0, 1, At, B1); PG8_BAR;
            PG8_LDA(At, 1, 1); PG8_STAGE(PG8_SA(1, 0), a3, voffA);
            PG8_BAR; PG8_WAIT_L(0); PG8_MMA(1, 0, At, B0); PG8_BAR; PG8_SCHED;
            PG8_STAGE(PG8_SB(1, 1), b3 + hstep, voffB);
            PG8_WAIT_V(6); PG8_BAR; PG8_MMA(1, 1, At, B1); PG8_BAR;
            }
        }
        if constexpr (ALIGN_EPI) { if (wr == 0) PG8_BAR; }
        if constexpr (!Epi::AFTER_DRAIN) { E(acc, cur, wr, wc, fr, fq); S.done(cur); }
        if (!has_next) break;
#pragma unroll
        for (int a = 0; a < 2; ++a)
#pragma unroll
            for (int b = 0; b < 2; ++b)
#pragma unroll
                for (int m = 0; m < 4; ++m)
#pragma unroll
                    for (int n = 0; n < 2; ++n) acc[a][b][m][n] = (f32x4){0.f, 0.f, 0.f, 0.f};
        cur = nxt; cA = nA; cB = nB; ++ui;
        if constexpr (ALIGN_EPI) { if (wr == 1) PG8_BAR; }
    }
    PG8_WAIT_V(0);
    if constexpr (!ALIGN_EPI) { if (wr == 0) PG8_BAR; }
    PG8_BAR;
    if constexpr (Epi::AFTER_DRAIN) { E.fused(acc, cur, wr, wc, fr, fq, lds, wid, lane); S.done(cur); }
#undef PG8_SA
#undef PG8_SB
#undef PG8_STAGE
#undef PG8_LDA
#undef PG8_LDB
#undef PG8_MMA
#undef PG8_WAIT_V
#undef PG8_WAIT_L
#undef PG8_BAR
#undef PG8_SCHED
}
}

constexpr int NT = 512, NWAVES = 8;
constexpr int LDS_BYTES = 147456;
constexpr int MTOK = 65536, DM = 1024, SEQ = 4096, NBATCH = 16;
constexpr int NPROJ = 3584;
constexpr int C_Q = 0, C_ZF = 512, C_ZB = 1024, C_I = 1536, C_G = 2048, C_U = 2560, C_V = 3072;
constexpr int NSC = 2048;
constexpr float ALPHA = 1.189207115002721f;
constexpr float LN_EPS = 1e-5f, RMS_EPS = 1e-6f;

constexpr size_t MiB = 1u << 20;
constexpr size_t WS_WIN = 1 * MiB;
constexpr size_t WS_WOUT = 8 * MiB;
constexpr size_t WS_WSC = 10 * MiB;
constexpr size_t WS_GW = 14 * MiB;
constexpr size_t WS_XB = 16 * MiB;
constexpr size_t WS_PROJ = 144 * MiB;
constexpr size_t WS_Y = 592 * MiB;
constexpr size_t WS_OF = 720 * MiB;
constexpr size_t WS_OB = 848 * MiB;
constexpr size_t WS_SC = 144 * MiB;
constexpr size_t WS_EID = 720 * MiB;
constexpr size_t WS_GATE = 752 * MiB;
constexpr size_t WS_U8 = 656 * MiB;
constexpr size_t WS_V8 = 672 * MiB;
constexpr size_t WS_SU = 688 * MiB;
constexpr size_t WS_SV = 689 * MiB;
constexpr size_t WS_HS = 690 * MiB;
constexpr size_t WS_H8 = 784 * MiB;
constexpr size_t WS_END = 976 * MiB;

typedef unsigned short bf16;
typedef float f32x4 __attribute__((ext_vector_type(4)));
typedef unsigned u32x4 __attribute__((ext_vector_type(4)));
#define LAS __attribute__((address_space(3)))

__device__ __forceinline__ unsigned f2bf(float f) { unsigned u = __float_as_uint(f); return (u + 0x7fffu + ((u >> 16) & 1u)) >> 16; }
__device__ __forceinline__ unsigned pk2(float lo, float hi) { return f2bf(lo) | (f2bf(hi) << 16); }
__device__ __forceinline__ float bflo(unsigned w) { return __uint_as_float(w << 16); }
__device__ __forceinline__ float bfhi(unsigned w) { return __uint_as_float(w & 0xffff0000u); }
__device__ __forceinline__ float sigmoidf_(float z) { return 1.0f / (1.0f + __expf(-z)); }
__device__ __forceinline__ float gelu_tanh(float x) { return x / (1.0f + __expf(-1.5957691216057308f * (x + 0.044715f * x * x * x))); }
__device__ __forceinline__ float silu_(float x) { return x / (1.0f + __expf(-x)); }
__device__ __forceinline__ float wave_sum(float v) {
#pragma unroll
    for (int o = 1; o < 64; o <<= 1) v += __shfl_xor(v, o);
    return v;
}

__device__ __forceinline__ float wave_max(float v) {
#pragma unroll
    for (int o = 1; o < 64; o <<= 1) v = fmaxf(v, __shfl_xor(v, o));
    return v;
}
__device__ __forceinline__ unsigned pk4_fp8(float a, float b, float c, float d) { int w = __builtin_amdgcn_cvt_pk_fp8_f32(a, b, 0, false); w = __builtin_amdgcn_cvt_pk_fp8_f32(c, d, w, true); return (unsigned)w; }

struct Params {
    const float *x, *w_in, *lb_logits, *hg_norm_g, *gm_ln_g, *gm_ln_b, *gm_ws, *gm_bs, *w_out, *ln1_g, *ln1_b, *wq, *k1, *k2, *pu, *pv, *ln2_g, *ln2_b;
    float* out; unsigned char* ws;
};

namespace pg8 {
struct EpiProj {
    static constexpr bool PERM = true, AFTER_DRAIN = false;
    bf16* O;
    __device__ __forceinline__ void operator()(const f32x4 (&acc)[2][2][4][2], const Unit& u, int wr, int wc, int fr, int fq) const {
        const int row0 = u.pm * BM + wr * 64 + fr, col0 = u.pn * BM + wc * 32 + 8 * fq;
        const int act = u.pn >= 10 ? 2 : (u.pn >= 8 ? 1 : 0);
#pragma unroll
        for (int ai = 0; ai < 2; ++ai)
#pragma unroll
            for (int m = 0; m < 4; ++m) { bf16* rowp = O + (size_t)(row0 + ai * HALF + m * 16) * NPROJ + col0;
#pragma unroll
                for (int bj = 0; bj < 2; ++bj) { f32x4 v0 = acc[ai][bj][m][0], v1 = acc[ai][bj][m][1];
                    if (act == 2) {
#pragma unroll
                        for (int j = 0; j < 4; ++j) { v0[j] = gelu_tanh(v0[j]); v1[j] = gelu_tanh(v1[j]); } }
                    else if (act == 1) {
#pragma unroll
                        for (int j = 0; j < 4; ++j) { v0[j] = silu_(v0[j]); v1[j] = silu_(v1[j]); } }
                    u32x4 w; w.x = cvt_pk_bf16(v0[0], v0[1]); w.y = cvt_pk_bf16(v0[2], v0[3]); w.z = cvt_pk_bf16(v1[0], v1[1]); w.w = cvt_pk_bf16(v1[2], v1[3]);
                    *(u32x4*)(rowp + bj * HALF) = w; } }
    }
};
struct EpiPre {
    static constexpr bool PERM = false, AFTER_DRAIN = false;
    const float* X; float* P;
    __device__ __forceinline__ void operator()(const f32x4 (&acc)[2][2][4][2], const Unit& u, int wr, int wc, int fr, int fq) const {
        const int row0 = u.pm * BM + wr * 64 + fr, col0 = u.pn * BM + wc * 32 + 4 * fq;
#pragma unroll
        for (int ai = 0; ai < 2; ++ai)
#pragma unroll
            for (int m = 0; m < 4; ++m) { const size_t off = (size_t)(row0 + ai * HALF + m * 16) * DM + col0;
#pragma unroll
                for (int bj = 0; bj < 2; ++bj)
#pragma unroll
                    for (int n = 0; n < 2; ++n) { const f32x4 xv = *(const f32x4*)(X + off + bj * HALF + n * 16);
                        *(f32x4*)(P + off + bj * HALF + n * 16) = xv * ALPHA + acc[ai][bj][m][n]; } }
    }
};
struct EpiF32 {
    static constexpr bool PERM = false, AFTER_DRAIN = false;
    float* C; int ldc;
    __device__ __forceinline__ void operator()(const f32x4 (&acc)[2][2][4][2], const Unit& u, int wr, int wc, int fr, int fq) const {
        const int row0 = u.pm * BM + wr * 64 + fr, col0 = u.pn * BM + wc * 32 + 4 * fq;
#pragma unroll
        for (int ai = 0; ai < 2; ++ai)
#pragma unroll
            for (int m = 0; m < 4; ++m) { float* rowp = C + (size_t)(row0 + ai * HALF + m * 16) * ldc + col0;
#pragma unroll
                for (int bj = 0; bj < 2; ++bj)
#pragma unroll
                    for (int n = 0; n < 2; ++n) *(f32x4*)(rowp + bj * HALF + n * 16) = acc[ai][bj][m][n]; }
    }
};
}

__device__ __forceinline__ void p0_transpose_item(const float* W, int K, int N, bf16* WT, LAS float* scr, int item, int lane) {
    const int nblk = N / 32, kb = item / nblk, nb = item % nblk, k0 = 64 * kb, n0 = 32 * nb;
#pragma unroll 8
    for (int i = 0; i < 32; ++i) { const int kk = 2 * i + (lane >> 5); scr[kk * 33 + (lane & 31)] = W[(size_t)(k0 + kk) * N + n0 + (lane & 31)]; }
    asm volatile("s_waitcnt lgkmcnt(0)" ::: "memory");
    const int c = lane & 7;
#pragma unroll
    for (int j = 0; j < 4; ++j) { const int n = (lane >> 3) + 8 * j; const LAS float* s = scr + (8 * c) * 33 + n;
        u32x4 o; o.x = pk2(s[0 * 33], s[1 * 33]); o.y = pk2(s[2 * 33], s[3 * 33]); o.z = pk2(s[4 * 33], s[5 * 33]); o.w = pk2(s[6 * 33], s[7 * 33]);
        *(u32x4*)(WT + (size_t)(n0 + n) * K + k0 + 8 * c) = o; }
    asm volatile("s_waitcnt lgkmcnt(0)" ::: "memory");
}

__device__ __forceinline__ void phase0(const Params& p, unsigned char* lds_g) {
    const int tid = threadIdx.x, lane = tid & 63, wave = tid >> 6;
    unsigned char* ws = p.ws;
    {
        const size_t n8 = (size_t)MTOK * DM / 8, gsz = (size_t)gridDim.x * NT;
        const f32x4* x4 = (const f32x4*)p.x; u32x4* o = (u32x4*)(ws + WS_XB);
        for (size_t i = (size_t)blockIdx.x * NT + tid; i < n8; i += gsz) { const f32x4 a = x4[2 * i], b = x4[2 * i + 1];
            u32x4 w; w.x = pk2(a[0], a[1]); w.y = pk2(a[2], a[3]); w.z = pk2(b[0], b[1]); w.w = pk2(b[2], b[3]); o[i] = w; }
    }
    {
        const f32x4* w4 = (const f32x4*)p.gm_ws; u32x4* o = (u32x4*)(ws + WS_GW);
        for (int i = blockIdx.x * NT + tid; i < 4 * 128 * 128 / 8; i += gridDim.x * NT) { const f32x4 a = w4[2 * i], b = w4[2 * i + 1];
            u32x4 w; w.x = pk2(a[0], a[1]); w.y = pk2(a[2], a[3]); w.z = pk2(b[0], b[1]); w.w = pk2(b[2], b[3]); o[i] = w; }
    }
    {
        LAS float* scr = (LAS float*)(lds_g + wave * 16384);
        const int gw = blockIdx.x * NWAVES + wave, NGW = gridDim.x * NWAVES;
        constexpr int I_IN = (DM / 64) * (NPROJ / 32), I_OUT = (DM / 64) * (DM / 32);
        for (int it = gw; it < I_IN + I_OUT; it += NGW) {
            if (it < I_IN) p0_transpose_item(p.w_in, DM, NPROJ, (bf16*)(ws + WS_WIN), scr, it, lane);
            else p0_transpose_item(p.w_out, DM, DM, (bf16*)(ws + WS_WOUT), scr, it - I_IN, lane);
        }
    }
    __syncthreads();
    {
        float* Ks = (float*)lds_g;
        float* Ws = (float*)(lds_g + 128 * 132 * 4);
        bf16* WscT = (bf16*)(ws + WS_WSC);
        for (int it = blockIdx.x; it < 256; it += gridDim.x) {
            const int combo = it >> 4, dt = it & 15, h = combo >> 1, half = combo & 1, d0 = dt * 64;
            const float* kp = (half ? p.k2 : p.k1) + (size_t)h * 128 * 128;
            for (int i = tid; i < 128 * 128; i += NT) Ks[(i >> 7) * 132 + (i & 127)] = kp[i];
            for (int i = tid; i < 64 * 128; i += NT) Ws[i] = p.wq[(size_t)(d0 + (i >> 7)) * 2048 + h * 256 + half * 128 + (i & 127)];
            __syncthreads();
            const int key = tid & 127, dg = tid >> 7;
            float acc[16];
#pragma unroll
            for (int i = 0; i < 16; ++i) acc[i] = 0.f;
            for (int j = 0; j < 128; j += 4) {
                const f32x4 kv = *(const f32x4*)(Ks + key * 132 + j);
#pragma unroll
                for (int i = 0; i < 16; ++i) { const f32x4 wv = *(const f32x4*)(Ws + (dg * 16 + i) * 128 + j);
                    acc[i] += kv[0] * wv[0] + kv[1] * wv[1] + kv[2] * wv[2] + kv[3] * wv[3]; }
            }
            bf16* orow = WscT + (size_t)(h * 256 + half * 128 + key) * DM + d0 + dg * 16;
            u32x4 w0, w1; w0.x = pk2(acc[0], acc[1]); w0.y = pk2(acc[2], acc[3]); w0.z = pk2(acc[4], acc[5]); w0.w = pk2(acc[6], acc[7]);
            w1.x = pk2(acc[8], acc[9]); w1.y = pk2(acc[10], acc[11]); w1.z = pk2(acc[12], acc[13]); w1.w = pk2(acc[14], acc[15]);
            *(u32x4*)orow = w0; *(u32x4*)(orow + 8) = w1;
            __syncthreads();
        }
    }
}

typedef float f32x16 __attribute__((ext_vector_type(16)));
typedef float f32x2v __attribute__((ext_vector_type(2)));
typedef __bf16 bf16x2v __attribute__((ext_vector_type(2)));
typedef short s16x8 __attribute__((ext_vector_type(8)));
typedef short s16x4 __attribute__((ext_vector_type(4)));
typedef unsigned u32x2 __attribute__((ext_vector_type(2)));
__device__ __forceinline__ unsigned pkbf(float lo, float hi) { return __builtin_bit_cast(unsigned, __builtin_convertvector((f32x2v){lo, hi}, bf16x2v)); }
#define MFMA32(a, b, c) __builtin_amdgcn_mfma_f32_32x32x16_bf16((a), (b), (c), 0, 0, 0)
#define DPP_MULSTEP(v, ctrl, rmask) v *= __builtin_bit_cast(float, __builtin_amdgcn_update_dpp(0x3f800000, __builtin_bit_cast(int, v), ctrl, rmask, 0xf, false))
constexpr int HG_QT = 0, HG_KT = 17408, HG_QH = 34816;
constexpr int HG_KTT = 52224, HG_VT = 70656;
constexpr int HG_ST = 89088;
constexpr int HG_DEC = 123904;
__device__ __forceinline__ void hgrn_chunk_item(const Params& p, unsigned char* lds_g, int item) {
    const int tid = threadIdx.x, lane = tid & 63, wave = __builtin_amdgcn_readfirstlane(tid >> 6);
    const int b = item >> 3, h = (item >> 1) & 3, dir = item & 1;
    LAS unsigned char* lds = (LAS unsigned char*)lds_g;
    const bf16* proj = (const bf16*)(p.ws + WS_PROJ);
    float* O = (float*)(p.ws + (dir ? WS_OB : WS_OF));
    const int zc = (dir ? C_ZB : C_ZF) + h * 128 + 16 * wave, qc = C_Q + h * 128 + 16 * wave, vc = C_I + h * 128 + 16 * wave;
    float lb[16];
#pragma unroll
    for (int i = 0; i < 16; ++i) { const int c = h * 128 + 16 * wave + i; const float l0 = p.lb_logits[(dir * 2 + 0) * 512 + c], l1 = p.lb_logits[(dir * 2 + 1) * 512 + c]; lb[i] = 1.0f / (1.0f + __expf(l1 - l0)); }
    const int eb = wave >> 1, tb = wave & 1, r32 = lane & 31, hq = lane >> 5;
#define HG_TOKROW(c_, l_) ((size_t)b * SEQ + (dir ? (SEQ - 1 - ((c_) * 64 + (l_))) : ((c_) * 64 + (l_))))
    u32x4 zr0, zr1, qr0, qr1, vr0, vr1;
#define HG_LOAD(c_) do { const bf16* pr_ = proj + HG_TOKROW(c_, lane) * NPROJ; zr0 = *(const u32x4*)(pr_ + zc); zr1 = *(const u32x4*)(pr_ + zc + 8); \
        qr0 = *(const u32x4*)(pr_ + qc); qr1 = *(const u32x4*)(pr_ + qc + 8); vr0 = *(const u32x4*)(pr_ + vc); vr1 = *(const u32x4*)(pr_ + vc + 8); } while (0)
    HG_LOAD(0);
    f32x16 S0, S1;
#pragma unroll
    for (int i = 0; i < 16; ++i) { S0[i] = 0.f; S1[i] = 0.f; }
    for (int c = 0; c < SEQ / 64; ++c) {
        {
            const unsigned zw[8] = {zr0.x, zr0.y, zr0.z, zr0.w, zr1.x, zr1.y, zr1.z, zr1.w};
            const unsigned qw[8] = {qr0.x, qr0.y, qr0.z, qr0.w, qr1.x, qr1.y, qr1.z, qr1.w};
            const unsigned vw[8] = {vr0.x, vr0.y, vr0.z, vr0.w, vr1.x, vr1.y, vr1.z, vr1.w};
            unsigned qtw[8], ktw[8], qhw[8]; float dec[16];
#pragma unroll
            for (int j = 0; j < 8; ++j) {
                float qt2[2], kt2[2], qh2[2];
#pragma unroll
                for (int u = 0; u < 2; ++u) {
                    const int d = 2 * j + u;
                    const float z = fminf(fmaxf(u ? bfhi(zw[j]) : bflo(zw[j]), -80.0f), 80.0f), q = u ? bfhi(qw[j]) : bflo(qw[j]);
                    const float ez = __expf(-z), sg = __builtin_amdgcn_rcpf(1.0f + ez), oml = 1.0f - lb[d];
                    const float f = lb[d] + oml * sg, kk = oml * ez * sg;
                    float P = f;
                    DPP_MULSTEP(P, 0x111, 0xf); DPP_MULSTEP(P, 0x112, 0xf); DPP_MULSTEP(P, 0x114, 0xf); DPP_MULSTEP(P, 0x118, 0xf);
                    DPP_MULSTEP(P, 0x142, 0xa); DPP_MULSTEP(P, 0x143, 0xc);
                    const float P63 = __builtin_bit_cast(float, __builtin_amdgcn_readlane(__builtin_bit_cast(int, P), 63));
                    const float iP63 = __builtin_amdgcn_rcpf(P63);
                    qh2[u] = q * P; qt2[u] = qh2[u] * iP63; kt2[u] = kk * P63 * __builtin_amdgcn_rcpf(P); dec[d] = P63;
                }
                qtw[j] = pkbf(qt2[0], qt2[1]); ktw[j] = pkbf(kt2[0], kt2[1]); qhw[j] = pkbf(qh2[0], qh2[1]);
            }
            const int ro = lane * 272 + wave * 32;
            *(LAS u32x4*)(lds + HG_QT + ro) = (u32x4){qtw[0], qtw[1], qtw[2], qtw[3]}; *(LAS u32x4*)(lds + HG_QT + ro + 16) = (u32x4){qtw[4], qtw[5], qtw[6], qtw[7]};
            *(LAS u32x4*)(lds + HG_KT + ro) = (u32x4){ktw[0], ktw[1], ktw[2], ktw[3]}; *(LAS u32x4*)(lds + HG_KT + ro + 16) = (u32x4){ktw[4], ktw[5], ktw[6], ktw[7]};
            *(LAS u32x4*)(lds + HG_QH + ro) = (u32x4){qhw[0], qhw[1], qhw[2], qhw[3]}; *(LAS u32x4*)(lds + HG_QH + ro + 16) = (u32x4){qhw[4], qhw[5], qhw[6], qhw[7]};
#pragma unroll
            for (int j = 0; j < 8; ++j) {
                *(LAS unsigned short*)(lds + HG_KTT + (16 * wave + 2 * j) * 144 + 2 * lane) = (unsigned short)(ktw[j] & 0xffffu);
                *(LAS unsigned short*)(lds + HG_KTT + (16 * wave + 2 * j + 1) * 144 + 2 * lane) = (unsigned short)(ktw[j] >> 16);
                *(LAS unsigned short*)(lds + HG_VT + (16 * wave + 2 * j) * 144 + 2 * lane) = (unsigned short)(vw[j] & 0xffffu);
                *(LAS unsigned short*)(lds + HG_VT + (16 * wave + 2 * j + 1) * 144 + 2 * lane) = (unsigned short)(vw[j] >> 16);
            }
            if (lane == 0) {
#pragma unroll
                for (int g = 0; g < 4; ++g) *(LAS f32x4*)(lds + HG_DEC + (16 * wave + 4 * g) * 4) = (f32x4){dec[4 * g], dec[4 * g + 1], dec[4 * g + 2], dec[4 * g + 3]};
            }
#pragma unroll
            for (int g = 0; g < 4; ++g) {
                *(LAS u32x2*)(lds + HG_ST + (32 * eb + r32) * 272 + (32 * (2 * tb) + 8 * g + 4 * hq) * 2) = (u32x2){pkbf(S0[4 * g], S0[4 * g + 1]), pkbf(S0[4 * g + 2], S0[4 * g + 3])};
                *(LAS u32x2*)(lds + HG_ST + (32 * eb + r32) * 272 + (32 * (2 * tb + 1) + 8 * g + 4 * hq) * 2) = (u32x2){pkbf(S1[4 * g], S1[4 * g + 1]), pkbf(S1[4 * g + 2], S1[4 * g + 3])};
            }
        }
        if (c + 1 < SEQ / 64) HG_LOAD(c + 1);
        __syncthreads();
        {
            f32x4 dv0[4], dv1[4];
#pragma unroll
            for (int g = 0; g < 4; ++g) { dv0[g] = *(const LAS f32x4*)(lds + HG_DEC + (32 * (2 * tb) + 8 * g + 4 * hq) * 4); dv1[g] = *(const LAS f32x4*)(lds + HG_DEC + (32 * (2 * tb + 1) + 8 * g + 4 * hq) * 4); }
#pragma unroll
            for (int g = 0; g < 4; ++g)
#pragma unroll
                for (int j = 0; j < 4; ++j) { S0[4 * g + j] *= dv0[g][j]; S1[4 * g + j] *= dv1[g][j]; }
#pragma unroll
            for (int ks = 0; ks < 4; ++ks) {
                const s16x8 Bv = *(const LAS s16x8*)(lds + HG_VT + (32 * eb + r32) * 144 + (16 * ks + 8 * hq) * 2);
                const s16x8 A0 = *(const LAS s16x8*)(lds + HG_KTT + (32 * (2 * tb) + r32) * 144 + (16 * ks + 8 * hq) * 2);
                const s16x8 A1 = *(const LAS s16x8*)(lds + HG_KTT + (32 * (2 * tb + 1) + r32) * 144 + (16 * ks + 8 * hq) * 2);
                S0 = MFMA32(A0, Bv, S0); S1 = MFMA32(A1, Bv, S1);
            }
        }
        f32x16 Oa;
#pragma unroll
        for (int i = 0; i < 16; ++i) Oa[i] = 0.f;
#pragma unroll
        for (int sb = 0; sb < 2; ++sb) {
            if (sb <= tb) {
                f32x16 X;
#pragma unroll
                for (int i = 0; i < 16; ++i) X[i] = 0.f;
#pragma unroll
                for (int ks = 0; ks < 8; ++ks) {
                    const s16x8 A = *(const LAS s16x8*)(lds + HG_KT + (32 * sb + r32) * 272 + (16 * ks + 8 * hq) * 2);
                    const s16x8 B = *(const LAS s16x8*)(lds + HG_QT + (32 * tb + r32) * 272 + (16 * ks + 8 * hq) * 2);
                    X = MFMA32(A, B, X);
                }
                if (sb == tb) {
#pragma unroll
                    for (int i = 0; i < 16; ++i) { const int srow = (i & 3) + 8 * (i >> 2) + 4 * hq; X[i] = srow <= r32 ? X[i] : 0.f; }
                }
#pragma unroll
                for (int ks = 0; ks < 2; ++ks) {
                    const u32x4 xp = (u32x4){pkbf(X[8 * ks], X[8 * ks + 1]), pkbf(X[8 * ks + 2], X[8 * ks + 3]), pkbf(X[8 * ks + 4], X[8 * ks + 5]), pkbf(X[8 * ks + 6], X[8 * ks + 7])};
                    const s16x4 alo = *(const LAS s16x4*)(lds + HG_VT + (32 * eb + r32) * 144 + (32 * sb + 16 * ks + 4 * hq) * 2);
                    const s16x4 ahi = *(const LAS s16x4*)(lds + HG_VT + (32 * eb + r32) * 144 + (32 * sb + 16 * ks + 8 + 4 * hq) * 2);
                    const s16x8 A = __builtin_shufflevector(alo, ahi, 0, 1, 2, 3, 4, 5, 6, 7);
                    Oa = MFMA32(A, __builtin_bit_cast(s16x8, xp), Oa);
                }
            }
        }
#pragma unroll
        for (int ks = 0; ks < 8; ++ks) {
            const s16x8 A = *(const LAS s16x8*)(lds + HG_ST + (32 * eb + r32) * 272 + (16 * ks + 8 * hq) * 2);
            const s16x8 B = *(const LAS s16x8*)(lds + HG_QH + (32 * tb + r32) * 272 + (16 * ks + 8 * hq) * 2);
            Oa = MFMA32(A, B, Oa);
        }
        {
            float* orow = O + HG_TOKROW(c, 32 * tb + r32) * 512 + h * 128 + 32 * eb + 4 * hq;
#pragma unroll
            for (int g = 0; g < 4; ++g) *(f32x4*)(orow + 8 * g) = (f32x4){Oa[4 * g], Oa[4 * g + 1], Oa[4 * g + 2], Oa[4 * g + 3]};
        }
        __syncthreads();
    }
#undef HG_LOAD
#undef HG_TOKROW
}

constexpr int GM_VT = 0;
constexpr int GM_RED = 34816;
__device__ __forceinline__ void gmlp_mfma_item(const Params& p, unsigned char* lds_g, int item) {
    const int tid = threadIdx.x, lane = tid & 63, wave = __builtin_amdgcn_readfirstlane(tid >> 6);
    const int g = item & 3, n = (item >> 2) & 31, b = item >> 7;
    LAS unsigned char* lds = (LAS unsigned char*)lds_g;
    LAS float* red = (LAS float*)(lds + GM_RED);
    const bf16* proj = (const bf16*)(p.ws + WS_PROJ);
    bf16* Y = (bf16*)(p.ws + WS_Y);
    const size_t row0 = (size_t)b * SEQ + n * 128;
    const int q = tid & 127, cq = tid >> 7;
    float v[32];
    {
        const bf16* src = proj + (row0 + q) * NPROJ + C_V + g * 128 + cq * 32;
#pragma unroll
        for (int i = 0; i < 4; ++i) { const u32x4 w = *(const u32x4*)(src + 8 * i);
            v[8 * i] = bflo(w.x); v[8 * i + 1] = bfhi(w.x); v[8 * i + 2] = bflo(w.y); v[8 * i + 3] = bfhi(w.y); v[8 * i + 4] = bflo(w.z); v[8 * i + 5] = bfhi(w.z); v[8 * i + 6] = bflo(w.w); v[8 * i + 7] = bfhi(w.w); }
    }
    float s1 = 0.f;
#pragma unroll
    for (int i = 0; i < 32; ++i) s1 += v[i];
    red[q * 4 + cq] = s1;
    __syncthreads();
    const f32x4 r1 = *(const LAS f32x4*)(red + q * 4);
    const float mu = ((r1[0] + r1[1]) + (r1[2] + r1[3])) * (1.0f / 128.0f);
    float s2 = 0.f;
#pragma unroll
    for (int i = 0; i < 32; ++i) { v[i] -= mu; s2 += v[i] * v[i]; }
    __syncthreads();
    red[q * 4 + cq] = s2;
    __syncthreads();
    const f32x4 r2 = *(const LAS f32x4*)(red + q * 4);
    const float rstd = 1.0f / sqrtf(((r2[0] + r2[1]) + (r2[2] + r2[3])) * (1.0f / 128.0f) + LN_EPS);
#pragma unroll
    for (int i = 0; i < 32; ++i) { const int c = cq * 32 + i; const float o = v[i] * rstd * p.gm_ln_g[g * 128 + c] + p.gm_ln_b[g * 128 + c];
        *(LAS unsigned short*)(lds + GM_VT + c * 272 + 2 * q) = (unsigned short)f2bf(o); }
    __syncthreads();
    const int pb = wave >> 1, ch = wave & 1, r32 = lane & 31, hq = lane >> 5;
    const bf16* Wg = (const bf16*)(p.ws + WS_GW) + (size_t)g * 128 * 128 + (size_t)(32 * pb + r32) * 128 + 8 * hq;
    f32x16 D0, D1;
#pragma unroll
    for (int i = 0; i < 16; ++i) { D0[i] = 0.f; D1[i] = 0.f; }
#pragma unroll
    for (int ks = 0; ks < 8; ++ks) {
        const s16x8 A = *(const s16x8*)(Wg + 16 * ks);
        const s16x8 B0 = *(const LAS s16x8*)(lds + GM_VT + (32 * (2 * ch) + r32) * 272 + (16 * ks + 8 * hq) * 2);
        const s16x8 B1 = *(const LAS s16x8*)(lds + GM_VT + (32 * (2 * ch + 1) + r32) * 272 + (16 * ks + 8 * hq) * 2);
        D0 = MFMA32(A, B0, D0); D1 = MFMA32(A, B1, D1);
    }
#pragma unroll
    for (int i = 0; i < 16; ++i) {
        const int pp = 32 * pb + (i & 3) + 8 * (i >> 2) + 4 * hq; const size_t row = row0 + pp; const float bias = p.gm_bs[g * 128 + pp];
        const int c0 = 32 * (2 * ch) + r32, c1 = c0 + 32;
        const float u0 = __uint_as_float(((unsigned)proj[row * NPROJ + C_U + g * 128 + c0]) << 16), u1 = __uint_as_float(((unsigned)proj[row * NPROJ + C_U + g * 128 + c1]) << 16);
        Y[row * DM + 512 + g * 128 + c0] = (bf16)f2bf(u0 * (D0[i] + bias)); Y[row * DM + 512 + g * 128 + c1] = (bf16)f2bf(u1 * (D1[i] + bias));
    }
    __syncthreads();
}

__device__ __forceinline__ void hgrn_finalize(const Params& p) {
    const int tid = threadIdx.x, lane = tid & 63, wave = tid >> 6;
    const float* OF = (const float*)(p.ws + WS_OF); const float* OB = (const float*)(p.ws + WS_OB);
    const bf16* proj = (const bf16*)(p.ws + WS_PROJ); bf16* Y = (bf16*)(p.ws + WS_Y);
    for (int t = blockIdx.x * NWAVES + wave; t < MTOK; t += gridDim.x * NWAVES) {
        const f32x4 a0 = *(const f32x4*)(OF + (size_t)t * 512 + lane * 8), a1 = *(const f32x4*)(OF + (size_t)t * 512 + lane * 8 + 4);
        const f32x4 b0 = *(const f32x4*)(OB + (size_t)t * 512 + lane * 8), b1 = *(const f32x4*)(OB + (size_t)t * 512 + lane * 8 + 4);
        const f32x4 o0 = a0 + b0, o1 = a1 + b1;
        float ss = o0[0] * o0[0] + o0[1] * o0[1] + o0[2] * o0[2] + o0[3] * o0[3] + o1[0] * o1[0] + o1[1] * o1[1] + o1[2] * o1[2] + o1[3] * o1[3];
        ss += __shfl_xor(ss, 1); ss += __shfl_xor(ss, 2); ss += __shfl_xor(ss, 4); ss += __shfl_xor(ss, 8);
        const float r = 1.0f / sqrtf(ss * (1.0f / 128.0f) + RMS_EPS);
        const u32x4 gw = *(const u32x4*)(proj + (size_t)t * NPROJ + C_G + lane * 8);
        const f32x4 n0 = *(const f32x4*)(p.hg_norm_g + lane * 8), n1 = *(const f32x4*)(p.hg_norm_g + lane * 8 + 4);
        u32x4 w;
        w.x = pk2(o0[0] * r * n0[0] * bflo(gw.x), o0[1] * r * n0[1] * bfhi(gw.x));
        w.y = pk2(o0[2] * r * n0[2] * bflo(gw.y), o0[3] * r * n0[3] * bfhi(gw.y));
        w.z = pk2(o1[0] * r * n1[0] * bflo(gw.z), o1[1] * r * n1[1] * bfhi(gw.z));
        w.w = pk2(o1[2] * r * n1[2] * bflo(gw.w), o1[3] * r * n1[3] * bfhi(gw.w));
        *(u32x4*)(Y + (size_t)t * DM + lane * 8) = w;
    }
}

__device__ __forceinline__ void ln1_pass(const Params& p, float* dst) {
    const int tid = threadIdx.x, lane = tid & 63, wave = tid >> 6;
    bf16* H1B = (bf16*)(p.ws + WS_XB);
    for (int t = blockIdx.x * NWAVES + wave; t < MTOK; t += gridDim.x * NWAVES) {
        float* row = p.out + (size_t)t * DM;
        f32x4 v[4]; float s = 0.f;
#pragma unroll
        for (int j = 0; j < 4; ++j) { v[j] = *(const f32x4*)(row + j * 256 + lane * 4); s += (v[j][0] + v[j][1]) + (v[j][2] + v[j][3]); }
        const float mean = wave_sum(s) * (1.0f / DM); float s2 = 0.f;
#pragma unroll
        for (int j = 0; j < 4; ++j) { v[j] = v[j] - mean; s2 += (v[j][0] * v[j][0] + v[j][1] * v[j][1]) + (v[j][2] * v[j][2] + v[j][3] * v[j][3]); }
        const float rstd = 1.0f / sqrtf(wave_sum(s2) * (1.0f / DM) + LN_EPS);
        float amax = 0.f;
#pragma unroll
        for (int j = 0; j < 4; ++j) { const f32x4 gg = *(const f32x4*)(p.ln1_g + j * 256 + lane * 4), bb = *(const f32x4*)(p.ln1_b + j * 256 + lane * 4);
            const f32x4 hv = v[j] * rstd * gg + bb;
            *(f32x4*)(dst + (size_t)t * DM + j * 256 + lane * 4) = hv;
            unsigned long long w = (unsigned long long)pk2(hv[0], hv[1]) | ((unsigned long long)pk2(hv[2], hv[3]) << 32);
            *(unsigned long long*)(H1B + (size_t)t * DM + j * 256 + lane * 4) = w;
            v[j] = hv; amax = fmaxf(amax, fmaxf(fmaxf(fabsf(hv[0]), fabsf(hv[1])), fmaxf(fabsf(hv[2]), fabsf(hv[3])))); }
        amax = wave_max(amax);
        const float inv = amax > 0.f ? 448.0f / amax : 0.f;
#pragma unroll
        for (int j = 0; j < 4; ++j) *(unsigned*)(p.ws + WS_H8 + (size_t)t * DM + j * 256 + lane * 4) = pk4_fp8(v[j][0] * inv, v[j][1] * inv, v[j][2] * inv, v[j][3] * inv);
        if (lane == 0) ((float*)(p.ws + WS_HS))[t] = amax * (1.0f / 448.0f);
    }
}

__device__ __forceinline__ unsigned mono_key(float f) { const unsigned u = __float_as_uint(f); return u ^ ((unsigned)((int)u >> 31) | 0x80000000u); }
__device__ __forceinline__ float mono_val(unsigned k) { return __uint_as_float(k ^ ((k >> 31) ? 0x80000000u : 0xFFFFFFFFu)); }
#define CE_DESC(a, b) do { const unsigned _mx = (a) > (b) ? (a) : (b), _mn = (a) > (b) ? (b) : (a); (a) = _mx; (b) = _mn; } while (0)
template <int N> __device__ __forceinline__ void bitonic_sort_desc(unsigned (&k)[N]) {
#pragma unroll
    for (int sz = 2; sz <= N; sz <<= 1)
#pragma unroll
        for (int j = sz >> 1; j > 0; j >>= 1)
#pragma unroll
            for (int i = 0; i < N; ++i) { const int l = i ^ j; if (l > i) { if ((i & sz) == 0) CE_DESC(k[i], k[l]); else CE_DESC(k[l], k[i]); } }
}
template <int N> __device__ __forceinline__ void bitonic_merge_desc(unsigned (&k)[N]) {
#pragma unroll
    for (int j = N >> 1; j > 0; j >>= 1)
#pragma unroll
        for (int i = 0; i < N; ++i) { const int l = i ^ j; if (l > i) CE_DESC(k[i], k[l]); }
}
__device__ __forceinline__ void top16_merge(unsigned (&a)[16], const unsigned (&b)[16]) {
#pragma unroll
    for (int i = 0; i < 16; ++i) a[i] = a[i] > b[15 - i] ? a[i] : b[15 - i];
    bitonic_merge_desc<16>(a);
}
template <int CTRL> __device__ __forceinline__ void top16_merge_dpp(unsigned (&a)[16]) {
    unsigned b[16];
#pragma unroll
    for (int i = 0; i < 16; ++i) b[i] = (unsigned)__builtin_amdgcn_mov_dpp((int)a[i], CTRL, 0xF, 0xF, true);
    top16_merge(a, b);
}
constexpr int TK_SEG = 1088;
constexpr int TK_SCR = 128 * TK_SEG;
__device__ __forceinline__ void topk_phase(const Params& p, unsigned char* lds_g) {
    const int tid = threadIdx.x, lane = tid & 63, wave = __builtin_amdgcn_readfirstlane(tid >> 6);
    const float* SC = (const float*)(p.ws + WS_SC);
    int* EID = (int*)(p.ws + WS_EID); float* GATE = (float*)(p.ws + WS_GATE);
    LAS unsigned char* lds = (LAS unsigned char*)lds_g;
    const int seg = tid >> 2, part = tid & 3;
    for (int bt = blockIdx.x; bt < MTOK / 16; bt += gridDim.x) {
        const float* src = SC + (size_t)bt * 16 * NSC;
#pragma unroll
        for (int i = 0; i < 16; ++i) { const int sg = wave * 16 + i;
            __builtin_amdgcn_global_load_lds((const unsigned*)(src + (size_t)sg * 256 + lane * 4), (LAS unsigned*)(lds + sg * TK_SEG), 16, 0, 0); }
        asm volatile("s_waitcnt vmcnt(0)" ::: "memory");
        __syncthreads();
        unsigned V[2][16];
#pragma unroll
        for (int hh = 0; hh < 2; ++hh) {
            unsigned ka[16], kb[16];
#pragma unroll
            for (int i = 0; i < 4; ++i) { const f32x4 v = *(const LAS f32x4*)(lds + seg * TK_SEG + hh * 512 + (4 * i + part) * 16);
#pragma unroll
                for (int j = 0; j < 4; ++j) ka[4 * i + j] = (mono_key(v[j]) & ~127u) | (unsigned)(127 - (16 * i + 4 * part + j)); }
#pragma unroll
            for (int i = 4; i < 8; ++i) { const f32x4 v = *(const LAS f32x4*)(lds + seg * TK_SEG + hh * 512 + (4 * i + part) * 16);
#pragma unroll
                for (int j = 0; j < 4; ++j) kb[4 * (i - 4) + j] = (mono_key(v[j]) & ~127u) | (unsigned)(127 - (16 * i + 4 * part + j)); }
            bitonic_sort_desc<16>(ka); bitonic_sort_desc<16>(kb);
            top16_merge(ka, kb);
            top16_merge_dpp<0xB1>(ka);
            top16_merge_dpp<0x4E>(ka);
#pragma unroll
            for (int i = 0; i < 16; ++i) V[hh][i] = ka[i];
        }
        LAS unsigned* scr = (LAS unsigned*)(lds + TK_SCR + seg * 32);
        if (part == 0) {
#pragma unroll
            for (int hh = 0; hh < 2; ++hh)
#pragma unroll
                for (int w = 0; w < 4; ++w) scr[hh * 4 + w] = (127u - (V[hh][4 * w] & 127u)) | ((127u - (V[hh][4 * w + 1] & 127u)) << 8) | ((127u - (V[hh][4 * w + 2] & 127u)) << 16) | ((127u - (V[hh][4 * w + 3] & 127u)) << 24);
        }
        float v1[16], v2[16];
#pragma unroll
        for (int i = 0; i < 16; ++i) { v1[i] = mono_val(V[0][i] & ~127u); v2[i] = mono_val(V[1][i] & ~127u); }
#define CKEY(a, b) ((mono_key(v1[a] + v2[b]) & ~255u) | (unsigned)(255 - (16 * (a) + (b))))
        unsigned g0[16], g1[16], g2[16], g3[16];
#pragma unroll
        for (int b = 0; b < 16; ++b) g0[b] = CKEY(0, b);
#pragma unroll
        for (int b = 0; b < 8; ++b) g1[b] = CKEY(1, b);
#pragma unroll
        for (int a = 8; a < 16; ++a) g1[8 + (15 - a)] = CKEY(a, 0);
        bitonic_merge_desc<16>(g1);
        g2[0] = CKEY(2, 0); g2[1] = CKEY(2, 1); g2[2] = CKEY(2, 2); g2[3] = CKEY(2, 3); g2[4] = CKEY(2, 4);
        g2[5] = CKEY(3, 0); g2[6] = CKEY(3, 1); g2[7] = CKEY(3, 2); g2[8] = CKEY(3, 3);
        g2[9] = CKEY(4, 0); g2[10] = CKEY(4, 1); g2[11] = CKEY(4, 2);
        g2[12] = CKEY(5, 0); g2[13] = CKEY(5, 1); g2[14] = CKEY(6, 0); g2[15] = CKEY(6, 1);
        bitonic_sort_desc<16>(g2);
        g3[0] = CKEY(7, 0); g3[1] = CKEY(7, 1);
#pragma unroll
        for (int i = 2; i < 16; ++i) g3[i] = 0u;
        top16_merge(g0, g1); top16_merge(g2, g3); top16_merge(g0, g2);
#undef CKEY
        const float mx = mono_val(g0[0] & ~255u);
        unsigned rk[4]; float ex[4]; float den = 0.f;
#pragma unroll
        for (int i = 0; i < 4; ++i) { rk[i] = part == 0 ? g0[4 * i] : (part == 1 ? g0[4 * i + 1] : (part == 2 ? g0[4 * i + 2] : g0[4 * i + 3]));
            ex[i] = __expf(mono_val(rk[i] & ~255u) - mx); den += ex[i]; }
        den += __builtin_bit_cast(float, __builtin_amdgcn_mov_dpp(__builtin_bit_cast(int, den), 0xB1, 0xF, 0xF, true));
        den += __builtin_bit_cast(float, __builtin_amdgcn_mov_dpp(__builtin_bit_cast(int, den), 0x4E, 0xF, 0xF, true));
        const float rden = 1.0f / den;
        asm volatile("s_waitcnt lgkmcnt(0)" ::: "memory");
        const LAS unsigned char* sb = (const LAS unsigned char*)scr;
        const int tl = seg >> 3, h = seg & 7; const size_t obase = (size_t)(bt * 16 + tl) * 128 + h * 16;
#pragma unroll
        for (int i = 0; i < 4; ++i) { const unsigned flat = 255u - (rk[i] & 255u); const int i1 = sb[flat >> 4], i2 = sb[16 + (flat & 15)];
            EID[obase + 4 * i + part] = i1 * 128 + i2; GATE[obase + 4 * i + part] = ex[i] * rden; }
        __syncthreads();
    }
}

__device__ __forceinline__ void tables_to_fp8(const Params& p) {
    const int lane = threadIdx.x & 63, wave = threadIdx.x >> 6;
    for (int rw = blockIdx.x * NWAVES + wave; rw < 2 * 16384; rw += gridDim.x * NWAVES) {
        const int tb = rw >= 16384, e = rw & 16383;
        const float* src = (tb ? p.pv : p.pu) + (size_t)e * DM + lane * 16;
        f32x4 v[4]; float mx = 0.f;
#pragma unroll
        for (int j = 0; j < 4; ++j) { v[j] = *(const f32x4*)(src + 4 * j); mx = fmaxf(mx, fmaxf(fmaxf(fabsf(v[j][0]), fabsf(v[j][1])), fmaxf(fabsf(v[j][2]), fabsf(v[j][3])))); }
        mx = wave_max(mx);
        const float inv = mx > 0.f ? 448.0f / mx : 0.f;
        u32x4 w; w.x = pk4_fp8(v[0][0] * inv, v[0][1] * inv, v[0][2] * inv, v[0][3] * inv); w.y = pk4_fp8(v[1][0] * inv, v[1][1] * inv, v[1][2] * inv, v[1][3] * inv);
        w.z = pk4_fp8(v[2][0] * inv, v[2][1] * inv, v[2][2] * inv, v[2][3] * inv); w.w = pk4_fp8(v[3][0] * inv, v[3][1] * inv, v[3][2] * inv, v[3][3] * inv);
        *(u32x4*)(p.ws + (tb ? WS_V8 : WS_U8) + (size_t)e * DM + lane * 16) = w;
        if (lane == 0) ((float*)(p.ws + (tb ? WS_SV : WS_SU)))[e] = mx * (1.0f / 448.0f);
    }
}

typedef float f32x2 __attribute__((ext_vector_type(2)));
typedef long i64x2 __attribute__((ext_vector_type(2)));
__device__ __forceinline__ void peer_phase(const Params& p, unsigned char* lds_g, float* dst) {
    const int tid = threadIdx.x, lane = tid & 63, wave = __builtin_amdgcn_readfirstlane(tid >> 6);
    LAS unsigned char* wl = (LAS unsigned char*)lds_g + wave * 4096;
    LAS int* ids = (LAS int*)(wl + 1024); LAS float* gts = (LAS float*)(wl + 1536); LAS float* act = (LAS float*)(wl + 2048); LAS float* sus = (LAS float*)(wl + 2560);
    const unsigned char* U8 = p.ws + WS_U8; const unsigned char* V8 = p.ws + WS_V8; const unsigned char* H8 = p.ws + WS_H8;
    const float* SU = (const float*)(p.ws + WS_SU); const float* SV = (const float*)(p.ws + WS_SV); const float* HS = (const float*)(p.ws + WS_HS);
    const int* EID = (const int*)(p.ws + WS_EID); const float* GATE = (const float*)(p.ws + WS_GATE);
    const int r = lane & 15, q = lane >> 4;
    for (int t = blockIdx.x * NWAVES + wave; t < MTOK; t += gridDim.x * NWAVES) {
        const int e_lo = EID[(size_t)t * 128 + lane], e_hi = EID[(size_t)t * 128 + 64 + lane];
        ids[lane] = e_lo; ids[64 + lane] = e_hi;
        gts[lane] = GATE[(size_t)t * 128 + lane] * SV[e_lo]; gts[64 + lane] = GATE[(size_t)t * 128 + 64 + lane] * SV[e_hi];
        const float hs = HS[t];
        sus[lane] = SU[e_lo] * hs; sus[64 + lane] = SU[e_hi] * hs;
        *(LAS u32x4*)(wl + lane * 16) = *(const u32x4*)(H8 + (size_t)t * DM + lane * 16);
        asm volatile("s_waitcnt lgkmcnt(0)" ::: "memory");
        const unsigned char* rp[8];
#pragma unroll
        for (int g = 0; g < 8; ++g) rp[g] = U8 + (size_t)ids[16 * g + r] * DM + q * 16;
        f32x4 acc[8];
#pragma unroll
        for (int g = 0; g < 8; ++g) acc[g] = (f32x4){0.f, 0.f, 0.f, 0.f};
#pragma unroll 2
        for (int s = 0; s < 16; ++s) {
            const i64x2 B = *(const LAS i64x2*)(wl + s * 64 + q * 16);
#pragma unroll
            for (int g = 0; g < 8; ++g) { const i64x2 A = *(const i64x2*)(rp[g] + s * 64);
                acc[g] = __builtin_amdgcn_mfma_f32_16x16x32_fp8_fp8(A[0], B[0], acc[g], 0, 0, 0);
                acc[g] = __builtin_amdgcn_mfma_f32_16x16x32_fp8_fp8(A[1], B[1], acc[g], 0, 0, 0); }
        }
#pragma unroll
        for (int g = 0; g < 8; ++g) { const f32x4 gt = *(const LAS f32x4*)(gts + 16 * g + 4 * q), su = *(const LAS f32x4*)(sus + 16 * g + 4 * q); f32x4 a;
#pragma unroll
            for (int j = 0; j < 4; ++j) a[j] = gt[j] * gelu_tanh(acc[g][j] * su[j]);
            if (r == 0) *(LAS f32x4*)(act + 16 * g + 4 * q) = a; }
        asm volatile("s_waitcnt lgkmcnt(0)" ::: "memory");
        f32x2 o[8];
#pragma unroll
        for (int i = 0; i < 8; ++i) o[i] = (f32x2){0.f, 0.f};
#pragma unroll 8
        for (int k = 0; k < 128; ++k) {
            const int e = __builtin_amdgcn_readfirstlane(ids[k]); const float a = act[k]; const f32x2 a2 = (f32x2){a, a};
            const u32x4 v = *(const u32x4*)(V8 + (size_t)e * DM + lane * 16);
            o[0] += __builtin_amdgcn_cvt_pk_f32_fp8((int)v.x, false) * a2; o[1] += __builtin_amdgcn_cvt_pk_f32_fp8((int)v.x, true) * a2;
            o[2] += __builtin_amdgcn_cvt_pk_f32_fp8((int)v.y, false) * a2; o[3] += __builtin_amdgcn_cvt_pk_f32_fp8((int)v.y, true) * a2;
            o[4] += __builtin_amdgcn_cvt_pk_f32_fp8((int)v.z, false) * a2; o[5] += __builtin_amdgcn_cvt_pk_f32_fp8((int)v.z, true) * a2;
            o[6] += __builtin_amdgcn_cvt_pk_f32_fp8((int)v.w, false) * a2; o[7] += __builtin_amdgcn_cvt_pk_f32_fp8((int)v.w, true) * a2;
        }
        float* row = p.out + (size_t)t * DM + lane * 16;
        f32x4 y[4]; float sm = 0.f;
#pragma unroll
        for (int j = 0; j < 4; ++j) { y[j] = *(const f32x4*)(row + 4 * j) * ALPHA + (f32x4){o[2 * j][0], o[2 * j][1], o[2 * j + 1][0], o[2 * j + 1][1]}; sm += (y[j][0] + y[j][1]) + (y[j][2] + y[j][3]); }
        const float mean = wave_sum(sm) * (1.0f / DM); float s2 = 0.f;
#pragma unroll
        for (int j = 0; j < 4; ++j) { y[j] = y[j] - mean; s2 += (y[j][0] * y[j][0] + y[j][1] * y[j][1]) + (y[j][2] * y[j][2] + y[j][3] * y[j][3]); }
        const float rstd = 1.0f / sqrtf(wave_sum(s2) * (1.0f / DM) + LN_EPS);
#pragma unroll
        for (int j = 0; j < 4; ++j) { const f32x4 gg = *(const f32x4*)(p.ln2_g + lane * 16 + 4 * j), bb = *(const f32x4*)(p.ln2_b + lane * 16 + 4 * j);
            *(f32x4*)(dst + (size_t)t * DM + lane * 16 + 4 * j) = y[j] * rstd * gg + bb; }
        asm volatile("s_waitcnt lgkmcnt(0)" ::: "memory");
    }
}

#ifndef REP_P0
#define REP_P0 1
#endif
#ifndef REP_P1
#define REP_P1 1
#endif
#ifndef REP_HG
#define REP_HG 1
#endif
#ifndef REP_GM
#define REP_GM 1
#endif
#ifndef REP_FIN
#define REP_FIN 1
#endif
#ifndef REP_P3
#define REP_P3 1
#endif
#ifndef REP_LN1
#define REP_LN1 1
#endif
#ifndef REP_TAB
#define REP_TAB 1
#endif
#ifndef REP_P4
#define REP_P4 1
#endif
#ifndef REP_TK
#define REP_TK 1
#endif
#ifndef REP_PEER
#define REP_PEER 1
#endif
#ifndef REP_SYNC
#define REP_SYNC 1
#endif
__global__ void __launch_bounds__(NT, 2) mega(Params p) {
    extern __shared__ __attribute__((aligned(16))) unsigned char lds[];
    cg::grid_group grid = cg::this_grid();
    unsigned char* ws = p.ws;
    const int G = gridDim.x;

    for (int rep = 0; rep < REP_P0; ++rep) { phase0(p, lds); __syncthreads(); }
    for (int rep = 0; rep < REP_SYNC; ++rep) grid.sync();

    for (int rep = 0; rep < REP_P1; ++rep)
    {
        pg8::Gemm g{(const bf16*)(ws + WS_XB), (const bf16*)(ws + WS_WIN), MTOK, NPROJ, DM}; pg8::StaticOrder S; S.init(MTOK, NPROJ, G, (int)blockIdx.x);
        pg8::EpiProj E{(bf16*)(ws + WS_PROJ)};
        pg8::gemm_phase<pg8::EpiProj, pg8::StaticOrder, true, true>((PG8_LAS unsigned char*)lds, g, S, E);
    }
    grid.sync();

    {
        const int half = G / 2;
        if ((int)blockIdx.x < half) { for (int rep = 0; rep < REP_HG; ++rep) for (int it = blockIdx.x; it < 128; it += half) hgrn_chunk_item(p, lds, it); }
        else { for (int rep = 0; rep < REP_GM; ++rep) for (int it = blockIdx.x - half; it < 2048; it += G - half) gmlp_mfma_item(p, lds, it); }
    }
    grid.sync();
    for (int rep = 0; rep < REP_FIN; ++rep) hgrn_finalize(p);
    grid.sync();

    for (int rep = 0; rep < REP_P3; ++rep)
    {
        pg8::Gemm g{(const bf16*)(ws + WS_Y), (const bf16*)(ws + WS_WOUT), MTOK, DM, DM}; pg8::StaticOrder S; S.init(MTOK, DM, G, (int)blockIdx.x);
        pg8::EpiPre E{p.x, p.out};
        pg8::gemm_phase<pg8::EpiPre, pg8::StaticOrder, true, true>((PG8_LAS unsigned char*)lds, g, S, E);
    }
    grid.sync();
    for (int rep = 1; rep < REP_LN1; ++rep) ln1_pass(p, (float*)(ws + WS_PROJ));
    ln1_pass(p, p.out);
    for (int rep = 0; rep < REP_TAB; ++rep) tables_to_fp8(p);
    grid.sync();

    for (int rep = 0; rep < REP_P4; ++rep)
    {
        pg8::Gemm g{(const bf16*)(ws + WS_XB), (const bf16*)(ws + WS_WSC), MTOK, NSC, DM}; pg8::StaticOrder S; S.init(MTOK, NSC, G, (int)blockIdx.x);
        pg8::EpiF32 E{(float*)(ws + WS_SC), NSC};
        pg8::gemm_phase<pg8::EpiF32, pg8::StaticOrder, true, true>((PG8_LAS unsigned char*)lds, g, S, E);
    }
    grid.sync();
    for (int rep = 0; rep < REP_TK; ++rep) topk_phase(p, lds);
    grid.sync();
    for (int rep = 1; rep < REP_PEER; ++rep) peer_phase(p, lds, (float*)(ws + WS_SC));
    peer_phase(p, lds, p.out);
}

extern "C" void kernel_launch(void* const* d_in, const int* in_sizes, int n_in, void* d_out, int out_size, void* d_ws, size_t ws_size, hipStream_t stream) {
    static int grid = 0;
    if (grid == 0) {
        if (n_in != 18 || in_sizes[0] != MTOK * DM || out_size != MTOK * DM || ws_size < WS_END) {
            fprintf(stderr, "kernel_launch: unexpected shapes (n_in %d, in0 %d, out %d, ws %zu); nothing launched\n", n_in, n_in > 0 ? in_sizes[0] : -1, out_size, ws_size); grid = -1; return; }
        int dev = 0, cus = 0, per_cu = 0;
        if (hipGetDevice(&dev) != hipSuccess || hipDeviceGetAttribute(&cus, hipDeviceAttributeMultiprocessorCount, dev) != hipSuccess) { grid = -1; return; }
        if (hipFuncSetAttribute((const void*)mega, hipFuncAttributeMaxDynamicSharedMemorySize, LDS_BYTES) != hipSuccess) { fprintf(stderr, "kernel_launch: hipFuncSetAttribute failed\n"); grid = -1; return; }
        if (hipOccupancyMaxActiveBlocksPerMultiprocessor(&per_cu, (const void*)mega, NT, LDS_BYTES) != hipSuccess || per_cu < 1) { fprintf(stderr, "kernel_launch: occupancy query says %d\n", per_cu); grid = -1; return; }
        grid = cus;
    }
    if (grid < 0) return;
    Params p{};
    p.x = (const float*)d_in[0]; p.w_in = (const float*)d_in[1]; p.lb_logits = (const float*)d_in[2]; p.hg_norm_g = (const float*)d_in[3];
    p.gm_ln_g = (const float*)d_in[4]; p.gm_ln_b = (const float*)d_in[5]; p.gm_ws = (const float*)d_in[6]; p.gm_bs = (const float*)d_in[7];
    p.w_out = (const float*)d_in[8]; p.ln1_g = (const float*)d_in[9]; p.ln1_b = (const float*)d_in[10]; p.wq = (const float*)d_in[11];
    p.k1 = (const float*)d_in[12]; p.k2 = (const float*)d_in[13]; p.pu = (const float*)d_in[14]; p.pv = (const float*)d_in[15];
    p.ln2_g = (const float*)d_in[16]; p.ln2_b = (const float*)d_in[17];
    p.out = (float*)d_out; p.ws = (unsigned char*)d_ws;
    void* args[] = {&p};
    hipError_t e = hipLaunchCooperativeKernel((const void*)mega, dim3(grid), dim3(NT), args, LDS_BYTES, stream);
    if (e != hipSuccess) fprintf(stderr, "kernel_launch: cooperative launch failed: %s (grid %d)\n", hipGetErrorString(e), grid);
}
```

```cpp
#include <hip/hip_runtime.h>
#include <hip/hip_cooperative_groups.h>
#include <cstdio>
#include <cstdint>
namespace cg = cooperative_groups;

namespace pg8 {
#define PG8_LAS __attribute__((address_space(3)))
typedef unsigned short bf16_t;
typedef short bf16x8 __attribute__((ext_vector_type(8)));
typedef float f32x4 __attribute__((ext_vector_type(4)));
typedef unsigned u32x4 __attribute__((ext_vector_type(4)));
constexpr int BM = 256, BK = 64, HALF = 128, HTB = HALF * BK * 2  , STAGE_BYTES = 8 * HTB, NXCD = 8, WGM = 8;

__host__ __device__ __forceinline__ int lds_byte(int r, int c) { const int st = (r >> 4) * 2 + (c >> 5), rr = r & 15, cc = c & 31, ob = rr * 64 + cc * 2; return st * 1024 + (ob ^ (((ob >> 9) & 1) << 5)); }
__host__ __device__ __forceinline__ void stage_rc(int b, int& R, int& C) { const int st = b / 1024, sb = b % 1024, swz = sb ^ (((sb >> 9) & 1) << 5); R = (st >> 1) * 16 + swz / 64; C = (st & 1) * 32 + (swz % 64) / 2; }
__host__ __device__ __forceinline__ int perm32(int rho) { const int n = rho >> 4, i = rho & 15; return 8 * (i >> 2) + 4 * n + (i & 3); }

struct Unit { int pm, pn; };
struct Gemm { const bf16_t* A; const bf16_t* Bt; int M, N, K; };

struct StaticOrder {
    int nM, nN, nwg, G, c;
    __host__ __device__ void init(int M, int N, int G_, int c_) { nM = M / BM; nN = N / BM; nwg = nM * nN; G = G_; c = c_; }
    __host__ __device__ bool next(int i, Unit& u) const {
        const long L = (long)i * G + c; if (L >= nwg) return false;
        int wgid = (int)L; { const int q = nwg / NXCD, r = nwg % NXCD, xcd = wgid % NXCD, off = wgid / NXCD; wgid = (xcd < r ? xcd * (q + 1) : r * (q + 1) + (xcd - r) * q) + off; }
        const int nig = WGM * nN, gid = wgid / nig, fm = gid * WGM, gsz = (nM - fm) < WGM ? (nM - fm) : WGM;
        u.pm = fm + ((wgid % nig) % gsz); u.pn = (wgid % nig) / gsz; return true;
    }
    __device__ __forceinline__ void a_ready(const Unit&) const {}
    __device__ __forceinline__ void done(const Unit&) const {}
};
__device__ __forceinline__ unsigned cvt_pk_bf16(float lo, float hi) { unsigned r; asm volatile("v_cvt_pk_bf16_f32 %0, %1, %2" : "=v"(r) : "v"(lo), "v"(hi)); return r; }
template <class Epi, class Sched, bool ALIGN_EPI = false, bool SP2 = false>
__device__ __forceinline__ void gemm_phase(PG8_LAS unsigned char* lds, const Gemm g, const Sched& S, const Epi& E) {
    const int tid = threadIdx.x, wid = __builtin_amdgcn_readfirstlane(tid >> 6), lane = tid & 63, wr = wid >> 2, wc = wid & 3, fr = lane & 15, fq = lane >> 4;
    const int K = g.K, nt = K / BK;
    unsigned voffA[2], voffB[2];
#pragma unroll
    for (int i = 0; i < 2; ++i) { int R, C; stage_rc(tid * 16 + i * 8192, R, C); const int Rb = Epi::PERM ? ((R & ~31) + perm32(R & 31)) : R;
        voffA[i] = (unsigned)(R * K + C) * 2u; voffB[i] = (unsigned)(Rb * K + C) * 2u; }
    const size_t kstep = (size_t)(BK * 2);
    const size_t hstep = (size_t)HALF * K * 2;
    const size_t tstep = 2 * hstep;
    const unsigned ldsw = (unsigned)wid * 1024u;
    const int aoff = lds_byte(wr * 64 + fr, fq * 8), boff = lds_byte(wc * 32 + fr, fq * 8);
#define PG8_SA(b, h) (((b) * 2 + (h)) * HTB)
#define PG8_SB(b, h) ((4 + (b) * 2 + (h)) * HTB)
#define PG8_STAGE(bufoff, gbase, voff) do { _Pragma("unroll") for (int _i = 0; _i < 2; ++_i) \
        __builtin_amdgcn_global_load_lds((const unsigned*)((const char*)(gbase) + (voff)[_i]), (PG8_LAS unsigned*)(lds + (bufoff) + ldsw + _i * 8192), 16, 0, 0); } while (0)
#define PG8_LDA(dst, b, h) do { _Pragma("unroll") for (int m = 0; m < 4; ++m) _Pragma("unroll") for (int k = 0; k < 2; ++k) dst[m][k] = *(const PG8_LAS bf16x8*)(lds + PG8_SA(b, h) + aoff + m * 2048 + k * 1024); } while (0)
#define PG8_LDB(dst, b, h) do { _Pragma("unroll") for (int n = 0; n < 2; ++n) _Pragma("unroll") for (int k = 0; k < 2; ++k) dst[n][k] = *(const PG8_LAS bf16x8*)(lds + PG8_SB(b, h) + boff + n * 2048 + k * 1024); } while (0)
#define PG8_MMA(ai, bj, At, Bt) do { __builtin_amdgcn_s_setprio(1); _Pragma("unroll") for (int m = 0; m < 4; ++m) _Pragma("unroll") for (int n = 0; n < 2; ++n) _Pragma("unroll") for (int k = 0; k < 2; ++k) \
        acc[ai][bj][m][n] = __builtin_amdgcn_mfma_f32_16x16x32_bf16(Bt[n][k], At[m][k], acc[ai][bj][m][n], 0, 0, 0); __builtin_amdgcn_s_setprio(0); } while (0)
#define PG8_WAIT_V(n) asm volatile("s_waitcnt vmcnt(" #n ")" ::: "memory")
#define PG8_WAIT_L(n) asm volatile("s_waitcnt lgkmcnt(" #n ")" ::: "memory")
#define PG8_BAR __builtin_amdgcn_s_barrier()
#define PG8_SCHED __builtin_amdgcn_sched_barrier(0)
    Unit cur, nxt; int ui = 0;
    if (!S.next(0, cur)) return;
    f32x4 acc[2][2][4][2];
#pragma unroll
    for (int a = 0; a < 2; ++a)
#pragma unroll
        for (int b = 0; b < 2; ++b)
#pragma unroll
            for (int m = 0; m < 4; ++m)
#pragma unroll
                for (int n = 0; n < 2; ++n) acc[a][b][m][n] = (f32x4){0.f, 0.f, 0.f, 0.f};
    bf16x8 At[4][2], B0[2][2], B1[2][2];
    const char* cA = (const char*)g.A + (size_t)cur.pm * tstep; const char* cB = (const char*)g.Bt + (size_t)cur.pn * tstep;
    S.a_ready(cur);
    if constexpr (SP2) {
        PG8_STAGE(PG8_SB(0, 0), cB, voffB); PG8_STAGE(PG8_SB(0, 1), cB + hstep, voffB); PG8_STAGE(PG8_SA(0, 0), cA, voffA); PG8_STAGE(PG8_SA(0, 1), cA + hstep, voffA);
        if (wr == 1) PG8_BAR;
        PG8_WAIT_V(2); PG8_BAR;
        PG8_STAGE(PG8_SB(1, 0), cB + kstep, voffB); PG8_STAGE(PG8_SA(1, 0), cA + kstep, voffA); PG8_STAGE(PG8_SB(1, 1), cB + hstep + kstep, voffB);
        PG8_WAIT_V(6); PG8_BAR;
    } else {
        PG8_STAGE(PG8_SB(0, 0), cB, voffB); PG8_STAGE(PG8_SA(0, 0), cA, voffA); PG8_STAGE(PG8_SB(0, 1), cB + hstep, voffB); PG8_STAGE(PG8_SA(0, 1), cA + hstep, voffA);
        if (wr == 1) PG8_BAR;
        PG8_WAIT_V(4); PG8_BAR;
        PG8_STAGE(PG8_SB(1, 0), cB + kstep, voffB); PG8_STAGE(PG8_SA(1, 0), cA + kstep, voffA); PG8_STAGE(PG8_SB(1, 1), cB + hstep + kstep, voffB);
        PG8_WAIT_V(6); PG8_BAR;
    }
    for (;;) {
        const bool has_next = S.next(ui + 1, nxt);
        const char* nA = has_next ? (const char*)g.A + (size_t)nxt.pm * tstep : cA; const char* nB = has_next ? (const char*)g.Bt + (size_t)nxt.pn * tstep : cB;
        for (int t = 0; t < nt; t += 2) {
            const bool last = (t == nt - 2);
            const char* a1 = cA + (size_t)(t + 1) * kstep;
            const char* a2 = last ? nA : cA + (size_t)(t + 2) * kstep; const char* b2 = last ? nB : cB + (size_t)(t + 2) * kstep;
            const char* a3 = a2 + kstep; const char* b3 = b2 + kstep;
            if (last && has_next) S.a_ready(nxt);
            if constexpr (SP2) {
            PG8_LDB(B0, 0, 0); PG8_LDB(B1, 0, 1); PG8_SCHED; PG8_LDA(At, 0, 0); PG8_STAGE(PG8_SA(1, 1), a1 + hstep, voffA);
            PG8_WAIT_V(8); PG8_WAIT_L(0); PG8_BAR; PG8_MMA(0, 0, At, B0); PG8_MMA(0, 1, At, B1); PG8_BAR; PG8_SCHED;
            PG8_LDA(At, 0, 1); PG8_STAGE(PG8_SB(0, 0), b2, voffB); PG8_STAGE(PG8_SB(0, 1), b2 + hstep, voffB); PG8_STAGE(PG8_SA(0, 0), a2, voffA);
            PG8_WAIT_V(8); PG8_WAIT_L(0); PG8_BAR; PG8_MMA(1, 0, At, B0); PG8_MMA(1, 1, At, B1); PG8_BAR; PG8_SCHED;
            PG8_LDB(B0, 1, 0); PG8_LDB(B1, 1, 1); PG8_SCHED; PG8_LDA(At, 1, 0); PG8_STAGE(PG8_SA(0, 1), a2 + hstep, voffA);
            PG8_WAIT_V(8); PG8_WAIT_L(0); PG8_BAR; PG8_MMA(0, 0, At, B0); PG8_MMA(0, 1, At, B1); PG8_BAR; PG8_SCHED;
            PG8_LDA(At, 1, 1); PG8_STAGE(PG8_SB(1, 0), b3, voffB); PG8_STAGE(PG8_SB(1, 1), b3 + hstep, voffB); PG8_STAGE(PG8_SA(1, 0), a3, voffA);
            PG8_WAIT_V(8); PG8_WAIT_L(0); PG8_BAR; PG8_MMA(1, 0, At, B0); PG8_MMA(1, 1, At, B1); PG8_BAR; PG8_SCHED;
            } else {
            PG8_LDB(B0, 0, 0); PG8_SCHED; PG8_LDA(At, 0, 0); PG8_STAGE(PG8_SA(1, 1), a1 + hstep, voffA);
            PG8_WAIT_L(8); PG8_BAR; PG8_WAIT_L(0); PG8_MMA(0, 0, At, B0); PG8_BAR; PG8_SCHED;
            PG8_LDB(B1, 0, 1); PG8_STAGE(PG8_SB(0, 0), b2, voffB);
            PG8_BAR; PG8_WAIT_L(0); PG8_MMA(0, 1, At, B1); PG8_BAR;
            PG8_LDA(At, 0, 1); PG8_STAGE(PG8_SA(0, 0), a2, voffA);
            PG8_BAR; PG8_WAIT_L(0); PG8_MMA(1, 0, At, B0); PG8_BAR; PG8_SCHED;
            PG8_STAGE(PG8_SB(0, 1), b2 + hstep, voffB);
            PG8_WAIT_V(6); PG8_BAR; PG8_MMA(1, 1, At, B1); PG8_BAR;
            PG8_LDB(B0, 1, 0); PG8_SCHED; PG8_LDA(At, 1, 0); PG8_STAGE(PG8_SA(0, 1), a2 + hstep, voffA);
            PG8_WAIT_L(8); PG8_BAR; PG8_WAIT_L(0); PG8_MMA(0, 0, At, B0); PG8_BAR; PG8_SCHED;
            PG8_LDB(B1, 1, 1); PG8_STAGE(PG8_SB(1, 0), b3, voffB);
            PG8_BAR; PG8_WAIT_L(0); PG8_MMA(0, 1, At, B1); PG8_BAR;
            PG8_LDA(At, 1, 1); PG8_STAGE(PG8_SA(1, 0), a3, voffA);
            PG8_BAR; PG8_WAIT_L(0); PG8_MMA(1, 0, At, B0); PG8_BAR; PG8_SCHED;
            PG8_STAGE(PG8_SB(1, 1), b3 + hstep, voffB);
            PG8_WAIT_V(6); PG8_BAR; PG8_MMA(1, 1, At, B1); PG8_BAR;
            }
        }
        if constexpr (ALIGN_EPI) { if (wr == 0) PG8_BAR; }
        if constexpr (!Epi::AFTER_DRAIN) { E(acc, cur, wr, wc, fr, fq); S.done(cur); }
        if (!has_next) break;
#pragma unroll
        for (int a = 0; a < 2; ++a)
#pragma unroll
            for (int b = 0; b < 2; ++b)
#pragma unroll
                for (int m = 0; m < 4; ++m)
#pragma unroll
                    for (int n = 0; n < 2; ++n) acc[a][b][m][n] = (f32x4){0.f, 0.f, 0.f, 0.f};
        cur = nxt; cA = nA; cB = nB; ++ui;
        if constexpr (ALIGN_EPI) { if (wr == 1) PG8_BAR; }
    }
    PG8_WAIT_V(0);
    if constexpr (!ALIGN_EPI) { if (wr == 0) PG8_BAR; }
    PG8_BAR;
    if constexpr (Epi::AFTER_DRAIN) { E.fused(acc, cur, wr, wc, fr, fq, lds, wid, lane); S.done(cur); }
#undef PG8_SA
#undef PG8_SB
#undef PG8_STAGE
#undef PG8_LDA
#undef PG8_LDB
#undef PG8_MMA
#undef PG8_WAIT_V
#undef PG8_WAIT_L
#undef PG8_BAR
#undef PG8_SCHED
}
}

constexpr int NT = 512, NWAVES = 8;
constexpr int LDS_BYTES = 147456;
constexpr int MTOK = 65536, DM = 1024, SEQ = 4096, NBATCH = 16;
constexpr int NPROJ = 3584;
constexpr int C_Q = 0, C_ZF = 512, C_ZB = 1024, C_I = 1536, C_G = 2048, C_U = 2560, C_V = 3072;
constexpr int NSC = 2048;
constexpr float ALPHA = 1.189207115002721f;
constexpr float LN_EPS = 1e-5f, RMS_EPS = 1e-6f;

constexpr size_t MiB = 1u << 20;
constexpr size_t WS_WIN = 1 * MiB;
constexpr size_t WS_WOUT = 8 * MiB;
constexpr size_t WS_WSC = 10 * MiB;
constexpr size_t WS_GW = 14 * MiB;
constexpr size_t WS_XB = 16 * MiB;
constexpr size_t WS_PROJ = 144 * MiB;
constexpr size_t WS_Y = 592 * MiB;
constexpr size_t WS_OF = 720 * MiB;
constexpr size_t WS_OB = 848 * MiB;
constexpr size_t WS_SC = 144 * MiB;
constexpr size_t WS_EID = 720 * MiB;
constexpr size_t WS_GATE = 752 * MiB;
constexpr size_t WS_U8 = 656 * MiB;
constexpr size_t WS_V8 = 672 * MiB;
constexpr size_t WS_SU = 688 * MiB;
constexpr size_t WS_SV = 689 * MiB;
constexpr size_t WS_HS = 690 * MiB;
constexpr size_t WS_HIDP = 144 * MiB;
constexpr size_t WS_EIDP = 432 * MiB;
constexpr size_t WS_ACT = 400 * MiB;
constexpr size_t WS_H8 = 784 * MiB;
constexpr size_t WS_END = 976 * MiB;

typedef unsigned short bf16;
typedef float f32x4 __attribute__((ext_vector_type(4)));
typedef unsigned u32x4 __attribute__((ext_vector_type(4)));
#define LAS __attribute__((address_space(3)))

__device__ __forceinline__ unsigned f2bf(float f) { unsigned u = __float_as_uint(f); return (u + 0x7fffu + ((u >> 16) & 1u)) >> 16; }
__device__ __forceinline__ unsigned pk2(float lo, float hi) { return f2bf(lo) | (f2bf(hi) << 16); }
__device__ __forceinline__ float bflo(unsigned w) { return __uint_as_float(w << 16); }
__device__ __forceinline__ float bfhi(unsigned w) { return __uint_as_float(w & 0xffff0000u); }
__device__ __forceinline__ float sigmoidf_(float z) { return 1.0f / (1.0f + __expf(-z)); }
__device__ __forceinline__ float gelu_tanh(float x) { return x / (1.0f + __expf(-1.5957691216057308f * (x + 0.044715f * x * x * x))); }
__device__ __forceinline__ float silu_(float x) { return x / (1.0f + __expf(-x)); }
__device__ __forceinline__ float wave_sum(float v) {
#pragma unroll
    for (int o = 1; o < 64; o <<= 1) v += __shfl_xor(v, o);
    return v;
}

__device__ __forceinline__ float wave_max(float v) {
#pragma unroll
    for (int o = 1; o < 64; o <<= 1) v = fmaxf(v, __shfl_xor(v, o));
    return v;
}
__device__ __forceinline__ unsigned pk4_fp8(float a, float b, float c, float d) { int w = __builtin_amdgcn_cvt_pk_fp8_f32(a, b, 0, false); w = __builtin_amdgcn_cvt_pk_fp8_f32(c, d, w, true); return (unsigned)w; }

struct Params {
    const float *x, *w_in, *lb_logits, *hg_norm_g, *gm_ln_g, *gm_ln_b, *gm_ws, *gm_bs, *w_out, *ln1_g, *ln1_b, *wq, *k1, *k2, *pu, *pv, *ln2_g, *ln2_b;
    float* out; unsigned char* ws;
};

namespace pg8 {
struct EpiProj {
    static constexpr bool PERM = true, AFTER_DRAIN = false;
    bf16* O;
    __device__ __forceinline__ void operator()(const f32x4 (&acc)[2][2][4][2], const Unit& u, int wr, int wc, int fr, int fq) const {
        const int row0 = u.pm * BM + wr * 64 + fr, col0 = u.pn * BM + wc * 32 + 8 * fq;
        const int act = u.pn >= 10 ? 2 : (u.pn >= 8 ? 1 : 0);
#pragma unroll
        for (int ai = 0; ai < 2; ++ai)
#pragma unroll
            for (int m = 0; m < 4; ++m) { bf16* rowp = O + (size_t)(row0 + ai * HALF + m * 16) * NPROJ + col0;
#pragma unroll
                for (int bj = 0; bj < 2; ++bj) { f32x4 v0 = acc[ai][bj][m][0], v1 = acc[ai][bj][m][1];
                    if (act == 2) {
#pragma unroll
                        for (int j = 0; j < 4; ++j) { v0[j] = gelu_tanh(v0[j]); v1[j] = gelu_tanh(v1[j]); } }
                    else if (act == 1) {
#pragma unroll
                        for (int j = 0; j < 4; ++j) { v0[j] = silu_(v0[j]); v1[j] = silu_(v1[j]); } }
                    u32x4 w; w.x = cvt_pk_bf16(v0[0], v0[1]); w.y = cvt_pk_bf16(v0[2], v0[3]); w.z = cvt_pk_bf16(v1[0], v1[1]); w.w = cvt_pk_bf16(v1[2], v1[3]);
                    *(u32x4*)(rowp + bj * HALF) = w; } }
    }
};
struct EpiPre {
    static constexpr bool PERM = false, AFTER_DRAIN = false;
    const float* X; float* P;
    __device__ __forceinline__ void operator()(const f32x4 (&acc)[2][2][4][2], const Unit& u, int wr, int wc, int fr, int fq) const {
        const int row0 = u.pm * BM + wr * 64 + fr, col0 = u.pn * BM + wc * 32 + 4 * fq;
#pragma unroll
        for (int ai = 0; ai < 2; ++ai)
#pragma unroll
            for (int m = 0; m < 4; ++m) { const size_t off = (size_t)(row0 + ai * HALF + m * 16) * DM + col0;
#pragma unroll
                for (int bj = 0; bj < 2; ++bj)
#pragma unroll
                    for (int n = 0; n < 2; ++n) { const f32x4 xv = *(const f32x4*)(X + off + bj * HALF + n * 16);
                        *(f32x4*)(P + off + bj * HALF + n * 16) = xv * ALPHA + acc[ai][bj][m][n]; } }
    }
};
struct EpiF32 {
    static constexpr bool PERM = false, AFTER_DRAIN = false;
    float* C; int ldc;
    __device__ __forceinline__ void operator()(const f32x4 (&acc)[2][2][4][2], const Unit& u, int wr, int wc, int fr, int fq) const {
        const int row0 = u.pm * BM + wr * 64 + fr, col0 = u.pn * BM + wc * 32 + 4 * fq;
#pragma unroll
        for (int ai = 0; ai < 2; ++ai)
#pragma unroll
            for (int m = 0; m < 4; ++m) { float* rowp = C + (size_t)(row0 + ai * HALF + m * 16) * ldc + col0;
#pragma unroll
                for (int bj = 0; bj < 2; ++bj)
#pragma unroll
                    for (int n = 0; n < 2; ++n) *(f32x4*)(rowp + bj * HALF + n * 16) = acc[ai][bj][m][n]; }
    }
};
}

__device__ __forceinline__ void p0_transpose_item(const float* W, int K, int N, bf16* WT, LAS float* scr, int item, int lane) {
    const int nblk = N / 32, kb = item / nblk, nb = item % nblk, k0 = 64 * kb, n0 = 32 * nb;
#pragma unroll 8
    for (int i = 0; i < 32; ++i) { const int kk = 2 * i + (lane >> 5); scr[kk * 33 + (lane & 31)] = W[(size_t)(k0 + kk) * N + n0 + (lane & 31)]; }
    asm volatile("s_waitcnt lgkmcnt(0)" ::: "memory");
    const int c = lane & 7;
#pragma unroll
    for (int j = 0; j < 4; ++j) { const int n = (lane >> 3) + 8 * j; const LAS float* s = scr + (8 * c) * 33 + n;
        u32x4 o; o.x = pk2(s[0 * 33], s[1 * 33]); o.y = pk2(s[2 * 33], s[3 * 33]); o.z = pk2(s[4 * 33], s[5 * 33]); o.w = pk2(s[6 * 33], s[7 * 33]);
        *(u32x4*)(WT + (size_t)(n0 + n) * K + k0 + 8 * c) = o; }
    asm volatile("s_waitcnt lgkmcnt(0)" ::: "memory");
}

__device__ __forceinline__ void phase0(const Params& p, unsigned char* lds_g) {
    const int tid = threadIdx.x, lane = tid & 63, wave = tid >> 6;
    unsigned char* ws = p.ws;
    {
        const size_t n8 = (size_t)MTOK * DM / 8, gsz = (size_t)gridDim.x * NT;
        const f32x4* x4 = (const f32x4*)p.x; u32x4* o = (u32x4*)(ws + WS_XB);
        for (size_t i = (size_t)blockIdx.x * NT + tid; i < n8; i += gsz) { const f32x4 a = x4[2 * i], b = x4[2 * i + 1];
            u32x4 w; w.x = pk2(a[0], a[1]); w.y = pk2(a[2], a[3]); w.z = pk2(b[0], b[1]); w.w = pk2(b[2], b[3]); o[i] = w; }
    }
    {
        const f32x4* w4 = (const f32x4*)p.gm_ws; u32x4* o = (u32x4*)(ws + WS_GW);
        for (int i = blockIdx.x * NT + tid; i < 4 * 128 * 128 / 8; i += gridDim.x * NT) { const f32x4 a = w4[2 * i], b = w4[2 * i + 1];
            u32x4 w; w.x = pk2(a[0], a[1]); w.y = pk2(a[2], a[3]); w.z = pk2(b[0], b[1]); w.w = pk2(b[2], b[3]); o[i] = w; }
    }
    {
        LAS float* scr = (LAS float*)(lds_g + wave * 16384);
        const int gw = blockIdx.x * NWAVES + wave, NGW = gridDim.x * NWAVES;
        constexpr int I_IN = (DM / 64) * (NPROJ / 32), I_OUT = (DM / 64) * (DM / 32);
        for (int it = gw; it < I_IN + I_OUT; it += NGW) {
            if (it < I_IN) p0_transpose_item(p.w_in, DM, NPROJ, (bf16*)(ws + WS_WIN), scr, it, lane);
            else p0_transpose_item(p.w_out, DM, DM, (bf16*)(ws + WS_WOUT), scr, it - I_IN, lane);
        }
    }
    __syncthreads();
    {
        float* Ks = (float*)lds_g;
        float* Ws = (float*)(lds_g + 128 * 132 * 4);
        bf16* WscT = (bf16*)(ws + WS_WSC);
        for (int it = blockIdx.x; it < 256; it += gridDim.x) {
            const int combo = it >> 4, dt = it & 15, h = combo >> 1, half = combo & 1, d0 = dt * 64;
            const float* kp = (half ? p.k2 : p.k1) + (size_t)h * 128 * 128;
            for (int i = tid; i < 128 * 128; i += NT) Ks[(i >> 7) * 132 + (i & 127)] = kp[i];
            for (int i = tid; i < 64 * 128; i += NT) Ws[i] = p.wq[(size_t)(d0 + (i >> 7)) * 2048 + h * 256 + half * 128 + (i & 127)];
            __syncthreads();
            const int key = tid & 127, dg = tid >> 7;
            float acc[16];
#pragma unroll
            for (int i = 0; i < 16; ++i) acc[i] = 0.f;
            for (int j = 0; j < 128; j += 4) {
                const f32x4 kv = *(const f32x4*)(Ks + key * 132 + j);
#pragma unroll
                for (int i = 0; i < 16; ++i) { const f32x4 wv = *(const f32x4*)(Ws + (dg * 16 + i) * 128 + j);
                    acc[i] += kv[0] * wv[0] + kv[1] * wv[1] + kv[2] * wv[2] + kv[3] * wv[3]; }
            }
            bf16* orow = WscT + (size_t)(h * 256 + half * 128 + key) * DM + d0 + dg * 16;
            u32x4 w0, w1; w0.x = pk2(acc[0], acc[1]); w0.y = pk2(acc[2], acc[3]); w0.z = pk2(acc[4], acc[5]); w0.w = pk2(acc[6], acc[7]);
            w1.x = pk2(acc[8], acc[9]); w1.y = pk2(acc[10], acc[11]); w1.z = pk2(acc[12], acc[13]); w1.w = pk2(acc[14], acc[15]);
            *(u32x4*)orow = w0; *(u32x4*)(orow + 8) = w1;
            __syncthreads();
        }
    }
}

typedef float f32x16 __attribute__((ext_vector_type(16)));
typedef float f32x2v __attribute__((ext_vector_type(2)));
typedef __bf16 bf16x2v __attribute__((ext_vector_type(2)));
typedef short s16x8 __attribute__((ext_vector_type(8)));
typedef short s16x4 __attribute__((ext_vector_type(4)));
typedef unsigned u32x2 __attribute__((ext_vector_type(2)));
__device__ __forceinline__ unsigned pkbf(float lo, float hi) { return __builtin_bit_cast(unsigned, __builtin_convertvector((f32x2v){lo, hi}, bf16x2v)); }
#define MFMA32(a, b, c) __builtin_amdgcn_mfma_f32_32x32x16_bf16((a), (b), (c), 0, 0, 0)
#define DPP_MULSTEP(v, ctrl, rmask) v *= __builtin_bit_cast(float, __builtin_amdgcn_update_dpp(0x3f800000, __builtin_bit_cast(int, v), ctrl, rmask, 0xf, false))
constexpr int HG_QT = 0, HG_KT = 17408, HG_QH = 34816;
constexpr int HG_KTT = 52224, HG_VT = 70656;
constexpr int HG_ST = 89088;
constexpr int HG_DEC = 123904;
__device__ __forceinline__ void hgrn_chunk_item(const Params& p, unsigned char* lds_g, int item) {
    const int tid = threadIdx.x, lane = tid & 63, wave = __builtin_amdgcn_readfirstlane(tid >> 6);
    const int b = item >> 3, h = (item >> 1) & 3, dir = item & 1;
    LAS unsigned char* lds = (LAS unsigned char*)lds_g;
    const bf16* proj = (const bf16*)(p.ws + WS_PROJ);
    float* O = (float*)(p.ws + (dir ? WS_OB : WS_OF));
    const int zc = (dir ? C_ZB : C_ZF) + h * 128 + 16 * wave, qc = C_Q + h * 128 + 16 * wave, vc = C_I + h * 128 + 16 * wave;
    float lb[16];
#pragma unroll
    for (int i = 0; i < 16; ++i) { const int c = h * 128 + 16 * wave + i; const float l0 = p.lb_logits[(dir * 2 + 0) * 512 + c], l1 = p.lb_logits[(dir * 2 + 1) * 512 + c]; lb[i] = 1.0f / (1.0f + __expf(l1 - l0)); }
    const int eb = wave >> 1, tb = wave & 1, r32 = lane & 31, hq = lane >> 5;
#define HG_TOKROW(c_, l_) ((size_t)b * SEQ + (dir ? (SEQ - 1 - ((c_) * 64 + (l_))) : ((c_) * 64 + (l_))))
    u32x4 zr0, zr1, qr0, qr1, vr0, vr1;
#define HG_LOAD(c_) do { const bf16* pr_ = proj + HG_TOKROW(c_, lane) * NPROJ; zr0 = *(const u32x4*)(pr_ + zc); zr1 = *(const u32x4*)(pr_ + zc + 8); \
        qr0 = *(const u32x4*)(pr_ + qc); qr1 = *(const u32x4*)(pr_ + qc + 8); vr0 = *(const u32x4*)(pr_ + vc); vr1 = *(const u32x4*)(pr_ + vc + 8); } while (0)
    HG_LOAD(0);
    f32x16 S0, S1;
#pragma unroll
    for (int i = 0; i < 16; ++i) { S0[i] = 0.f; S1[i] = 0.f; }
    for (int c = 0; c < SEQ / 64; ++c) {
        {
            const unsigned zw[8] = {zr0.x, zr0.y, zr0.z, zr0.w, zr1.x, zr1.y, zr1.z, zr1.w};
            const unsigned qw[8] = {qr0.x, qr0.y, qr0.z, qr0.w, qr1.x, qr1.y, qr1.z, qr1.w};
            const unsigned vw[8] = {vr0.x, vr0.y, vr0.z, vr0.w, vr1.x, vr1.y, vr1.z, vr1.w};
            unsigned qtw[8], ktw[8], qhw[8]; float dec[16];
#pragma unroll
            for (int j = 0; j < 8; ++j) {
                float qt2[2], kt2[2], qh2[2];
#pragma unroll
                for (int u = 0; u < 2; ++u) {
                    const int d = 2 * j + u;
                    const float z = fminf(fmaxf(u ? bfhi(zw[j]) : bflo(zw[j]), -80.0f), 80.0f), q = u ? bfhi(qw[j]) : bflo(qw[j]);
                    const float ez = __expf(-z), sg = __builtin_amdgcn_rcpf(1.0f + ez), oml = 1.0f - lb[d];
                    const float f = lb[d] + oml * sg, kk = oml * ez * sg;
                    float P = f;
                    DPP_MULSTEP(P, 0x111, 0xf); DPP_MULSTEP(P, 0x112, 0xf); DPP_MULSTEP(P, 0x114, 0xf); DPP_MULSTEP(P, 0x118, 0xf);
                    DPP_MULSTEP(P, 0x142, 0xa); DPP_MULSTEP(P, 0x143, 0xc);
                    const float P63 = __builtin_bit_cast(float, __builtin_amdgcn_readlane(__builtin_bit_cast(int, P), 63));
                    const float iP63 = __builtin_amdgcn_rcpf(P63);
                    qh2[u] = q * P; qt2[u] = qh2[u] * iP63; kt2[u] = kk * P63 * __builtin_amdgcn_rcpf(P); dec[d] = P63;
                }
                qtw[j] = pkbf(qt2[0], qt2[1]); ktw[j] = pkbf(kt2[0], kt2[1]); qhw[j] = pkbf(qh2[0], qh2[1]);
            }
            const int ro = lane * 272 + wave * 32;
            *(LAS u32x4*)(lds + HG_QT + ro) = (u32x4){qtw[0], qtw[1], qtw[2], qtw[3]}; *(LAS u32x4*)(lds + HG_QT + ro + 16) = (u32x4){qtw[4], qtw[5], qtw[6], qtw[7]};
            *(LAS u32x4*)(lds + HG_KT + ro) = (u32x4){ktw[0], ktw[1], ktw[2], ktw[3]}; *(LAS u32x4*)(lds + HG_KT + ro + 16) = (u32x4){ktw[4], ktw[5], ktw[6], ktw[7]};
            *(LAS u32x4*)(lds + HG_QH + ro) = (u32x4){qhw[0], qhw[1], qhw[2], qhw[3]}; *(LAS u32x4*)(lds + HG_QH + ro + 16) = (u32x4){qhw[4], qhw[5], qhw[6], qhw[7]};
#pragma unroll
            for (int j = 0; j < 8; ++j) {
                *(LAS unsigned short*)(lds + HG_KTT + (16 * wave + 2 * j) * 144 + 2 * lane) = (unsigned short)(ktw[j] & 0xffffu);
                *(LAS unsigned short*)(lds + HG_KTT + (16 * wave + 2 * j + 1) * 144 + 2 * lane) = (unsigned short)(ktw[j] >> 16);
                *(LAS unsigned short*)(lds + HG_VT + (16 * wave + 2 * j) * 144 + 2 * lane) = (unsigned short)(vw[j] & 0xffffu);
                *(LAS unsigned short*)(lds + HG_VT + (16 * wave + 2 * j + 1) * 144 + 2 * lane) = (unsigned short)(vw[j] >> 16);
            }
            if (lane == 0) {
#pragma unroll
                for (int g = 0; g < 4; ++g) *(LAS f32x4*)(lds + HG_DEC + (16 * wave + 4 * g) * 4) = (f32x4){dec[4 * g], dec[4 * g + 1], dec[4 * g + 2], dec[4 * g + 3]};
            }
#pragma unroll
            for (int g = 0; g < 4; ++g) {
                *(LAS u32x2*)(lds + HG_ST + (32 * eb + r32) * 272 + (32 * (2 * tb) + 8 * g + 4 * hq) * 2) = (u32x2){pkbf(S0[4 * g], S0[4 * g + 1]), pkbf(S0[4 * g + 2], S0[4 * g + 3])};
                *(LAS u32x2*)(lds + HG_ST + (32 * eb + r32) * 272 + (32 * (2 * tb + 1) + 8 * g + 4 * hq) * 2) = (u32x2){pkbf(S1[4 * g], S1[4 * g + 1]), pkbf(S1[4 * g + 2], S1[4 * g + 3])};
            }
        }
        if (c + 1 < SEQ / 64) HG_LOAD(c + 1);
        __syncthreads();
        {
            f32x4 dv0[4], dv1[4];
#pragma unroll
            for (int g = 0; g < 4; ++g) { dv0[g] = *(const LAS f32x4*)(lds + HG_DEC + (32 * (2 * tb) + 8 * g + 4 * hq) * 4); dv1[g] = *(const LAS f32x4*)(lds + HG_DEC + (32 * (2 * tb + 1) + 8 * g + 4 * hq) * 4); }
#pragma unroll
            for (int g = 0; g < 4; ++g)
#pragma unroll
                for (int j = 0; j < 4; ++j) { S0[4 * g + j] *= dv0[g][j]; S1[4 * g + j] *= dv1[g][j]; }
#pragma unroll
            for (int ks = 0; ks < 4; ++ks) {
                const s16x8 Bv = *(const LAS s16x8*)(lds + HG_VT + (32 * eb + r32) * 144 + (16 * ks + 8 * hq) * 2);
                const s16x8 A0 = *(const LAS s16x8*)(lds + HG_KTT + (32 * (2 * tb) + r32) * 144 + (16 * ks + 8 * hq) * 2);
                const s16x8 A1 = *(const LAS s16x8*)(lds + HG_KTT + (32 * (2 * tb + 1) + r32) * 144 + (16 * ks + 8 * hq) * 2);
                S0 = MFMA32(A0, Bv, S0); S1 = MFMA32(A1, Bv, S1);
            }
        }
        f32x16 Oa;
#pragma unroll
        for (int i = 0; i < 16; ++i) Oa[i] = 0.f;
#pragma unroll
        for (int sb = 0; sb < 2; ++sb) {
            if (sb <= tb) {
                f32x16 X;
#pragma unroll
                for (int i = 0; i < 16; ++i) X[i] = 0.f;
#pragma unroll
                for (int ks = 0; ks < 8; ++ks) {
                    const s16x8 A = *(const LAS s16x8*)(lds + HG_KT + (32 * sb + r32) * 272 + (16 * ks + 8 * hq) * 2);
                    const s16x8 B = *(const LAS s16x8*)(lds + HG_QT + (32 * tb + r32) * 272 + (16 * ks + 8 * hq) * 2);
                    X = MFMA32(A, B, X);
                }
                if (sb == tb) {
#pragma unroll
                    for (int i = 0; i < 16; ++i) { const int srow = (i & 3) + 8 * (i >> 2) + 4 * hq; X[i] = srow <= r32 ? X[i] : 0.f; }
                }
#pragma unroll
                for (int ks = 0; ks < 2; ++ks) {
                    const u32x4 xp = (u32x4){pkbf(X[8 * ks], X[8 * ks + 1]), pkbf(X[8 * ks + 2], X[8 * ks + 3]), pkbf(X[8 * ks + 4], X[8 * ks + 5]), pkbf(X[8 * ks + 6], X[8 * ks + 7])};
                    const s16x4 alo = *(const LAS s16x4*)(lds + HG_VT + (32 * eb + r32) * 144 + (32 * sb + 16 * ks + 4 * hq) * 2);
                    const s16x4 ahi = *(const LAS s16x4*)(lds + HG_VT + (32 * eb + r32) * 144 + (32 * sb + 16 * ks + 8 + 4 * hq) * 2);
                    const s16x8 A = __builtin_shufflevector(alo, ahi, 0, 1, 2, 3, 4, 5, 6, 7);
                    Oa = MFMA32(A, __builtin_bit_cast(s16x8, xp), Oa);
                }
            }
        }
#pragma unroll
        for (int ks = 0; ks < 8; ++ks) {
            const s16x8 A = *(const LAS s16x8*)(lds + HG_ST + (32 * eb + r32) * 272 + (16 * ks + 8 * hq) * 2);
            const s16x8 B = *(const LAS s16x8*)(lds + HG_QH + (32 * tb + r32) * 272 + (16 * ks + 8 * hq) * 2);
            Oa = MFMA32(A, B, Oa);
        }
        {
            float* orow = O + HG_TOKROW(c, 32 * tb + r32) * 512 + h * 128 + 32 * eb + 4 * hq;
#pragma unroll
            for (int g = 0; g < 4; ++g) *(f32x4*)(orow + 8 * g) = (f32x4){Oa[4 * g], Oa[4 * g + 1], Oa[4 * g + 2], Oa[4 * g + 3]};
        }
        __syncthreads();
    }
#undef HG_LOAD
#undef HG_TOKROW
}

constexpr int GM_VT = 0;
constexpr int GM_RED = 34816;
__device__ __forceinline__ void gmlp_mfma_item(const Params& p, unsigned char* lds_g, int item) {
    const int tid = threadIdx.x, lane = tid & 63, wave = __builtin_amdgcn_readfirstlane(tid >> 6);
    const int g = item & 3, n = (item >> 2) & 31, b = item >> 7;
    LAS unsigned char* lds = (LAS unsigned char*)lds_g;
    LAS float* red = (LAS float*)(lds + GM_RED);
    const bf16* proj = (const bf16*)(p.ws + WS_PROJ);
    bf16* Y = (bf16*)(p.ws + WS_Y);
    const size_t row0 = (size_t)b * SEQ + n * 128;
    const int q = tid & 127, cq = tid >> 7;
    float v[32];
    {
        const bf16* src = proj + (row0 + q) * NPROJ + C_V + g * 128 + cq * 32;
#pragma unroll
        for (int i = 0; i < 4; ++i) { const u32x4 w = *(const u32x4*)(src + 8 * i);
            v[8 * i] = bflo(w.x); v[8 * i + 1] = bfhi(w.x); v[8 * i + 2] = bflo(w.y); v[8 * i + 3] = bfhi(w.y); v[8 * i + 4] = bflo(w.z); v[8 * i + 5] = bfhi(w.z); v[8 * i + 6] = bflo(w.w); v[8 * i + 7] = bfhi(w.w); }
    }
    float s1 = 0.f;
#pragma unroll
    for (int i = 0; i < 32; ++i) s1 += v[i];
    red[q * 4 + cq] = s1;
    __syncthreads();
    const f32x4 r1 = *(const LAS f32x4*)(red + q * 4);
    const float mu = ((r1[0] + r1[1]) + (r1[2] + r1[3])) * (1.0f / 128.0f);
    float s2 = 0.f;
#pragma unroll
    for (int i = 0; i < 32; ++i) { v[i] -= mu; s2 += v[i] * v[i]; }
    __syncthreads();
    red[q * 4 + cq] = s2;
    __syncthreads();
    const f32x4 r2 = *(const LAS f32x4*)(red + q * 4);
    const float rstd = 1.0f / sqrtf(((r2[0] + r2[1]) + (r2[2] + r2[3])) * (1.0f / 128.0f) + LN_EPS);
#pragma unroll
    for (int i = 0; i < 32; ++i) { const int c = cq * 32 + i; const float o = v[i] * rstd * p.gm_ln_g[g * 128 + c] + p.gm_ln_b[g * 128 + c];
        *(LAS unsigned short*)(lds + GM_VT + c * 272 + 2 * q) = (unsigned short)f2bf(o); }
    __syncthreads();
    const int pb = wave >> 1, ch = wave & 1, r32 = lane & 31, hq = lane >> 5;
    const bf16* Wg = (const bf16*)(p.ws + WS_GW) + (size_t)g * 128 * 128 + (size_t)(32 * pb + r32) * 128 + 8 * hq;
    f32x16 D0, D1;
#pragma unroll
    for (int i = 0; i < 16; ++i) { D0[i] = 0.f; D1[i] = 0.f; }
#pragma unroll
    for (int ks = 0; ks < 8; ++ks) {
        const s16x8 A = *(const s16x8*)(Wg + 16 * ks);
        const s16x8 B0 = *(const LAS s16x8*)(lds + GM_VT + (32 * (2 * ch) + r32) * 272 + (16 * ks + 8 * hq) * 2);
        const s16x8 B1 = *(const LAS s16x8*)(lds + GM_VT + (32 * (2 * ch + 1) + r32) * 272 + (16 * ks + 8 * hq) * 2);
        D0 = MFMA32(A, B0, D0); D1 = MFMA32(A, B1, D1);
    }
#pragma unroll
    for (int i = 0; i < 16; ++i) {
        const int pp = 32 * pb + (i & 3) + 8 * (i >> 2) + 4 * hq; const size_t row = row0 + pp; const float bias = p.gm_bs[g * 128 + pp];
        const int c0 = 32 * (2 * ch) + r32, c1 = c0 + 32;
        const float u0 = __uint_as_float(((unsigned)proj[row * NPROJ + C_U + g * 128 + c0]) << 16), u1 = __uint_as_float(((unsigned)proj[row * NPROJ + C_U + g * 128 + c1]) << 16);
        Y[row * DM + 512 + g * 128 + c0] = (bf16)f2bf(u0 * (D0[i] + bias)); Y[row * DM + 512 + g * 128 + c1] = (bf16)f2bf(u1 * (D1[i] + bias));
    }
    __syncthreads();
}

__device__ __forceinline__ void hgrn_finalize(const Params& p) {
    const int tid = threadIdx.x, lane = tid & 63, wave = tid >> 6;
    const float* OF = (const float*)(p.ws + WS_OF); const float* OB = (const float*)(p.ws + WS_OB);
    const bf16* proj = (const bf16*)(p.ws + WS_PROJ); bf16* Y = (bf16*)(p.ws + WS_Y);
    for (int t = blockIdx.x * NWAVES + wave; t < MTOK; t += gridDim.x * NWAVES) {
        const f32x4 a0 = *(const f32x4*)(OF + (size_t)t * 512 + lane * 8), a1 = *(const f32x4*)(OF + (size_t)t * 512 + lane * 8 + 4);
        const f32x4 b0 = *(const f32x4*)(OB + (size_t)t * 512 + lane * 8), b1 = *(const f32x4*)(OB + (size_t)t * 512 + lane * 8 + 4);
        const f32x4 o0 = a0 + b0, o1 = a1 + b1;
        float ss = o0[0] * o0[0] + o0[1] * o0[1] + o0[2] * o0[2] + o0[3] * o0[3] + o1[0] * o1[0] + o1[1] * o1[1] + o1[2] * o1[2] + o1[3] * o1[3];
        ss += __shfl_xor(ss, 1); ss += __shfl_xor(ss, 2); ss += __shfl_xor(ss, 4); ss += __shfl_xor(ss, 8);
        const float r = 1.0f / sqrtf(ss * (1.0f / 128.0f) + RMS_EPS);
        const u32x4 gw = *(const u32x4*)(proj + (size_t)t * NPROJ + C_G + lane * 8);
        const f32x4 n0 = *(const f32x4*)(p.hg_norm_g + lane * 8), n1 = *(const f32x4*)(p.hg_norm_g + lane * 8 + 4);
        u32x4 w;
        w.x = pk2(o0[0] * r * n0[0] * bflo(gw.x), o0[1] * r * n0[1] * bfhi(gw.x));
        w.y = pk2(o0[2] * r * n0[2] * bflo(gw.y), o0[3] * r * n0[3] * bfhi(gw.y));
        w.z = pk2(o1[0] * r * n1[0] * bflo(gw.z), o1[1] * r * n1[1] * bfhi(gw.z));
        w.w = pk2(o1[2] * r * n1[2] * bflo(gw.w), o1[3] * r * n1[3] * bfhi(gw.w));
        *(u32x4*)(Y + (size_t)t * DM + lane * 8) = w;
    }
}

__device__ __forceinline__ void ln1_pass(const Params& p, float* dst) {
    const int tid = threadIdx.x, lane = tid & 63, wave = tid >> 6;
    bf16* H1B = (bf16*)(p.ws + WS_XB);
    for (int t = blockIdx.x * NWAVES + wave; t < MTOK; t += gridDim.x * NWAVES) {
        float* row = p.out + (size_t)t * DM;
        f32x4 v[4]; float s = 0.f;
#pragma unroll
        for (int j = 0; j < 4; ++j) { v[j] = *(const f32x4*)(row + j * 256 + lane * 4); s += (v[j][0] + v[j][1]) + (v[j][2] + v[j][3]); }
        const float mean = wave_sum(s) * (1.0f / DM); float s2 = 0.f;
#pragma unroll
        for (int j = 0; j < 4; ++j) { v[j] = v[j] - mean; s2 += (v[j][0] * v[j][0] + v[j][1] * v[j][1]) + (v[j][2] * v[j][2] + v[j][3] * v[j][3]); }
        const float rstd = 1.0f / sqrtf(wave_sum(s2) * (1.0f / DM) + LN_EPS);
        float amax = 0.f;
#pragma unroll
        for (int j = 0; j < 4; ++j) { const f32x4 gg = *(const f32x4*)(p.ln1_g + j * 256 + lane * 4), bb = *(const f32x4*)(p.ln1_b + j * 256 + lane * 4);
            const f32x4 hv = v[j] * rstd * gg + bb;
            *(f32x4*)(dst + (size_t)t * DM + j * 256 + lane * 4) = hv;
            unsigned long long w = (unsigned long long)pk2(hv[0], hv[1]) | ((unsigned long long)pk2(hv[2], hv[3]) << 32);
            *(unsigned long long*)(H1B + (size_t)t * DM + j * 256 + lane * 4) = w;
            v[j] = hv; amax = fmaxf(amax, fmaxf(fmaxf(fabsf(hv[0]), fabsf(hv[1])), fmaxf(fabsf(hv[2]), fabsf(hv[3])))); }
        amax = wave_max(amax);
        const float inv = amax > 0.f ? 448.0f / amax : 0.f;
#pragma unroll
        for (int j = 0; j < 4; ++j) *(unsigned*)(p.ws + WS_H8 + (size_t)t * DM + j * 256 + lane * 4) = pk4_fp8(v[j][0] * inv, v[j][1] * inv, v[j][2] * inv, v[j][3] * inv);
        if (lane == 0) ((float*)(p.ws + WS_HS))[t] = amax * (1.0f / 448.0f);
    }
}

__device__ __forceinline__ unsigned mono_key(float f) { const unsigned u = __float_as_uint(f); return u ^ ((unsigned)((int)u >> 31) | 0x80000000u); }
__device__ __forceinline__ float mono_val(unsigned k) { return __uint_as_float(k ^ ((k >> 31) ? 0x80000000u : 0xFFFFFFFFu)); }
#define CE_DESC(a, b) do { const unsigned _mx = (a) > (b) ? (a) : (b), _mn = (a) > (b) ? (b) : (a); (a) = _mx; (b) = _mn; } while (0)
template <int N> __device__ __forceinline__ void bitonic_sort_desc(unsigned (&k)[N]) {
#pragma unroll
    for (int sz = 2; sz <= N; sz <<= 1)
#pragma unroll
        for (int j = sz >> 1; j > 0; j >>= 1)
#pragma unroll
            for (int i = 0; i < N; ++i) { const int l = i ^ j; if (l > i) { if ((i & sz) == 0) CE_DESC(k[i], k[l]); else CE_DESC(k[l], k[i]); } }
}
template <int N> __device__ __forceinline__ void bitonic_merge_desc(unsigned (&k)[N]) {
#pragma unroll
    for (int j = N >> 1; j > 0; j >>= 1)
#pragma unroll
        for (int i = 0; i < N; ++i) { const int l = i ^ j; if (l > i) CE_DESC(k[i], k[l]); }
}
__device__ __forceinline__ void top16_merge(unsigned (&a)[16], const unsigned (&b)[16]) {
#pragma unroll
    for (int i = 0; i < 16; ++i) a[i] = a[i] > b[15 - i] ? a[i] : b[15 - i];
    bitonic_merge_desc<16>(a);
}
template <int CTRL> __device__ __forceinline__ void top16_merge_dpp(unsigned (&a)[16]) {
    unsigned b[16];
#pragma unroll
    for (int i = 0; i < 16; ++i) b[i] = (unsigned)__builtin_amdgcn_mov_dpp((int)a[i], CTRL, 0xF, 0xF, true);
    top16_merge(a, b);
}
constexpr int TK_SEG = 1088;
constexpr int TK_SCR = 128 * TK_SEG;
__device__ __forceinline__ void topk_phase(const Params& p, unsigned char* lds_g) {
    const int tid = threadIdx.x, lane = tid & 63, wave = __builtin_amdgcn_readfirstlane(tid >> 6);
    const float* SC = (const float*)(p.ws + WS_SC);
    int* EID = (int*)(p.ws + WS_EID); float* GATE = (float*)(p.ws + WS_GATE);
    LAS unsigned char* lds = (LAS unsigned char*)lds_g;
    const int seg = tid >> 2, part = tid & 3;
    for (int bt = blockIdx.x; bt < MTOK / 16; bt += gridDim.x) {
        const float* src = SC + (size_t)bt * 16 * NSC;
#pragma unroll
        for (int i = 0; i < 16; ++i) { const int sg = wave * 16 + i;
            __builtin_amdgcn_global_load_lds((const unsigned*)(src + (size_t)sg * 256 + lane * 4), (LAS unsigned*)(lds + sg * TK_SEG), 16, 0, 0); }
        asm volatile("s_waitcnt vmcnt(0)" ::: "memory");
        __syncthreads();
        unsigned V[2][16];
#pragma unroll
        for (int hh = 0; hh < 2; ++hh) {
            unsigned ka[16], kb[16];
#pragma unroll
            for (int i = 0; i < 4; ++i) { const f32x4 v = *(const LAS f32x4*)(lds + seg * TK_SEG + hh * 512 + (4 * i + part) * 16);
#pragma unroll
                for (int j = 0; j < 4; ++j) ka[4 * i + j] = (mono_key(v[j]) & ~127u) | (unsigned)(127 - (16 * i + 4 * part + j)); }
#pragma unroll
            for (int i = 4; i < 8; ++i) { const f32x4 v = *(const LAS f32x4*)(lds + seg * TK_SEG + hh * 512 + (4 * i + part) * 16);
#pragma unroll
                for (int j = 0; j < 4; ++j) kb[4 * (i - 4) + j] = (mono_key(v[j]) & ~127u) | (unsigned)(127 - (16 * i + 4 * part + j)); }
            bitonic_sort_desc<16>(ka); bitonic_sort_desc<16>(kb);
            top16_merge(ka, kb);
            top16_merge_dpp<0xB1>(ka);
            top16_merge_dpp<0x4E>(ka);
#pragma unroll
            for (int i = 0; i < 16; ++i) V[hh][i] = ka[i];
        }
        LAS unsigned* scr = (LAS unsigned*)(lds + TK_SCR + seg * 32);
        if (part == 0) {
#pragma unroll
            for (int hh = 0; hh < 2; ++hh)
#pragma unroll
                for (int w = 0; w < 4; ++w) scr[hh * 4 + w] = (127u - (V[hh][4 * w] & 127u)) | ((127u - (V[hh][4 * w + 1] & 127u)) << 8) | ((127u - (V[hh][4 * w + 2] & 127u)) << 16) | ((127u - (V[hh][4 * w + 3] & 127u)) << 24);
        }
        float v1[16], v2[16];
#pragma unroll
        for (int i = 0; i < 16; ++i) { v1[i] = mono_val(V[0][i] & ~127u); v2[i] = mono_val(V[1][i] & ~127u); }
#define CKEY(a, b) ((mono_key(v1[a] + v2[b]) & ~255u) | (unsigned)(255 - (16 * (a) + (b))))
        unsigned g0[16], g1[16], g2[16], g3[16];
#pragma unroll
        for (int b = 0; b < 16; ++b) g0[b] = CKEY(0, b);
#pragma unroll
        for (int b = 0; b < 8; ++b) g1[b] = CKEY(1, b);
#pragma unroll
        for (int a = 8; a < 16; ++a) g1[8 + (15 - a)] = CKEY(a, 0);
        bitonic_merge_desc<16>(g1);
        g2[0] = CKEY(2, 0); g2[1] = CKEY(2, 1); g2[2] = CKEY(2, 2); g2[3] = CKEY(2, 3); g2[4] = CKEY(2, 4);
        g2[5] = CKEY(3, 0); g2[6] = CKEY(3, 1); g2[7] = CKEY(3, 2); g2[8] = CKEY(3, 3);
        g2[9] = CKEY(4, 0); g2[10] = CKEY(4, 1); g2[11] = CKEY(4, 2);
        g2[12] = CKEY(5, 0); g2[13] = CKEY(5, 1); g2[14] = CKEY(6, 0); g2[15] = CKEY(6, 1);
        bitonic_sort_desc<16>(g2);
        g3[0] = CKEY(7, 0); g3[1] = CKEY(7, 1);
#pragma unroll
        for (int i = 2; i < 16; ++i) g3[i] = 0u;
        top16_merge(g0, g1); top16_merge(g2, g3); top16_merge(g0, g2);
#undef CKEY
        const float mx = mono_val(g0[0] & ~255u);
        unsigned rk[4]; float ex[4]; float den = 0.f;
#pragma unroll
        for (int i = 0; i < 4; ++i) { rk[i] = part == 0 ? g0[4 * i] : (part == 1 ? g0[4 * i + 1] : (part == 2 ? g0[4 * i + 2] : g0[4 * i + 3]));
            ex[i] = __expf(mono_val(rk[i] & ~255u) - mx); den += ex[i]; }
        den += __builtin_bit_cast(float, __builtin_amdgcn_mov_dpp(__builtin_bit_cast(int, den), 0xB1, 0xF, 0xF, true));
        den += __builtin_bit_cast(float, __builtin_amdgcn_mov_dpp(__builtin_bit_cast(int, den), 0x4E, 0xF, 0xF, true));
        const float rden = 1.0f / den;
        asm volatile("s_waitcnt lgkmcnt(0)" ::: "memory");
        const LAS unsigned char* sb = (const LAS unsigned char*)scr;
        const int tl = seg >> 3, h = seg & 7; const size_t obase = (size_t)(bt * 16 + tl) * 128 + h * 16;
#pragma unroll
        for (int i = 0; i < 4; ++i) { const unsigned flat = 255u - (rk[i] & 255u); const int i1 = sb[flat >> 4], i2 = sb[16 + (flat & 15)];
            EID[obase + 4 * i + part] = i1 * 128 + i2; GATE[obase + 4 * i + part] = ex[i] * rden; }
        __syncthreads();
    }
}

__device__ __forceinline__ void tables_to_fp8(const Params& p) {
    const int lane = threadIdx.x & 63, wave = threadIdx.x >> 6;
    for (int rw = blockIdx.x * NWAVES + wave; rw < 2 * 16384; rw += gridDim.x * NWAVES) {
        const int tb = rw >= 16384, e = rw & 16383;
        const float* src = (tb ? p.pv : p.pu) + (size_t)e * DM + lane * 16;
        f32x4 v[4]; float mx = 0.f;
#pragma unroll
        for (int j = 0; j < 4; ++j) { v[j] = *(const f32x4*)(src + 4 * j); mx = fmaxf(mx, fmaxf(fmaxf(fabsf(v[j][0]), fabsf(v[j][1])), fmaxf(fabsf(v[j][2]), fabsf(v[j][3])))); }
        mx = wave_max(mx);
        const float inv = mx > 0.f ? 448.0f / mx : 0.f;
        u32x4 w; w.x = pk4_fp8(v[0][0] * inv, v[0][1] * inv, v[0][2] * inv, v[0][3] * inv); w.y = pk4_fp8(v[1][0] * inv, v[1][1] * inv, v[1][2] * inv, v[1][3] * inv);
        w.z = pk4_fp8(v[2][0] * inv, v[2][1] * inv, v[2][2] * inv, v[2][3] * inv); w.w = pk4_fp8(v[3][0] * inv, v[3][1] * inv, v[3][2] * inv, v[3][3] * inv);
        *(u32x4*)(p.ws + (tb ? WS_V8 : WS_U8) + (size_t)(lane >> 3) * (16384 * 128) + (size_t)e * 128 + (lane & 7) * 16) = w;
        if (lane == 0) ((float*)(p.ws + (tb ? WS_SV : WS_SU)))[e] = mx * (1.0f / 448.0f);
    }
}

typedef float f32x2 __attribute__((ext_vector_type(2)));
typedef long i64x2 __attribute__((ext_vector_type(2)));
typedef int i32x4 __attribute__((ext_vector_type(4)));
constexpr size_t SLICE_BYTES = (size_t)16384 * 128;
#define PK_CVT(w_, hi_) __builtin_amdgcn_cvt_pk_f32_fp8((int)(w_), hi_)
__device__ __forceinline__ float dpp_f(float v, const int ctrl_sel) {
    const int iv = __builtin_bit_cast(int, v);
    const int o = ctrl_sel == 0 ? __builtin_amdgcn_mov_dpp(iv, 0xB1, 0xF, 0xF, true) : (ctrl_sel == 1 ? __builtin_amdgcn_mov_dpp(iv, 0x4E, 0xF, 0xF, true) : __builtin_amdgcn_mov_dpp(iv, 0x141, 0xF, 0xF, true));
    return __builtin_bit_cast(float, o);
}
__device__ __forceinline__ void peer_u_phase(const Params& p) {
    const int tid = threadIdx.x, lane = tid & 63, wave = tid >> 6;
    const int x = blockIdx.x & 7, wg = (blockIdx.x >> 3) * NWAVES + wave, nwg = (gridDim.x >> 3) * NWAVES;
    const unsigned char* U8 = p.ws + WS_U8 + (size_t)x * SLICE_BYTES; const unsigned char* H8 = p.ws + WS_H8 + 128 * x;
    const int* EID = (const int*)(p.ws + WS_EID); float* HIDP = (float*)(p.ws + WS_HIDP) + (size_t)x * MTOK * 128;
    const int r8 = lane >> 3, c = lane & 7;
    const int NS = ((MTOK / 8 - wg + nwg - 1) / nwg) * 16;
#define PS_TOK(s_) ((size_t)(wg + ((s_) >> 4) * nwg) * 8 + r8)
#define PS_IDP(s_) (EID + PS_TOK(s_) * 128 + 8 * ((s_) & 15))
#define PS_GATHER(G_, ea_, eb_) do { G_[0] = *(const u32x4*)(U8 + (size_t)ea_[0] * 128 + 16 * c); G_[1] = *(const u32x4*)(U8 + (size_t)ea_[1] * 128 + 16 * c); G_[2] = *(const u32x4*)(U8 + (size_t)ea_[2] * 128 + 16 * c); G_[3] = *(const u32x4*)(U8 + (size_t)ea_[3] * 128 + 16 * c); \
        G_[4] = *(const u32x4*)(U8 + (size_t)eb_[0] * 128 + 16 * c); G_[5] = *(const u32x4*)(U8 + (size_t)eb_[1] * 128 + 16 * c); G_[6] = *(const u32x4*)(U8 + (size_t)eb_[2] * 128 + 16 * c); G_[7] = *(const u32x4*)(U8 + (size_t)eb_[3] * 128 + 16 * c); } while (0)
#define PU_CONSUME(G_, val_) do { val_ = 0.f; _Pragma("unroll") for (int j_ = 0; j_ < 8; ++j_) { const u32x4 v_ = G_[j_]; \
        f32x2 sa_ = PK_CVT(v_.x, false) * hf[0]; sa_ += PK_CVT(v_.x, true) * hf[1]; sa_ += PK_CVT(v_.y, false) * hf[2]; sa_ += PK_CVT(v_.y, true) * hf[3]; \
        sa_ += PK_CVT(v_.z, false) * hf[4]; sa_ += PK_CVT(v_.z, true) * hf[5]; sa_ += PK_CVT(v_.w, false) * hf[6]; sa_ += PK_CVT(v_.w, true) * hf[7]; \
        float d_ = sa_[0] + sa_[1]; d_ += dpp_f(d_, 0); d_ += dpp_f(d_, 1); d_ += dpp_f(d_, 2); val_ = (c == j_) ? d_ : val_; } } while (0)
#define PU_HCVT(h_) do { hf[0] = PK_CVT(h_.x, false); hf[1] = PK_CVT(h_.x, true); hf[2] = PK_CVT(h_.y, false); hf[3] = PK_CVT(h_.y, true); \
        hf[4] = PK_CVT(h_.z, false); hf[5] = PK_CVT(h_.z, true); hf[6] = PK_CVT(h_.w, false); hf[7] = PK_CVT(h_.w, true); } while (0)
    if (NS <= 0) return;
    i32x4 ea[3], eb[3]; u32x4 G[3][8];
#pragma unroll
    for (int i = 0; i < 3; ++i) { ea[i] = *(const i32x4*)PS_IDP(i); eb[i] = *(const i32x4*)(PS_IDP(i) + 4); }
    PS_GATHER(G[0], ea[0], eb[0]); PS_GATHER(G[1], ea[1], eb[1]);
    ea[0] = *(const i32x4*)PS_IDP(3); eb[0] = *(const i32x4*)(PS_IDP(3) + 4); ea[1] = *(const i32x4*)PS_IDP(4); eb[1] = *(const i32x4*)(PS_IDP(4) + 4);
    u32x4 hnext = *(const u32x4*)(H8 + PS_TOK(0) * DM + 16 * c);
    f32x2 hf[8];
    PU_HCVT(hnext);
#define PU_STEP(i_) do { const int s_ = s0 + (i_); if (s_ < NS) { \
        if (s_ + 2 < NS) PS_GATHER(G[((i_) + 2) % 3], ea[((i_) + 2) % 3], eb[((i_) + 2) % 3]); \
        if (s_ + 5 < NS) { ea[((i_) + 2) % 3] = *(const i32x4*)PS_IDP(s_ + 5); eb[((i_) + 2) % 3] = *(const i32x4*)(PS_IDP(s_ + 5) + 4); } \
        if ((s_ & 15) == 0 && s_ + 16 < NS) hnext = *(const u32x4*)(H8 + PS_TOK(s_ + 16) * DM + 16 * c); \
        float val_; PU_CONSUME(G[(i_)], val_); \
        HIDP[PS_TOK(s_) * 128 + 8 * (s_ & 15) + c] = val_; \
        if ((s_ & 15) == 15) PU_HCVT(hnext); } } while (0)
    for (int s0 = 0; s0 < NS; s0 += 3) { PU_STEP(0); PU_STEP(1); PU_STEP(2); }
#undef PU_STEP
#undef PU_HCVT
#undef PU_CONSUME
#undef PS_GATHER
}
__device__ __forceinline__ void peer_a_phase(const Params& p) {
    const float* HIDP = (const float*)(p.ws + WS_HIDP); const int* EID = (const int*)(p.ws + WS_EID); const float* GATE = (const float*)(p.ws + WS_GATE);
    const float* SU = (const float*)(p.ws + WS_SU); const float* SV = (const float*)(p.ws + WS_SV); const float* HS = (const float*)(p.ws + WS_HS);
    float* ACT = (float*)(p.ws + WS_ACT);
    const size_t n4 = (size_t)MTOK * 128 / 4, gsz = (size_t)gridDim.x * NT;
    for (size_t i = (size_t)blockIdx.x * NT + threadIdx.x; i < n4; i += gsz) {
        f32x4 h = *(const f32x4*)(HIDP + 4 * i);
#pragma unroll
        for (int xx = 1; xx < 8; ++xx) h += *(const f32x4*)(HIDP + (size_t)xx * MTOK * 128 + 4 * i);
        const i32x4 e = *(const i32x4*)(EID + 4 * i); const f32x4 g = *(const f32x4*)(GATE + 4 * i); const float hs = HS[i >> 5];
        f32x4 a;
#pragma unroll
        for (int j = 0; j < 4; ++j) a[j] = g[j] * SV[e[j]] * gelu_tanh(h[j] * SU[e[j]] * hs);
        *(f32x4*)(ACT + 4 * i) = a;
    }
}
__device__ __forceinline__ void peer_v_phase(const Params& p, float* dst, int tmask) {
    const int tid = threadIdx.x, lane = tid & 63, wave = tid >> 6;
    const int x = blockIdx.x & 7, wg = (blockIdx.x >> 3) * NWAVES + wave, nwg = (gridDim.x >> 3) * NWAVES;
    const unsigned char* V8 = p.ws + WS_V8 + (size_t)x * SLICE_BYTES;
    const int* EID = (const int*)(p.ws + WS_EID); const float* ACT = (const float*)(p.ws + WS_ACT);
    const int r8 = lane >> 3, c = lane & 7;
    const int NS = ((MTOK / 8 - wg + nwg - 1) / nwg) * 16;
#define PS_GATHER(G_, ea_, eb_) do { G_[0] = *(const u32x4*)(V8 + (size_t)ea_[0] * 128 + 16 * c); G_[1] = *(const u32x4*)(V8 + (size_t)ea_[1] * 128 + 16 * c); G_[2] = *(const u32x4*)(V8 + (size_t)ea_[2] * 128 + 16 * c); G_[3] = *(const u32x4*)(V8 + (size_t)ea_[3] * 128 + 16 * c); \
        G_[4] = *(const u32x4*)(V8 + (size_t)eb_[0] * 128 + 16 * c); G_[5] = *(const u32x4*)(V8 + (size_t)eb_[1] * 128 + 16 * c); G_[6] = *(const u32x4*)(V8 + (size_t)eb_[2] * 128 + 16 * c); G_[7] = *(const u32x4*)(V8 + (size_t)eb_[3] * 128 + 16 * c); } while (0)
#define PS_ACP(s_) (ACT + PS_TOK(s_) * 128 + 8 * ((s_) & 15))
#define PV_CONSUME(G_, aa_, ab_) do { _Pragma("unroll") for (int j_ = 0; j_ < 8; ++j_) { const u32x4 v_ = G_[j_]; const float a_ = j_ < 4 ? aa_[j_ & 3] : ab_[j_ & 3]; const f32x2 a2_ = (f32x2){a_, a_}; \
        o[0] += PK_CVT(v_.x, false) * a2_; o[1] += PK_CVT(v_.x, true) * a2_; o[2] += PK_CVT(v_.y, false) * a2_; o[3] += PK_CVT(v_.y, true) * a2_; \
        o[4] += PK_CVT(v_.z, false) * a2_; o[5] += PK_CVT(v_.z, true) * a2_; o[6] += PK_CVT(v_.w, false) * a2_; o[7] += PK_CVT(v_.w, true) * a2_; } } while (0)
    if (NS <= 0) return;
    i32x4 ea[3], eb[3]; f32x4 aa[3], ab[3]; u32x4 G[3][8];
#pragma unroll
    for (int i = 0; i < 3; ++i) { ea[i] = *(const i32x4*)PS_IDP(i); eb[i] = *(const i32x4*)(PS_IDP(i) + 4); aa[i] = *(const f32x4*)PS_ACP(i); ab[i] = *(const f32x4*)(PS_ACP(i) + 4); }
    PS_GATHER(G[0], ea[0], eb[0]); PS_GATHER(G[1], ea[1], eb[1]);
    ea[0] = *(const i32x4*)PS_IDP(3); eb[0] = *(const i32x4*)(PS_IDP(3) + 4); ea[1] = *(const i32x4*)PS_IDP(4); eb[1] = *(const i32x4*)(PS_IDP(4) + 4);
    f32x2 o[8];
#pragma unroll
    for (int i = 0; i < 8; ++i) o[i] = (f32x2){0.f, 0.f};
#define PV_STEP(i_) do { const int s_ = s0 + (i_); if (s_ < NS) { \
        if (s_ + 2 < NS) PS_GATHER(G[((i_) + 2) % 3], ea[((i_) + 2) % 3], eb[((i_) + 2) % 3]); \
        if (s_ + 5 < NS) { ea[((i_) + 2) % 3] = *(const i32x4*)PS_IDP(s_ + 5); eb[((i_) + 2) % 3] = *(const i32x4*)(PS_IDP(s_ + 5) + 4); } \
        PV_CONSUME(G[(i_)], aa[(i_)], ab[(i_)]); \
        if (s_ + 3 < NS) { aa[(i_)] = *(const f32x4*)PS_ACP(s_ + 3); ab[(i_)] = *(const f32x4*)(PS_ACP(s_ + 3) + 4); } \
        if ((s_ & 15) == 15) { const size_t t_ = PS_TOK(s_); \
            const float* row_ = p.out + t_ * DM + 128 * x + 16 * c; float* drow_ = dst + (size_t)(t_ & (size_t)tmask) * DM + 128 * x + 16 * c; \
            _Pragma("unroll") for (int j_ = 0; j_ < 4; ++j_) *(f32x4*)(drow_ + 4 * j_) = *(const f32x4*)(row_ + 4 * j_) * ALPHA + (f32x4){o[2 * j_][0], o[2 * j_][1], o[2 * j_ + 1][0], o[2 * j_ + 1][1]}; \
            _Pragma("unroll") for (int j_ = 0; j_ < 8; ++j_) o[j_] = (f32x2){0.f, 0.f}; } } } while (0)
    for (int s0 = 0; s0 < NS; s0 += 3) { PV_STEP(0); PV_STEP(1); PV_STEP(2); }
#undef PV_STEP
#undef PV_CONSUME
#undef PS_GATHER
#undef PS_ACP
#undef PS_IDP
#undef PS_TOK
}
__device__ __forceinline__ void ln2_pass(const Params& p) {
    const int tid = threadIdx.x, lane = tid & 63, wave = tid >> 6;
    for (int t = blockIdx.x * NWAVES + wave; t < MTOK; t += gridDim.x * NWAVES) {
        float* row = p.out + (size_t)t * DM;
        f32x4 v[4]; float s = 0.f;
#pragma unroll
        for (int j = 0; j < 4; ++j) { v[j] = *(const f32x4*)(row + j * 256 + lane * 4); s += (v[j][0] + v[j][1]) + (v[j][2] + v[j][3]); }
        const float mean = wave_sum(s) * (1.0f / DM); float s2 = 0.f;
#pragma unroll
        for (int j = 0; j < 4; ++j) { v[j] = v[j] - mean; s2 += (v[j][0] * v[j][0] + v[j][1] * v[j][1]) + (v[j][2] * v[j][2] + v[j][3] * v[j][3]); }
        const float rstd = 1.0f / sqrtf(wave_sum(s2) * (1.0f / DM) + LN_EPS);
#pragma unroll
        for (int j = 0; j < 4; ++j) { const f32x4 gg = *(const f32x4*)(p.ln2_g + j * 256 + lane * 4), bb = *(const f32x4*)(p.ln2_b + j * 256 + lane * 4);
            *(f32x4*)(row + j * 256 + lane * 4) = v[j] * rstd * gg + bb; }
    }
}

#define RLX_AGENT __ATOMIC_RELAXED, __HIP_MEMORY_SCOPE_AGENT
#define XB_TMO      128
#define XB_XCNT(j)  (256  + 64 * (j))
#define XB_XSUB(j)  (1280 + 64 * (j))
#define XB_XGEN(j)  (2304 + 64 * (j))
#define XB_TOP      3328
#define XB_TOPGEN   3392
#define XCD_BAR_WORDS 3456
#define XB_SPIN_CAP (1u << 18)

__device__ __forceinline__ unsigned xb_ld(unsigned* p)              { return __hip_atomic_load(p, __ATOMIC_RELAXED, __HIP_MEMORY_SCOPE_AGENT); }
__device__ __forceinline__ unsigned xb_add(unsigned* p, unsigned v) { return __hip_atomic_fetch_add(p, v, __ATOMIC_RELAXED, __HIP_MEMORY_SCOPE_AGENT); }
__device__ __forceinline__ unsigned xb_xcc_id() { return (unsigned)__builtin_amdgcn_s_getreg((3 << 11) | 20) & 0xFu; }
#define XB_SPIN(cond, bar) do { unsigned _sp = 0; while (cond) { __builtin_amdgcn_s_sleep(1); \
    if ((++_sp & 255u) == 0u) { if (xb_ld(&(bar)[XB_TMO])) break; if (_sp > XB_SPIN_CAP) { atomicAdd(&(bar)[XB_TMO], 1u); break; } } } } while (0)

struct XcdBarrier {
    unsigned* bar; unsigned x;
    volatile LAS unsigned* st;
};

__device__ __forceinline__ XcdBarrier xcd_barrier_post(unsigned* bar, volatile LAS unsigned* st) {
    XcdBarrier b; b.bar = bar; b.x = xb_xcc_id(); b.st = st;
    if (threadIdx.x == 0) (void)xb_add(&bar[XB_XCNT(b.x)], 1u);
    return b;
}
__device__ __forceinline__ void xcd_barrier_complete(unsigned* bar, unsigned x, unsigned& nloc, unsigned& nx) {
    const unsigned G = gridDim.x * gridDim.y * gridDim.z;
    unsigned sum, cnt, mine, sp = 0u;
    for (;;) {
        sum = 0u; cnt = 0u; mine = 0u;
#pragma unroll
        for (unsigned j = 0; j < 16; ++j) { const unsigned c = xb_ld(&bar[XB_XCNT(j)]); sum += c; cnt += (c > 0u) ? 1u : 0u; mine = (j == x) ? c : mine; }
        if (sum == G) break;
        __builtin_amdgcn_s_sleep(1);
        if ((++sp & 255u) == 0u) { if (xb_ld(&bar[XB_TMO])) break; if (sp > XB_SPIN_CAP) { atomicAdd(&bar[XB_TMO], 1u); break; } }
    }
    nloc = mine > 0u ? mine : 1u; nx = cnt > 0u ? cnt : 1u;
}

__device__ __forceinline__ void xcd_barrier(const XcdBarrier& b) {
    asm volatile("s_waitcnt vmcnt(0)" ::: "memory");
    __syncthreads();
    if (threadIdx.x == 0) {
        unsigned* bar = b.bar;
        __builtin_amdgcn_s_waitcnt(0);
        unsigned nloc = b.st[0], nx = b.st[1];
        if (nloc == 0u) { xcd_barrier_complete(bar, b.x, nloc, nx); b.st[0] = nloc; b.st[1] = nx; }
        const unsigned old = xb_add(&bar[XB_XSUB(b.x)], 1u);
        const unsigned gen = old / nloc;
        if (old + 1u == (gen + 1u) * nloc) {
            __builtin_amdgcn_fence(__ATOMIC_RELEASE, "agent");
            asm volatile("s_waitcnt vmcnt(0)" ::: "memory");
            const unsigned og = xb_add(&bar[XB_TOP], 1u);
            const unsigned tg = og / nx;
            if (og + 1u == (tg + 1u) * nx) xb_add(&bar[XB_TOPGEN], 1u);
            else XB_SPIN(xb_ld(&bar[XB_TOPGEN]) == tg, bar);
            __builtin_amdgcn_fence(__ATOMIC_ACQUIRE, "agent");
            xb_add(&bar[XB_XGEN(b.x)], 1u);
            asm volatile("s_waitcnt vmcnt(0)" ::: "memory");
        } else {
            XB_SPIN(xb_ld(&bar[XB_XGEN(b.x)]) == gen, bar);
            __builtin_amdgcn_fence(__ATOMIC_ACQUIRE, "agent");
            asm volatile("s_waitcnt vmcnt(0)" ::: "memory");
        }
    }
    __syncthreads();
}

#ifndef REP_P0
#define REP_P0 1
#endif
#ifndef REP_P1
#define REP_P1 1
#endif
#ifndef REP_HG
#define REP_HG 1
#endif
#ifndef REP_GM
#define REP_GM 1
#endif
#ifndef REP_FIN
#define REP_FIN 1
#endif
#ifndef REP_P3
#define REP_P3 1
#endif
#ifndef REP_LN1
#define REP_LN1 1
#endif
#ifndef REP_TAB
#define REP_TAB 1
#endif
#ifndef REP_P4
#define REP_P4 1
#endif
#ifndef REP_TK
#define REP_TK 1
#endif
#ifndef REP_PEER
#define REP_PEER 1
#endif
#ifndef REP_PV
#define REP_PV 1
#endif
#ifndef REP_SYNC
#define REP_SYNC 1
#endif
__global__ void __launch_bounds__(NT, 2) mega(Params p) {
    extern __shared__ __attribute__((aligned(16))) unsigned char lds[];
    cg::grid_group grid = cg::this_grid();
    unsigned char* ws = p.ws;
    const int G = gridDim.x;
    volatile LAS unsigned* xst = (volatile LAS unsigned*)((LAS unsigned char*)lds + (LDS_BYTES - 64));
    if (threadIdx.x < 2) xst[threadIdx.x] = 0u;
    __syncthreads();
    const XcdBarrier xb = xcd_barrier_post((unsigned*)ws, xst);

    for (int rep = 0; rep < REP_P0; ++rep) { phase0(p, lds); __syncthreads(); }
    for (int rep = 0; rep < REP_SYNC; ++rep) grid.sync();

    for (int rep = 0; rep < REP_P1; ++rep)
    {
        pg8::Gemm g{(const bf16*)(ws + WS_XB), (const bf16*)(ws + WS_WIN), MTOK, NPROJ, DM}; pg8::StaticOrder S; S.init(MTOK, NPROJ, G, (int)blockIdx.x);
        pg8::EpiProj E{(bf16*)(ws + WS_PROJ)};
        pg8::gemm_phase<pg8::EpiProj, pg8::StaticOrder, true, true>((PG8_LAS unsigned char*)lds, g, S, E);
    }
    xcd_barrier(xb);

    {
        const int half = G / 2;
        if ((int)blockIdx.x < half) { for (int rep = 0; rep < REP_HG; ++rep) for (int it = blockIdx.x; it < 128; it += half) hgrn_chunk_item(p, lds, it); }
        else { for (int rep = 0; rep < REP_GM; ++rep) for (int it = blockIdx.x - half; it < 2048; it += G - half) gmlp_mfma_item(p, lds, it); }
    }
    xcd_barrier(xb);
    for (int rep = 0; rep < REP_FIN; ++rep) hgrn_finalize(p);
    xcd_barrier(xb);

    for (int rep = 0; rep < REP_P3; ++rep)
    {
        pg8::Gemm g{(const bf16*)(ws + WS_Y), (const bf16*)(ws + WS_WOUT), MTOK, DM, DM}; pg8::StaticOrder S; S.init(MTOK, DM, G, (int)blockIdx.x);
        pg8::EpiPre E{p.x, p.out};
        pg8::gemm_phase<pg8::EpiPre, pg8::StaticOrder, true, true>((PG8_LAS unsigned char*)lds, g, S, E);
    }
    xcd_barrier(xb);
    for (int rep = 1; rep < REP_LN1; ++rep) ln1_pass(p, (float*)(ws + WS_PROJ));
    ln1_pass(p, p.out);
    for (int rep = 0; rep < REP_TAB; ++rep) tables_to_fp8(p);
    xcd_barrier(xb);

    for (int rep = 0; rep < REP_P4; ++rep)
    {
        pg8::Gemm g{(const bf16*)(ws + WS_XB), (const bf16*)(ws + WS_WSC), MTOK, NSC, DM}; pg8::StaticOrder S; S.init(MTOK, NSC, G, (int)blockIdx.x);
        pg8::EpiF32 E{(float*)(ws + WS_SC), NSC};
        pg8::gemm_phase<pg8::EpiF32, pg8::StaticOrder, true, true>((PG8_LAS unsigned char*)lds, g, S, E);
    }
    xcd_barrier(xb);
    for (int rep = 0; rep < REP_TK; ++rep) topk_phase(p, lds);
    xcd_barrier(xb);
    for (int rep = 0; rep < REP_PEER; ++rep) peer_u_phase(p);
    xcd_barrier(xb);
    peer_a_phase(p);
    xcd_barrier(xb);
    for (int rep = 1; rep < REP_PV; ++rep) peer_v_phase(p, (float*)(ws + WS_OB), 32767);
    peer_v_phase(p, p.out, MTOK - 1);
    xcd_barrier(xb);
    ln2_pass(p);
}

extern "C" void kernel_launch(void* const* d_in, const int* in_sizes, int n_in, void* d_out, int out_size, void* d_ws, size_t ws_size, hipStream_t stream) {
    static int grid = 0;
    if (grid == 0) {
        if (n_in != 18 || in_sizes[0] != MTOK * DM || out_size != MTOK * DM || ws_size < WS_END) {
            fprintf(stderr, "kernel_launch: unexpected shapes (n_in %d, in0 %d, out %d, ws %zu); nothing launched\n", n_in, n_in > 0 ? in_sizes[0] : -1, out_size, ws_size); grid = -1; return; }
        int dev = 0, cus = 0, per_cu = 0;
        if (hipGetDevice(&dev) != hipSuccess || hipDeviceGetAttribute(&cus, hipDeviceAttributeMultiprocessorCount, dev) != hipSuccess) { grid = -1; return; }
        if (hipFuncSetAttribute((const void*)mega, hipFuncAttributeMaxDynamicSharedMemorySize, LDS_BYTES) != hipSuccess) { fprintf(stderr, "kernel_launch: hipFuncSetAttribute failed\n"); grid = -1; return; }
        if (hipOccupancyMaxActiveBlocksPerMultiprocessor(&per_cu, (const void*)mega, NT, LDS_BYTES) != hipSuccess || per_cu < 1) { fprintf(stderr, "kernel_launch: occupancy query says %d\n", per_cu); grid = -1; return; }
        grid = cus;
    }
    if (grid < 0) return;
    Params p{};
    p.x = (const float*)d_in[0]; p.w_in = (const float*)d_in[1]; p.lb_logits = (const float*)d_in[2]; p.hg_norm_g = (const float*)d_in[3];
    p.gm_ln_g = (const float*)d_in[4]; p.gm_ln_b = (const float*)d_in[5]; p.gm_ws = (const float*)d_in[6]; p.gm_bs = (const float*)d_in[7];
    p.w_out = (const float*)d_in[8]; p.ln1_g = (const float*)d_in[9]; p.ln1_b = (const float*)d_in[10]; p.wq = (const float*)d_in[11];
    p.k1 = (const float*)d_in[12]; p.k2 = (const float*)d_in[13]; p.pu = (const float*)d_in[14]; p.pv = (const float*)d_in[15];
    p.ln2_g = (const float*)d_in[16]; p.ln2_b = (const float*)d_in[17];
    p.out = (float*)d_out; p.ws = (unsigned char*)d_ws;
    if (hipMemsetAsync(d_ws, 0, XCD_BAR_WORDS * 4, stream) != hipSuccess) { fprintf(stderr, "kernel_launch: hipMemsetAsync of the barrier words failed; nothing launched\n"); return; }
    void* args[] = {&p};
    hipError_t e = hipLaunchCooperativeKernel((const void*)mega, dim3(grid), dim3(NT), args, LDS_BYTES, stream);
    if (e != hipSuccess) fprintf(stderr, "kernel_launch: cooperative launch failed: %s (grid %d)\n", hipGetErrorString(e), grid);
}
```
